# Optimizing an MI355X kernel written in HIP

```python
import jax
import jax.numpy as jnp
from jax import lax
import numpy as np

D_MODEL = 4096
BATCH = 4
SEQ = 2048
DEPTH = 2
DEC_BATCH = 8
DEC_SEQ = 8
PAST_LEN = 16384
PAGE_SIZE = 128

N_MIXERS = 2
N_A_LAYERS = (DEPTH + 1) // 2
N_B_LAYERS = DEPTH // 2
RMS_EPS = 1e-6

N_MEM = 256
MEM_HEADS = 4
MEM_HD = D_MODEL // 16
MEM_W = MEM_HEADS * MEM_HD
MIX_W = D_MODEL - MEM_W

A_HD = 64
A_HEADS = MIX_W // A_HD
DECAY_LORA = 96
AAA_LORA = 96
GATE_LORA = 384
A_SHIFT_W = 3 * MIX_W + DECAY_LORA + AAA_LORA + GATE_LORA
A_IN_W = A_SHIFT_W + MEM_W
A_OUT_W = MIX_W + MEM_W
LNX_EPS = 64e-5

B_HD = 128
B_GROUPS = ((128, 1), (512, 4), (2048, 16))
B_HEADS = MIX_W // B_HD
B_GH = B_HEADS // len(B_GROUPS)
B_OUT_W = B_GH * B_HD
B_IN_W = 3 * MIX_W + MEM_W
B_OUT_IN = B_OUT_W + MEM_W

D_FF = -(-(8 * D_MODEL) // (3 * 256)) * 256

kernel_name = 'rwkv7_dilated_swa_memxattn_hybrid_step'


def _rmsnorm(x, g, eps=RMS_EPS):
    xf = x.astype(jnp.float32)
    y = xf * lax.rsqrt(jnp.mean(xf * xf, axis=-1, keepdims=True) + eps)
    return (y * g.astype(jnp.float32)).astype(x.dtype)


def _mem_kv(mem, g_norm, w_kv, g_k):
    b = mem.shape[0]
    kv = (_rmsnorm(mem, g_norm) @ w_kv).reshape(b, N_MEM, 2, MEM_HEADS, MEM_HD)
    return jnp.stack([_rmsnorm(kv[:, :, 0], g_k), kv[:, :, 1]], axis=2)


def _mem_attend(qm, kv, g_q):
    b, t = qm.shape[:2]
    q = _rmsnorm(qm.reshape(b, t, MEM_HEADS, MEM_HD), g_q)
    s = jnp.einsum('bthd,bmhd->bhtm', q, kv[:, :, 0]).astype(jnp.float32) * (MEM_HD ** -0.5)
    p = jax.nn.softmax(s, axis=-1).astype(kv.dtype)
    return jnp.einsum('bhtm,bmhd->bthd', p, kv[:, :, 1]).reshape(b, t, MEM_W)


def _wkv_scan(s0, r, w, k, v, a, b):
    xs = tuple(jnp.moveaxis(z.astype(jnp.float32), 1, 0) for z in (r, w, k, v, a, b))

    def step(s, inp):
        r_t, w_t, k_t, v_t, a_t, b_t = inp
        sa = jnp.einsum('bhvk,bhk->bhv', s, a_t)
        s = s * w_t[:, :, None, :] + sa[..., None] * b_t[:, :, None, :] + v_t[..., None] * k_t[:, :, None, :]
        return s, jnp.einsum('bhvk,bhk->bhv', s, r_t)

    s, ys = lax.scan(step, s0.astype(jnp.float32), xs)
    return s, jnp.moveaxis(ys, 0, 1)


def _rwkv7(u, u_prev0, s0, mu, w0, w2, a0, a2, g2, k_k, k_a, r_k, lnx_g, lnx_b):
    bsz, t = u.shape[:2]
    u_prev = jnp.concatenate([u_prev0.astype(u.dtype), u[:, :-1]], axis=1)
    us = u + (u_prev - u) * mu
    o = 3 * MIX_W
    r, k, v = us[..., :MIX_W], us[..., MIX_W:2 * MIX_W], us[..., 2 * MIX_W:o]
    wl = us[..., o:o + DECAY_LORA]
    al = us[..., o + DECAY_LORA:o + DECAY_LORA + AAA_LORA]
    gl = us[..., o + DECAY_LORA + AAA_LORA:]
    w_log = -jax.nn.softplus(-(w0 + jnp.tanh(wl) @ w2)) - 0.5
    decay = jnp.exp(-jnp.exp(w_log.astype(jnp.float32)))
    a = jax.nn.sigmoid(a0 + al @ a2)
    g = jax.nn.sigmoid(gl) @ g2
    hs = lambda z: z.reshape(bsz, t, A_HEADS, A_HD)
    kk = hs(k * k_k).astype(jnp.float32)
    kk = kk / jnp.maximum(jnp.sqrt(jnp.sum(kk * kk, axis=-1, keepdims=True)), 1e-12)
    k = k * (1 + (a - 1) * k_a)
    ah = hs(a).astype(jnp.float32)
    s, y = _wkv_scan(s0, hs(r), hs(decay), hs(k), hs(v), -kk, kk * ah)
    mean = jnp.mean(y, axis=-1, keepdims=True)
    var = jnp.mean(jnp.square(y - mean), axis=-1, keepdims=True)
    y = ((y - mean) * lax.rsqrt(var + LNX_EPS)).reshape(bsz, t, MIX_W) * lnx_g + lnx_b
    bonus = jnp.sum(hs(r).astype(jnp.float32) * hs(k).astype(jnp.float32) * r_k, axis=-1, keepdims=True) * hs(v).astype(jnp.float32)
    y = (y + bonus.reshape(bsz, t, MIX_W)).astype(u.dtype) * g
    return y, s, u[:, -1:]


def _dswa_qkv(u, g_q, g_k):
    bsz, t = u.shape[:2]
    hs = lambda z: z.reshape(bsz, t, B_HEADS, B_HD)
    q = _rmsnorm(hs(u[..., :MIX_W]), g_q)
    k = _rmsnorm(hs(u[..., MIX_W:2 * MIX_W]), g_k)
    v = hs(u[..., 2 * MIX_W:3 * MIX_W])
    return q, k, v


def _dilated_band_attn(q, k, v, window, dil):
    bsz, t = q.shape[:2]
    span = window // dil
    sub = t // dil
    n_blk = -(-sub // span)
    pad = n_blk * span - sub

    def blocks(z):
        z = z.reshape(bsz, sub, dil, B_GH, B_HD).transpose(0, 2, 1, 3, 4)
        z = jnp.pad(z, ((0, 0), (0, 0), (0, pad), (0, 0), (0, 0)))
        return z.reshape(bsz, dil, n_blk, span, B_GH, B_HD)

    def with_prev(z):
        prev = jnp.pad(z, ((0, 0), (0, 0), (1, 0), (0, 0), (0, 0), (0, 0)))[:, :, :-1]
        return jnp.concatenate([prev, z], axis=3)

    qb = blocks(q)
    kb = with_prev(blocks(k))
    vb = with_prev(blocks(v))
    s = jnp.einsum('brnqhd,brnkhd->brnhqk', qb, kb).astype(jnp.float32) * (B_HD ** -0.5)
    qi = jnp.arange(span)[:, None] + span
    ki = jnp.arange(2 * span)[None, :]
    dist = qi - ki
    band = (dist >= 0) & (dist <= span)
    exists = (jnp.arange(n_blk)[:, None, None] * span + ki[None] - span) >= 0
    mask = band[None] & exists
    s = jnp.where(mask[None, None, :, None], s, -jnp.inf)
    lse = jax.nn.logsumexp(s, axis=-1)
    p = jnp.exp(s - lse[..., None]).astype(v.dtype)
    o = jnp.einsum('brnhqk,brnkhd->brnqhd', p, vb)
    o = o.reshape(bsz, dil, n_blk * span, B_GH, B_HD)[:, :, :sub]
    o = o.transpose(0, 2, 1, 3, 4).reshape(bsz, t, B_GH, B_HD)
    lse = lse.transpose(0, 1, 2, 4, 3).reshape(bsz, dil, n_blk * span, B_GH)[:, :, :sub]
    lse = lse.transpose(0, 2, 1, 3).reshape(bsz, t, B_GH)
    return o, lse


def _dilated_window_step(q, k, v, buf, window, dil):
    rows = buf.shape[1]
    ts = q.shape[1]
    kc = jnp.concatenate([buf[:, :, 0], k], axis=1)
    vc = jnp.concatenate([buf[:, :, 1], v], axis=1)
    span = window // dil
    idx = rows + jnp.arange(ts)[:, None] - dil * jnp.arange(span + 1)[None, :]
    valid = idx >= 0
    idx = jnp.maximum(idx, 0)
    kg = kc[:, idx]
    vg = vc[:, idx]
    s = jnp.einsum('bthd,btjhd->bthj', q, kg).astype(jnp.float32) * (B_HD ** -0.5)
    s = jnp.where(valid[None, :, None, :], s, -jnp.inf)
    lse = jax.nn.logsumexp(s, axis=-1)
    p = jnp.exp(s - lse[..., None]).astype(vg.dtype)
    o = jnp.einsum('bthj,btjhd->bthd', p, vg)
    new_buf = jnp.stack([kc[:, -rows:], vc[:, -rows:]], axis=2)
    return o, lse, new_buf


def _merge_groups(outs, lses):
    wts = jax.nn.softmax(jnp.stack(lses, axis=0), axis=0)
    o = jnp.einsum('gbth,gbthd->bthd', wts, jnp.stack(outs, axis=0).astype(jnp.float32))
    return o.reshape(o.shape[0], o.shape[1], B_OUT_W)


def _dswa_prompt(u, g_q, g_k):
    q, k, v = _dswa_qkv(u, g_q, g_k)
    outs, lses, bufs = [], [], []
    for g, (win, dil) in enumerate(B_GROUPS):
        sl = slice(g * B_GH, (g + 1) * B_GH)
        o, l = _dilated_band_attn(q[:, :, sl], k[:, :, sl], v[:, :, sl], win, dil)
        outs.append(o)
        lses.append(l)
        keep = min(win, q.shape[1])
        bufs.append(jnp.stack([k[:, -keep:, sl], v[:, -keep:, sl]], axis=2))
    return _merge_groups(outs, lses).astype(u.dtype), bufs


def _dswa_sample(u, g_q, g_k, bufs_in):
    q, k, v = _dswa_qkv(u, g_q, g_k)
    outs, lses, bufs = [], [], []
    for g, (win, dil) in enumerate(B_GROUPS):
        sl = slice(g * B_GH, (g + 1) * B_GH)
        o, l, nb = _dilated_window_step(q[:, :, sl], k[:, :, sl], v[:, :, sl], bufs_in[g], win, dil)
        outs.append(o)
        lses.append(l)
        bufs.append(nb)
    return _merge_groups(outs, lses).astype(u.dtype), bufs


def _swiglu(h, w_in, w_out):
    gu = h @ w_in
    return (jax.nn.silu(gu[..., :D_FF]) * gu[..., D_FF:]) @ w_out


def setup_inputs(seed: int = 0) -> dict:
    key = jax.random.key(seed)
    ks = iter(jax.random.split(key, 64))
    f32 = jnp.float32

    def nrm(shape, scale=1.0):
        return jax.random.normal(next(ks), shape, f32) * scale

    def gain(shape):
        return 1.0 + nrm(shape, 0.02)

    rows = [min(w, PAST_LEN) for w, _ in B_GROUPS]
    return {
        'x_prompt': nrm((BATCH, SEQ, D_MODEL)),
        'x_sample': nrm((DEC_BATCH, DEC_SEQ, D_MODEL)),
        'state_wkv': nrm((N_A_LAYERS, DEC_BATCH, A_HEADS, A_HD, A_HD)),
        'state_shift': nrm((N_A_LAYERS, DEC_BATCH, 1, A_SHIFT_W)),
        'cache_swa_kv1': nrm((N_B_LAYERS, DEC_BATCH, rows[0], 2, B_GH, B_HD)),
        'cache_swa_kv2': nrm((N_B_LAYERS, DEC_BATCH, rows[1], 2, B_GH, B_HD)),
        'cache_swa_kv3': nrm((N_B_LAYERS, DEC_BATCH, rows[2], 2, B_GH, B_HD)),
        'cache_mem_kv': nrm((DEPTH, DEC_BATCH, N_MEM, 2, MEM_HEADS, MEM_HD)),
        'mem_prompt': nrm((BATCH, N_MEM, D_MODEL)),
        'norm_mix': gain((DEPTH, D_MODEL)),
        'norm_ffn': gain((DEPTH, D_MODEL)),
        'norm_mem': gain((DEPTH, D_MODEL)),
        'w_mem_kv': nrm((DEPTH, D_MODEL, 2 * MEM_W), D_MODEL ** -0.5),
        'q_norm_mem': gain((DEPTH, MEM_HD)),
        'k_norm_mem': gain((DEPTH, MEM_HD)),
        'w_in_a': nrm((N_A_LAYERS, D_MODEL, A_IN_W), D_MODEL ** -0.5),
        'w_out_a': nrm((N_A_LAYERS, A_OUT_W, D_MODEL), A_OUT_W ** -0.5),
        'mu_a': jax.random.uniform(next(ks), (N_A_LAYERS, A_SHIFT_W), f32),
        'w0_a': -2.0 + nrm((N_A_LAYERS, MIX_W), 0.5),
        'w2_a': nrm((N_A_LAYERS, DECAY_LORA, MIX_W), 0.1),
        'a0_a': nrm((N_A_LAYERS, MIX_W), 0.5),
        'a2_a': nrm((N_A_LAYERS, AAA_LORA, MIX_W), 0.1),
        'g2_a': nrm((N_A_LAYERS, GATE_LORA, MIX_W), GATE_LORA ** -0.5),
        'kk_a': 0.85 + nrm((N_A_LAYERS, MIX_W), 0.05),
        'ka_a': 1.0 + nrm((N_A_LAYERS, MIX_W), 0.05),
        'rk_a': nrm((N_A_LAYERS, A_HEADS, A_HD), 0.1),
        'lnx_g_a': gain((N_A_LAYERS, MIX_W)),
        'lnx_b_a': nrm((N_A_LAYERS, MIX_W), 0.02),
        'w_in_b': nrm((N_B_LAYERS, D_MODEL, B_IN_W), D_MODEL ** -0.5),
        'w_out_b': nrm((N_B_LAYERS, B_OUT_IN, D_MODEL), B_OUT_IN ** -0.5),
        'q_norm_b': gain((N_B_LAYERS, B_HD)),
        'k_norm_b': gain((N_B_LAYERS, B_HD)),
        'w_ffn_in': nrm((DEPTH, D_MODEL, 2 * D_FF), D_MODEL ** -0.5),
        'w_ffn_out': nrm((DEPTH, D_FF, D_MODEL), D_FF ** -0.5),
    }


def reference(x_prompt, x_sample, state_wkv, state_shift, cache_swa_kv1, cache_swa_kv2, cache_swa_kv3,
              cache_mem_kv, mem_prompt, norm_mix, norm_ffn, norm_mem, w_mem_kv, q_norm_mem, k_norm_mem,
              w_in_a, w_out_a, mu_a, w0_a, w2_a, a0_a, a2_a, g2_a, kk_a, ka_a, rk_a, lnx_g_a, lnx_b_a,
              w_in_b, w_out_b, q_norm_b, k_norm_b, w_ffn_in, w_ffn_out):
    yp, ys = x_prompt, x_sample
    bp = x_prompt.shape[0]
    swa_in = (cache_swa_kv1, cache_swa_kv2, cache_swa_kv3)
    wkv_p, shift_p, wkv_s, shift_s, mem_p = [], [], [], [], []
    swa_p = [[] for _ in B_GROUPS]
    swa_s = [[] for _ in B_GROUPS]
    for i in range(DEPTH):
        j = i // N_MIXERS
        mkv_p = _mem_kv(mem_prompt, norm_mem[i], w_mem_kv[i], k_norm_mem[i])
        mem_p.append(mkv_p)
        mkv_s = cache_mem_kv[i]
        hp = _rmsnorm(yp, norm_mix[i])
        hs_ = _rmsnorm(ys, norm_mix[i])
        if i % N_MIXERS == 0:
            up = hp @ w_in_a[j]
            us = hs_ @ w_in_a[j]
            prm = (mu_a[j], w0_a[j], w2_a[j], a0_a[j], a2_a[j], g2_a[j], kk_a[j], ka_a[j], rk_a[j], lnx_g_a[j], lnx_b_a[j])
            zero_row = jnp.zeros((bp, 1, A_SHIFT_W), up.dtype)
            zero_s = jnp.zeros((bp, A_HEADS, A_HD, A_HD), jnp.float32)
            mp, sp, lp = _rwkv7(up[..., :A_SHIFT_W], zero_row, zero_s, *prm)
            ms, ss, ls = _rwkv7(us[..., :A_SHIFT_W], state_shift[j], state_wkv[j], *prm)
            op = jnp.concatenate([mp, _mem_attend(up[..., A_SHIFT_W:], mkv_p, q_norm_mem[i])], axis=-1)
            os_ = jnp.concatenate([ms, _mem_attend(us[..., A_SHIFT_W:], mkv_s, q_norm_mem[i])], axis=-1)
            yp = yp + op @ w_out_a[j]
            ys = ys + os_ @ w_out_a[j]
            wkv_p.append(sp)
            shift_p.append(lp)
            wkv_s.append(ss)
            shift_s.append(ls)
        else:
            up = hp @ w_in_b[j]
            us = hs_ @ w_in_b[j]
            mp, bufs_p = _dswa_prompt(up, q_norm_b[j], k_norm_b[j])
            ms, bufs_s = _dswa_sample(us, q_norm_b[j], k_norm_b[j], [c[j] for c in swa_in])
            op = jnp.concatenate([mp, _mem_attend(up[..., 3 * MIX_W:], mkv_p, q_norm_mem[i])], axis=-1)
            os_ = jnp.concatenate([ms, _mem_attend(us[..., 3 * MIX_W:], mkv_s, q_norm_mem[i])], axis=-1)
            yp = yp + op @ w_out_b[j]
            ys = ys + os_ @ w_out_b[j]
            for g in range(len(B_GROUPS)):
                swa_p[g].append(bufs_p[g])
                swa_s[g].append(bufs_s[g])
        yp = yp + _swiglu(_rmsnorm(yp, norm_ffn[i]), w_ffn_in[i], w_ffn_out[i])
        ys = ys + _swiglu(_rmsnorm(ys, norm_ffn[i]), w_ffn_in[i], w_ffn_out[i])
    return (yp, ys,
            jnp.stack(wkv_p), jnp.stack(shift_p),
            jnp.stack(swa_p[0]), jnp.stack(swa_p[1]), jnp.stack(swa_p[2]),
            jnp.stack(mem_p),
            jnp.stack(wkv_s), jnp.stack(shift_s),
            jnp.stack(swa_s[0]), jnp.stack(swa_s[1]), jnp.stack(swa_s[2]))
```

```cpp
#include <hip/hip_runtime.h>
#include <cstdio>
#include <cstdint>
namespace pg8 {
#define PG8_LAS __attribute__((address_space(3)))
typedef unsigned short bf16_t;
typedef short bf16x8 __attribute__((ext_vector_type(8)));
typedef float f32x4 __attribute__((ext_vector_type(4)));
typedef unsigned u32x4 __attribute__((ext_vector_type(4)));
constexpr int BM = 256, BK = 64, HALF = 128, HTB = HALF * BK * 2  , STAGE_BYTES = 8 * HTB, NXCD = 8, WGM = 8;

__host__ __device__ __forceinline__ int lds_byte(int r, int c) { const int st = (r >> 4) * 2 + (c >> 5), rr = r & 15, cc = c & 31, ob = rr * 64 + cc * 2; return st * 1024 + (ob ^ (((ob >> 9) & 1) << 5)); }
__host__ __device__ __forceinline__ void stage_rc(int b, int& R, int& C) { const int st = b / 1024, sb = b % 1024, swz = sb ^ (((sb >> 9) & 1) << 5); R = (st >> 1) * 16 + swz / 64; C = (st & 1) * 32 + (swz % 64) / 2; }
__host__ __device__ __forceinline__ int perm32(int rho) { const int n = rho >> 4, i = rho & 15; return 8 * (i >> 2) + 4 * n + (i & 3); }

struct Unit { int pm, pn; };
struct Gemm { const bf16_t* A; const bf16_t* Bt; int M, N, K; };

struct StaticOrder {
    int nM, nN, nwg, G, c;
    __host__ __device__ void init(int M, int N, int G_, int c_) { nM = M / BM; nN = N / BM; nwg = nM * nN; G = G_; c = c_; }
    __host__ __device__ bool next(int i, Unit& u) const {
        const long L = (long)i * G + c; if (L >= nwg) return false;
        int wgid = (int)L; { const int q = nwg / NXCD, r = nwg % NXCD, xcd = wgid % NXCD, off = wgid / NXCD; wgid = (xcd < r ? xcd * (q + 1) : r * (q + 1) + (xcd - r) * q) + off; }
        const int nig = WGM * nN, gid = wgid / nig, fm = gid * WGM, gsz = (nM - fm) < WGM ? (nM - fm) : WGM;
        u.pm = fm + ((wgid % nig) % gsz); u.pn = (wgid % nig) / gsz; return true;
    }
    __device__ __forceinline__ void a_ready(const Unit&) const {}
    __device__ __forceinline__ void done(const Unit&) const {}
};

__device__ __forceinline__ unsigned cvt_pk_bf16(float lo, float hi) { unsigned r; asm volatile("v_cvt_pk_bf16_f32 %0, %1, %2" : "=v"(r) : "v"(lo), "v"(hi)); return r; }
typedef float f32x2 __attribute__((ext_vector_type(2)));
template <int RS> struct RowScale {
    const float* p;
    __device__ __forceinline__ float get(int row, int fq) const {
        if constexpr (RS == 0) { return 1.f; }
        else if constexpr (RS == 1) { return p[row]; }
        else {
            const f32x4* q = (const f32x4*)(p + (size_t)row * 64 + fq * 16);
            const f32x4 a = q[0], b = q[1], c = q[2], d = q[3];
            float s = ((a[0] + a[1]) + (a[2] + a[3])) + ((b[0] + b[1]) + (b[2] + b[3])) + ((c[0] + c[1]) + (c[2] + c[3])) + ((d[0] + d[1]) + (d[2] + d[3]));
            s += __shfl_xor(s, 16); s += __shfl_xor(s, 32);
            return 1.0f / sqrtf(s * (1.0f / 4096.0f) + 1e-6f);
        }
    }
};
template <int RS> struct EpiB16 {
    static constexpr bool PERM = true, AFTER_DRAIN = false;
    bf16_t* O; int ldc; RowScale<RS> rs;
    __device__ __forceinline__ void operator()(const f32x4 (&acc)[2][2][4][2], const Unit& u, int wr, int wc, int fr, int fq) const {
        const int row0 = u.pm * BM + wr * 64 + fr, col0 = u.pn * BM + wc * 32 + 8 * fq;
#pragma unroll
        for (int ai = 0; ai < 2; ++ai)
#pragma unroll
            for (int m = 0; m < 4; ++m) { const int row = row0 + ai * HALF + m * 16; const float sc = rs.get(row, fq); bf16_t* rowp = O + (size_t)row * ldc + col0;
#pragma unroll
                for (int bj = 0; bj < 2; ++bj) { const f32x4 v0 = acc[ai][bj][m][0] * sc, v1 = acc[ai][bj][m][1] * sc;
                    u32x4 w; w.x = cvt_pk_bf16(v0[0], v0[1]); w.y = cvt_pk_bf16(v0[2], v0[3]); w.z = cvt_pk_bf16(v1[0], v1[1]); w.w = cvt_pk_bf16(v1[2], v1[3]);
                    *(u32x4*)(rowp + bj * HALF) = w; } }
    }
};
__device__ __forceinline__ float silu_mul(float g, float u) { return g * u * __builtin_amdgcn_rcpf(1.0f + __builtin_amdgcn_exp2f(-1.44269504089f * g)); }
struct EpiSwiGLU {
    static constexpr bool PERM = true, AFTER_DRAIN = false;
    bf16_t* O; int ldc; RowScale<2> rs;
    __device__ __forceinline__ void operator()(const f32x4 (&acc)[2][2][4][2], const Unit& u, int wr, int wc, int fr, int fq) const {
        const int row0 = u.pm * BM + wr * 64 + fr, col0 = u.pn * HALF + wc * 32 + 8 * fq;
#pragma unroll
        for (int ai = 0; ai < 2; ++ai)
#pragma unroll
            for (int m = 0; m < 4; ++m) { const int row = row0 + ai * HALF + m * 16; const float sc = rs.get(row, fq);
                const f32x4 g0 = acc[ai][0][m][0] * sc, g1 = acc[ai][0][m][1] * sc, u0 = acc[ai][1][m][0] * sc, u1 = acc[ai][1][m][1] * sc;
                u32x4 w; w.x = cvt_pk_bf16(silu_mul(g0[0], u0[0]), silu_mul(g0[1], u0[1])); w.y = cvt_pk_bf16(silu_mul(g0[2], u0[2]), silu_mul(g0[3], u0[3]));
                w.z = cvt_pk_bf16(silu_mul(g1[0], u1[0]), silu_mul(g1[1], u1[1])); w.w = cvt_pk_bf16(silu_mul(g1[2], u1[2]), silu_mul(g1[3], u1[3]));
                *(u32x4*)(O + (size_t)row * ldc + col0) = w; }
    }
};
struct EpiF32 {
    static constexpr bool PERM = false, AFTER_DRAIN = false;
    float* C; int ldc; RowScale<1> rs;
    __device__ __forceinline__ void operator()(const f32x4 (&acc)[2][2][4][2], const Unit& u, int wr, int wc, int fr, int fq) const {
        const int row0 = u.pm * BM + wr * 64 + fr, col0 = u.pn * BM + wc * 32 + 4 * fq;
#pragma unroll
        for (int ai = 0; ai < 2; ++ai)
#pragma unroll
            for (int m = 0; m < 4; ++m) { const int row = row0 + ai * HALF + m * 16; const float sc = rs.get(row, fq); float* rowp = C + (size_t)row * ldc + col0;
#pragma unroll
                for (int bj = 0; bj < 2; ++bj)
#pragma unroll
                    for (int n = 0; n < 2; ++n) *(f32x4*)(rowp + bj * HALF + n * 16) = acc[ai][bj][m][n] * sc; }
    }
};
__device__ __forceinline__ float decay_fn(float x) {
    const float z = -x, e = __builtin_amdgcn_exp2f(-1.44269504089f * fabsf(z));
    const float sp = fmaxf(z, 0.f) + 0.69314718056f * __builtin_amdgcn_logf(1.0f + e);
    return __builtin_amdgcn_exp2f(-1.44269504089f * __builtin_amdgcn_exp2f(-1.44269504089f * (sp + 0.5f)));
}
template <int MODE> struct EpiScanSlot {
    static constexpr bool PERM = false, AFTER_DRAIN = false;
    float* bufP; float* bufS; const float* bias; int slot; int mrows;
    __device__ __forceinline__ float fn(float x) const { if constexpr (MODE == 0) return decay_fn(x); else return __builtin_amdgcn_rcpf(1.0f + __builtin_amdgcn_exp2f(-1.44269504089f * x)); }
    __device__ __forceinline__ void operator()(const f32x4 (&acc)[2][2][4][2], const Unit& u, int wr, int wc, int fr, int fq) const {
        const int col0 = u.pn * BM + wc * 32 + 4 * fq;
        if (u.pm < 32) {
            const int t0 = (u.pm & 7) * 256 + wr * 64 + fr; float* b0 = bufP + (size_t)(u.pm >> 3) * 48 * 2048 * 384 + (size_t)slot * 64;
#pragma unroll
            for (int bj = 0; bj < 2; ++bj)
#pragma unroll
                for (int n = 0; n < 2; ++n) { const int c = col0 + bj * HALF + n * 16; const f32x4 bv = *(const f32x4*)(bias + c); float* bc = b0 + ((size_t)(c >> 6) * 2048 + t0) * 384 + (c & 63);
#pragma unroll
                    for (int ai = 0; ai < 2; ++ai)
#pragma unroll
                        for (int m = 0; m < 4; ++m) { const f32x4 x = acc[ai][bj][m][n] + bv; f32x4 o; o[0] = fn(x[0]); o[1] = fn(x[1]); o[2] = fn(x[2]); o[3] = fn(x[3]);
                            *(f32x4*)(bc + (size_t)(ai * HALF + m * 16) * 384) = o; }
                    asm volatile("" ::: "memory"); }
        } else if (wr == 0) {
#pragma unroll
            for (int bj = 0; bj < 2; ++bj)
#pragma unroll
                for (int n = 0; n < 2; ++n) { const int c = col0 + bj * HALF + n * 16; const f32x4 bv = *(const f32x4*)(bias + c);
#pragma unroll
                    for (int m = 0; m < 4; ++m) { const int lr = m * 16 + fr; const f32x4 x = acc[0][bj][m][n] + bv; f32x4 o; o[0] = fn(x[0]); o[1] = fn(x[1]); o[2] = fn(x[2]); o[3] = fn(x[3]);
                        *(f32x4*)(bufS + (((size_t)((lr >> 3) * 48 + (c >> 6)) * 8 + (lr & 7)) * 6 + slot) * 64 + (c & 63)) = o; }
                    asm volatile("" ::: "memory"); }
        }
    }
};
struct EpiRes {
    static constexpr bool PERM = false, AFTER_DRAIN = false;
    const float* baseP; const float* baseS; float* Y; bf16_t* XA; float* SS; int ldc; int mrows;
    __device__ __forceinline__ void operator()(const f32x4 (&acc)[2][2][4][2], const Unit& u, int wr, int wc, int fr, int fq) const {
        typedef unsigned u32x2v __attribute__((ext_vector_type(2)));
        const int row0 = u.pm * BM + wr * 64 + fr, col0 = u.pn * BM + wc * 32 + 4 * fq;
#pragma unroll
        for (int ai = 0; ai < 2; ++ai)
#pragma unroll
            for (int m = 0; m < 4; ++m) { const int row = row0 + ai * HALF + m * 16; const bool ok = row < mrows; const int rr = ok ? row : 0;
                const float* bp = (rr < 8192 ? baseP + (size_t)rr * ldc : baseS + (size_t)(rr - 8192) * ldc) + col0; float q = 0.f;
#pragma unroll
                for (int bj = 0; bj < 2; ++bj)
#pragma unroll
                    for (int n = 0; n < 2; ++n) { const f32x4 y = *(const f32x4*)(bp + bj * HALF + n * 16) + acc[ai][bj][m][n];
                        q += (y[0] * y[0] + y[1] * y[1]) + (y[2] * y[2] + y[3] * y[3]);
                        if (ok) { *(f32x4*)(Y + (size_t)row * ldc + col0 + bj * HALF + n * 16) = y; u32x2v w; w.x = cvt_pk_bf16(y[0], y[1]); w.y = cvt_pk_bf16(y[2], y[3]);
                            *(u32x2v*)(XA + (size_t)row * ldc + col0 + bj * HALF + n * 16) = w; } }
                q += __shfl_xor(q, 16); q += __shfl_xor(q, 32);
                if (ok && fq == 0) SS[(size_t)row * 64 + u.pn * 4 + wc] = q; }
    }
};
template <class Epi, class Sched, bool ALIGN_EPI = false, bool SP2 = false>
__device__ __forceinline__ void gemm_phase(PG8_LAS unsigned char* lds, const Gemm g, const Sched& S, const Epi& E) {
    int tid = threadIdx.x; asm volatile("" : "+v"(tid));
    const int wid = __builtin_amdgcn_readfirstlane(tid >> 6), lane = tid & 63, wr = wid >> 2, wc = wid & 3, fr = lane & 15, fq = lane >> 4;
    int K = g.K; asm volatile("" : "+s"(K));
    const int nt = K / BK;
    unsigned voffA[2], voffB[2];
#pragma unroll
    for (int i = 0; i < 2; ++i) { int R, C; stage_rc(tid * 16 + i * 8192, R, C); const int Rb = Epi::PERM ? ((R & ~31) + perm32(R & 31)) : R;
        voffA[i] = (unsigned)(R * K + C) * 2u; voffB[i] = (unsigned)(Rb * K + C) * 2u; }
    const size_t kstep = (size_t)(BK * 2);
    const size_t hstep = (size_t)HALF * K * 2;
    const size_t tstep = 2 * hstep;
    const unsigned ldsw = (unsigned)wid * 1024u;
    const int aoff = lds_byte(wr * 64 + fr, fq * 8), boff = lds_byte(wc * 32 + fr, fq * 8);
#define PG8_SA(b, h) (((b) * 2 + (h)) * HTB)
#define PG8_SB(b, h) ((4 + (b) * 2 + (h)) * HTB)
#define PG8_STAGE(bufoff, gbase, voff) do { _Pragma("unroll") for (int _i = 0; _i < 2; ++_i) \
        __builtin_amdgcn_global_load_lds((const unsigned*)((const char*)(gbase) + (voff)[_i]), (PG8_LAS unsigned*)(lds + (bufoff) + ldsw + _i * 8192), 16, 0, 0); } while (0)
#define PG8_LDA(dst, b, h) do { _Pragma("unroll") for (int m = 0; m < 4; ++m) _Pragma("unroll") for (int k = 0; k < 2; ++k) dst[m][k] = *(const PG8_LAS bf16x8*)(lds + PG8_SA(b, h) + aoff + m * 2048 + k * 1024); } while (0)
#define PG8_LDB(dst, b, h) do { _Pragma("unroll") for (int n = 0; n < 2; ++n) _Pragma("unroll") for (int k = 0; k < 2; ++k) dst[n][k] = *(const PG8_LAS bf16x8*)(lds + PG8_SB(b, h) + boff + n * 2048 + k * 1024); } while (0)
#define PG8_MMA(ai, bj, At, Bt) do { __builtin_amdgcn_s_setprio(1); _Pragma("unroll") for (int m = 0; m < 4; ++m) _Pragma("unroll") for (int n = 0; n < 2; ++n) _Pragma("unroll") for (int k = 0; k < 2; ++k) \
        acc[ai][bj][m][n] = __builtin_amdgcn_mfma_f32_16x16x32_bf16(Bt[n][k], At[m][k], acc[ai][bj][m][n], 0, 0, 0); __builtin_amdgcn_s_setprio(0); } while (0)
#define PG8_WAIT_V(n) asm volatile("s_waitcnt vmcnt(" #n ")" ::: "memory")
#define PG8_WAIT_L(n) asm volatile("s_waitcnt lgkmcnt(" #n ")" ::: "memory")
#define PG8_BAR __builtin_amdgcn_s_barrier()
#define PG8_SCHED __builtin_amdgcn_sched_barrier(0)
    Unit cur, nxt; int ui = 0;
    if (!S.next(0, cur)) return;
    f32x4 acc[2][2][4][2];
#pragma unroll
    for (int a = 0; a < 2; ++a)
#pragma unroll
        for (int b = 0; b < 2; ++b)
#pragma unroll
            for (int m = 0; m < 4; ++m)
#pragma unroll
                for (int n = 0; n < 2; ++n) acc[a][b][m][n] = (f32x4){0.f, 0.f, 0.f, 0.f};
    bf16x8 At[4][2], B0[2][2], B1[2][2];
    const char* cA = (const char*)g.A + (size_t)cur.pm * tstep; const char* cB = (const char*)g.Bt + (size_t)cur.pn * tstep;
    S.a_ready(cur);
    if constexpr (SP2) {
        PG8_STAGE(PG8_SB(0, 0), cB, voffB); PG8_STAGE(PG8_SB(0, 1), cB + hstep, voffB); PG8_STAGE(PG8_SA(0, 0), cA, voffA); PG8_STAGE(PG8_SA(0, 1), cA + hstep, voffA);
        if (wr == 1) PG8_BAR;
        PG8_WAIT_V(2); PG8_BAR;
        PG8_STAGE(PG8_SB(1, 0), cB + kstep, voffB); PG8_STAGE(PG8_SA(1, 0), cA + kstep, voffA); PG8_STAGE(PG8_SB(1, 1), cB + hstep + kstep, voffB);
        PG8_WAIT_V(6); PG8_BAR;
    } else {
        PG8_STAGE(PG8_SB(0, 0), cB, voffB); PG8_STAGE(PG8_SA(0, 0), cA, voffA); PG8_STAGE(PG8_SB(0, 1), cB + hstep, voffB); PG8_STAGE(PG8_SA(0, 1), cA + hstep, voffA);
        if (wr == 1) PG8_BAR;
        PG8_WAIT_V(4); PG8_BAR;
        PG8_STAGE(PG8_SB(1, 0), cB + kstep, voffB); PG8_STAGE(PG8_SA(1, 0), cA + kstep, voffA); PG8_STAGE(PG8_SB(1, 1), cB + hstep + kstep, voffB);
        PG8_WAIT_V(6); PG8_BAR;
    }
    for (;;) {
        const bool has_next = S.next(ui + 1, nxt);
        const char* nA = has_next ? (const char*)g.A + (size_t)nxt.pm * tstep : cA; const char* nB = has_next ? (const char*)g.Bt + (size_t)nxt.pn * tstep : cB;
        for (int t = 0; t < nt; t += 2) {
            const bool last = (t == nt - 2);
            const char* a1 = cA + (size_t)(t + 1) * kstep;
            const char* a2 = last ? nA : cA + (size_t)(t + 2) * kstep; const char* b2 = last ? nB : cB + (size_t)(t + 2) * kstep;
            const char* a3 = a2 + kstep; const char* b3 = b2 + kstep;
            if (last && has_next) S.a_ready(nxt);
            if constexpr (SP2) {
            PG8_LDB(B0, 0, 0); PG8_LDB(B1, 0, 1); PG8_SCHED; PG8_LDA(At, 0, 0); PG8_STAGE(PG8_SA(1, 1), a1 + hstep, voffA);
            PG8_WAIT_V(8); PG8_WAIT_L(0); PG8_BAR; PG8_MMA(0, 0, At, B0); PG8_MMA(0, 1, At, B1); PG8_BAR; PG8_SCHED;
            PG8_LDA(At, 0, 1); PG8_STAGE(PG8_SB(0, 0), b2, voffB); PG8_STAGE(PG8_SB(0, 1), b2 + hstep, voffB); PG8_STAGE(PG8_SA(0, 0), a2, voffA);
            PG8_WAIT_V(8); PG8_WAIT_L(0); PG8_BAR; PG8_MMA(1, 0, At, B0); PG8_MMA(1, 1, At, B1); PG8_BAR; PG8_SCHED;
            PG8_LDB(B0, 1, 0); PG8_LDB(B1, 1, 1); PG8_SCHED; PG8_LDA(At, 1, 0); PG8_STAGE(PG8_SA(0, 1), a2 + hstep, voffA);
            PG8_WAIT_V(8); PG8_WAIT_L(0); PG8_BAR; PG8_MMA(0, 0, At, B0); PG8_MMA(0, 1, At, B1); PG8_BAR; PG8_SCHED;
            PG8_LDA(At, 1, 1); PG8_STAGE(PG8_SB(1, 0), b3, voffB); PG8_STAGE(PG8_SB(1, 1), b3 + hstep, voffB); PG8_STAGE(PG8_SA(1, 0), a3, voffA);
            PG8_WAIT_V(8); PG8_WAIT_L(0); PG8_BAR; PG8_MMA(1, 0, At, B0); PG8_MMA(1, 1, At, B1); PG8_BAR; PG8_SCHED;
            } else {
            PG8_LDB(B0, 0, 0); PG8_SCHED; PG8_LDA(At, 0, 0); PG8_STAGE(PG8_SA(1, 1), a1 + hstep, voffA);
            PG8_WAIT_L(8); PG8_BAR; PG8_WAIT_L(0); PG8_MMA(0, 0, At, B0); PG8_BAR; PG8_SCHED;
            PG8_LDB(B1, 0, 1); PG8_STAGE(PG8_SB(0, 0), b2, voffB);
            PG8_BAR; PG8_WAIT_L(0); PG8_MMA(0, 1, At, B1); PG8_BAR;
            PG8_LDA(At, 0, 1); PG8_STAGE(PG8_SA(0, 0), a2, voffA);
            PG8_BAR; PG8_WAIT_L(0); PG8_MMA(1, 0, At, B0); PG8_BAR; PG8_SCHED;
            PG8_STAGE(PG8_SB(0, 1), b2 + hstep, voffB);
            PG8_WAIT_V(6); PG8_BAR; PG8_MMA(1, 1, At, B1); PG8_BAR;
            PG8_LDB(B0, 1, 0); PG8_SCHED; PG8_LDA(At, 1, 0); PG8_STAGE(PG8_SA(0, 1), a2 + hstep, voffA);
            PG8_WAIT_L(8); PG8_BAR; PG8_WAIT_L(0); PG8_MMA(0, 0, At, B0); PG8_BAR; PG8_SCHED;
            PG8_LDB(B1, 1, 1); PG8_STAGE(PG8_SB(1, 0), b3, voffB);
            PG8_BAR; PG8_WAIT_L(0); PG8_MMA(0, 1, At, B1); PG8_BAR;
            PG8_LDA(At, 1, 1); PG8_STAGE(PG8_SA(1, 0), a3, voffA);
            PG8_BAR; PG8_WAIT_L(0); PG8_MMA(1, 0, At, B0); PG8_BAR; PG8_SCHED;
            PG8_STAGE(PG8_SB(1, 1), b3 + hstep, voffB);
            PG8_WAIT_V(6); PG8_BAR; PG8_MMA(1, 1, At, B1); PG8_BAR;
            }
        }
        if constexpr (ALIGN_EPI) { if (wr == 0) PG8_BAR; }
        if constexpr (!Epi::AFTER_DRAIN) { E(acc, cur, wr, wc, fr, fq); S.done(cur); }
        if (!has_next) break;
#pragma unroll
        for (int a = 0; a < 2; ++a)
#pragma unroll
            for (int b = 0; b < 2; ++b)
#pragma unroll
                for (int m = 0; m < 4; ++m)
#pragma unroll
                    for (int n = 0; n < 2; ++n) acc[a][b][m][n] = (f32x4){0.f, 0.f, 0.f, 0.f};
        cur = nxt; cA = nA; cB = nB; ++ui;
        if constexpr (ALIGN_EPI) { if (wr == 1) PG8_BAR; }
    }
    PG8_WAIT_V(0);
    if constexpr (!ALIGN_EPI) { if (wr == 0) PG8_BAR; }
    PG8_BAR;
    if constexpr (Epi::AFTER_DRAIN) { E.fused(acc, cur, wr, wc, fr, fq, lds, wid, lane); S.done(cur); }
#undef PG8_SA
#undef PG8_SB
#undef PG8_STAGE
#undef PG8_LDA
#undef PG8_LDB
#undef PG8_MMA
#undef PG8_WAIT_V
#undef PG8_WAIT_L
#undef PG8_BAR
#undef PG8_SCHED
}
}
#define GAS __attribute__((address_space(1)))
#define LAS __attribute__((address_space(3)))
typedef unsigned short bf16;
typedef unsigned v4u __attribute__((ext_vector_type(4)));
typedef float f32x4 __attribute__((ext_vector_type(4)));
typedef short bf16x8 __attribute__((ext_vector_type(8)));
typedef GAS unsigned gu32;
typedef GAS unsigned long long gu64;
#define RLX_AGENT __ATOMIC_RELAXED, __HIP_MEMORY_SCOPE_AGENT
#define LDS_WAIT() asm volatile("s_waitcnt lgkmcnt(0)" ::: "memory")
#define VM_WAIT() asm volatile("s_waitcnt vmcnt(0)" ::: "memory")
__device__ __forceinline__ unsigned long long rt() { return __builtin_amdgcn_s_memrealtime(); }
__device__ __forceinline__ unsigned f2bf(float f) { unsigned u = __builtin_bit_cast(unsigned, f); return (u + 0x7fffu + ((u >> 16) & 1u)) >> 16; }
__device__ __forceinline__ unsigned pk2(float lo, float hi) { return f2bf(lo) | (f2bf(hi) << 16); }

#define XB_TMO      128
#define XB_XCNT(j)  (256  + 64 * (j))
#define XB_XSUB(j)  (1280 + 64 * (j))
#define XB_XGEN(j)  (2304 + 64 * (j))
#define XB_TOP      3328
#define XB_TOPGEN   3392
#define XCD_BAR_WORDS 3456
#define XB_SPIN_CAP (1u << 18)

__device__ __forceinline__ unsigned xb_ld(unsigned* p)              { return __hip_atomic_load(p, __ATOMIC_RELAXED, __HIP_MEMORY_SCOPE_AGENT); }
__device__ __forceinline__ unsigned xb_add(unsigned* p, unsigned v) { return __hip_atomic_fetch_add(p, v, __ATOMIC_RELAXED, __HIP_MEMORY_SCOPE_AGENT); }
__device__ __forceinline__ unsigned xb_xcc_id() { return (unsigned)__builtin_amdgcn_s_getreg((3 << 11) | 20) & 0xFu; }
#define XB_SPIN(cond, bar) do { unsigned _sp = 0; while (cond) { __builtin_amdgcn_s_sleep(1); \
    if ((++_sp & 255u) == 0u) { if (xb_ld(&(bar)[XB_TMO])) break; if (_sp > XB_SPIN_CAP) { atomicAdd(&(bar)[XB_TMO], 1u); break; } } } } while (0)

struct XcdBarrier {
    unsigned* bar; unsigned x;
    volatile LAS unsigned* st;
};

__device__ __forceinline__ XcdBarrier xcd_barrier_post(unsigned* bar, volatile LAS unsigned* st) {
    XcdBarrier b; b.bar = bar; b.x = xb_xcc_id(); b.st = st;
    if (threadIdx.x == 0) (void)xb_add(&bar[XB_XCNT(b.x)], 1u);
    return b;
}
__device__ __forceinline__ void xcd_barrier_complete(unsigned* bar, unsigned x, unsigned& nloc, unsigned& nx) {
    const unsigned G = gridDim.x * gridDim.y * gridDim.z;
    unsigned sum, cnt, mine, sp = 0u;
    for (;;) {
        sum = 0u; cnt = 0u; mine = 0u;
#pragma unroll
        for (unsigned j = 0; j < 16; ++j) { const unsigned c = xb_ld(&bar[XB_XCNT(j)]); sum += c; cnt += (c > 0u) ? 1u : 0u; mine = (j == x) ? c : mine; }
        if (sum == G) break;
        __builtin_amdgcn_s_sleep(1);
        if ((++sp & 255u) == 0u) { if (xb_ld(&bar[XB_TMO])) break; if (sp > XB_SPIN_CAP) { atomicAdd(&bar[XB_TMO], 1u); break; } }
    }
    nloc = mine > 0u ? mine : 1u; nx = cnt > 0u ? cnt : 1u;
}

__device__ __forceinline__ void xcd_barrier(const XcdBarrier& b) {
    asm volatile("s_waitcnt vmcnt(0)" ::: "memory");
    __syncthreads();
    if (threadIdx.x == 0) {
        unsigned* bar = b.bar;
        __builtin_amdgcn_s_waitcnt(0);
        unsigned nloc = b.st[0], nx = b.st[1];
        if (nloc == 0u) { xcd_barrier_complete(bar, b.x, nloc, nx); b.st[0] = nloc; b.st[1] = nx; }
        const unsigned old = xb_add(&bar[XB_XSUB(b.x)], 1u);
        const unsigned gen = old / nloc;
        if (old + 1u == (gen + 1u) * nloc) {
            __builtin_amdgcn_fence(__ATOMIC_RELEASE, "agent");
            asm volatile("s_waitcnt vmcnt(0)" ::: "memory");
            const unsigned og = xb_add(&bar[XB_TOP], 1u);
            const unsigned tg = og / nx;
            if (og + 1u == (tg + 1u) * nx) xb_add(&bar[XB_TOPGEN], 1u);
            else XB_SPIN(xb_ld(&bar[XB_TOPGEN]) == tg, bar);
            __builtin_amdgcn_fence(__ATOMIC_ACQUIRE, "agent");
            xb_add(&bar[XB_XGEN(b.x)], 1u);
            asm volatile("s_waitcnt vmcnt(0)" ::: "memory");
        } else {
            XB_SPIN(xb_ld(&bar[XB_XGEN(b.x)]) == gen, bar);
            __builtin_amdgcn_fence(__ATOMIC_ACQUIRE, "agent");
            asm volatile("s_waitcnt vmcnt(0)" ::: "memory");
        }
    }
    __syncthreads();
}
constexpr int NWAVES = 8;
constexpr int D = 4096, MP = 8192, MS = 64, M = MP + MS, MPAD = 8448;
constexpr int SEQ = 2048, DSEQ = 8, NBP = 4, NBS = 8;
constexpr int MIXW = 3072, ASW = 9792, AINW = 10816, NA = 11008;
constexpr int NB = 10240, DFF = 11008, NFI = 22016;
constexpr int NMEM = 256, MEMW = 1024, AH = 48;
constexpr float RMS_EPS = 1e-6f, LNX_EPS = 64e-5f;
constexpr float LOG2E = 1.44269504089f, LN2 = 0.69314718056f;

constexpr size_t MiB = 1u << 20;
constexpr size_t WS_CTL = 0, CTL_ZERO_BYTES = 1 * MiB;
constexpr size_t WS_WMEM = 1 * MiB;
constexpr size_t WS_WINA = WS_WMEM + 32 * MiB;
constexpr size_t WS_WOUTA = WS_WINA + 86 * MiB;
constexpr size_t WS_WINB = WS_WOUTA + 32 * MiB;
constexpr size_t WS_WOUTB = WS_WINB + 80 * MiB;
constexpr size_t WS_WFI = WS_WOUTB + 16 * MiB;
constexpr size_t WS_WFO = WS_WFI + 344 * MiB;
constexpr size_t WS_W2 = WS_WFO + 172 * MiB;
constexpr size_t WS_A2 = WS_W2 + 2 * MiB;
constexpr size_t WS_G2 = WS_A2 + 2 * MiB;
constexpr size_t WS_XA = WS_G2 + 3 * MiB;
constexpr size_t WS_XM = WS_XA + 66 * MiB;
constexpr size_t WS_RSTDM = WS_XM + 8 * MiB;
constexpr size_t WS_SS = WS_RSTDM + 1 * MiB;
constexpr size_t SS_STRIDE = 3 * MiB;
constexpr size_t WS_U = WS_SS + 15 * MiB;
constexpr size_t WS_HID = WS_U + 178 * MiB;
constexpr size_t WS_O = WS_HID + 178 * MiB;
constexpr size_t WS_XLW = WS_O + 66 * MiB;
constexpr size_t WS_XLA = WS_XLW + 5 * MiB;
constexpr size_t WS_XLG = WS_XLA + 5 * MiB;
constexpr size_t WS_G = WS_XLG + 7 * MiB;
constexpr size_t WS_SCANP = WS_G + 50 * MiB;
constexpr size_t WS_SCANS = WS_SCANP + 576 * MiB;
constexpr size_t WS_MEMRAW = WS_SCANS + 5 * MiB;
constexpr size_t WS_KP = WS_MEMRAW + 16 * MiB;
constexpr size_t WS_VTP = WS_KP + 4 * MiB;
constexpr size_t WS_KS = WS_VTP + 4 * MiB;
constexpr size_t WS_VTS = WS_KS + 8 * MiB;
constexpr size_t WS_QN = WS_VTS + 8 * MiB;
constexpr size_t WS_KN = WS_QN + 48 * MiB;
constexpr size_t WS_VT = WS_KN + 48 * MiB;
constexpr size_t WS_OG = WS_VT + 48 * MiB;
constexpr size_t WS_LSE = WS_OG + 48 * MiB;
constexpr size_t WS_QS = WS_LSE + 1 * MiB;
constexpr size_t WS_END = WS_QS + 1 * MiB;
constexpr int CW_BAR = 4096;

constexpr size_t OUT_Y = 0;
constexpr size_t OUT_WKVP = (size_t)M * D;
constexpr size_t OUT_SHIFTP = OUT_WKVP + 4 * 48 * 4096;
constexpr size_t OUT_SWAP1 = OUT_SHIFTP + 4 * ASW;
constexpr size_t OUT_SWAP2 = OUT_SWAP1 + (size_t)4 * 128 * 2048;
constexpr size_t OUT_SWAP3 = OUT_SWAP2 + (size_t)4 * 512 * 2048;
constexpr size_t OUT_MEMKV = OUT_SWAP3 + (size_t)4 * 2048 * 2048;
constexpr size_t OUT_WKVS = OUT_MEMKV + (size_t)2 * 1024 * 2048;
constexpr size_t OUT_SHIFTS = OUT_WKVS + 8 * 48 * 4096;
constexpr size_t OUT_SWAS1 = OUT_SHIFTS + 8 * ASW;
constexpr size_t OUT_SWAS2 = OUT_SWAS1 + (size_t)8 * 128 * 2048;
constexpr size_t OUT_SWAS3 = OUT_SWAS2 + (size_t)8 * 512 * 2048;
constexpr size_t OUT_END = OUT_SWAS3 + (size_t)8 * 2048 * 2048;

constexpr int RING_OFF = 0, RING_BYTES = 131072;
constexpr int LDSCTL_OFF = RING_BYTES, MISC_OFF = LDSCTL_OFF + 320;
constexpr int LDS_BYTES = 147456;

enum { I_XP = 0, I_XS, I_SWKV, I_SSHIFT, I_C1, I_C2, I_C3, I_CMEM, I_MEM, I_NMIX, I_NFFN, I_NMEM, I_WMEM, I_QNM, I_KNM,
       I_WINA, I_WOUTA, I_MU, I_W0, I_W2, I_A0, I_A2, I_G2, I_KK, I_KA, I_RK, I_LNG, I_LNB, I_WINB, I_WOUTB, I_QNB, I_KNB, I_WFI, I_WFO, N_IN };

struct Args { const float* in[N_IN]; float* out; unsigned char* ws; int ph_lo, ph_hi; };
struct Frame {
    LAS unsigned char* lds;
    volatile LAS unsigned* MISC;
    gu32* ctl;
    int tid, lane, wave;
    int vcu, G;
    int gw, NGW;
    const struct Args* a;
    float* out; unsigned char* ws;
};
#define WSP(T, off) ((T*)(F.ws + (off)))
__device__ __forceinline__ int opaque_v(int x) { asm volatile("" : "+v"(x)); return x; }
__device__ __forceinline__ int opaque_s(int x) { asm volatile("" : "+s"(x)); return x; }
#define PHASE_LOCAL(F) do { F.lane = opaque_v(F.lane); F.gw = opaque_s(F.gw); } while (0)

__device__ __forceinline__ float wave_sum(float v) {
#pragma unroll
    for (int o = 1; o < 64; o <<= 1) v += __shfl_xor(v, o);
    return v;
}
__device__ __forceinline__ float wave_max(float v) {
#pragma unroll
    for (int o = 1; o < 64; o <<= 1) v = fmaxf(v, __shfl_xor(v, o));
    return v;
}
typedef float f32x2 __attribute__((ext_vector_type(2)));
__device__ __forceinline__ float bf2f(unsigned short b) { return __builtin_bit_cast(float, (unsigned)b << 16); }

__device__ __forceinline__ void tr_item(const float* W, int Ksrc, int ldw, bf16* WT, int Kdst, int drow, const float* gain, LAS float* scr, int k0, int n0, int lane) {
#pragma unroll 8
    for (int i = 0; i < 32; ++i) { const int kk = 2 * i + (lane >> 5), k = k0 + kk; float v = 0.f;
        if (k < Ksrc) { v = W[(size_t)k * ldw + n0 + (lane & 31)]; if (gain) v *= gain[k]; }
        scr[kk * 33 + (lane & 31)] = v; }
    LDS_WAIT(); asm volatile("" ::: "memory");
    const int c = lane & 7;
#pragma unroll
    for (int j = 0; j < 4; ++j) { const int n = (lane >> 3) + 8 * j; const LAS float* s = scr + (8 * c) * 33 + n;
        v4u o; o.x = pk2(s[0 * 33], s[1 * 33]); o.y = pk2(s[2 * 33], s[3 * 33]); o.z = pk2(s[4 * 33], s[5 * 33]); o.w = pk2(s[6 * 33], s[7 * 33]);
        *(GAS v4u*)(WT + (size_t)(drow + n) * Kdst + k0 + 8 * c) = o; }
    LDS_WAIT(); asm volatile("" ::: "memory");
}
template <int MAP> __device__ __forceinline__ void tr_matrix(Frame& F, LAS float* scr, const float* W, int Ksrc, int N, bf16* WT, int Kdst, const float* gain, int& rot) {
    const int nblk = N / 32, items = (Kdst / 64) * nblk;
    int start = F.gw - rot; if (start < 0) start += F.NGW;
    for (int it = start; it < items; it += F.NGW) {
        const int kb = it / nblk, nb = it % nblk, n0 = 32 * nb; int drow = n0;
        if (MAP == 1) { const int up = n0 >= DFF, j = n0 - up * DFF; drow = 256 * (j >> 7) + 128 * up + (j & 127); }
        tr_item(W, Ksrc, N, WT, Kdst, drow, gain, scr, 64 * kb, n0, F.lane);
    }
    rot = (rot + items) % F.NGW;
}
__device__ __forceinline__ float row_to_bf16(const float* xrow, bf16* orow, int lane) {
    const GAS f32x4* xr = (const GAS f32x4*)xrow + lane; float s = 0.f;
#pragma unroll
    for (int h = 0; h < 2; ++h) { f32x4 v[8];
#pragma unroll
        for (int j = 0; j < 8; ++j) v[j] = xr[64 * (8 * h + j)];
#pragma unroll
        for (int j = 0; j < 8; ++j) { s += (v[j].x * v[j].x + v[j].y * v[j].y) + (v[j].z * v[j].z + v[j].w * v[j].w);
            ((GAS unsigned long long*)orow)[lane + 64 * (8 * h + j)] = (unsigned long long)pk2(v[j].x, v[j].y) | ((unsigned long long)pk2(v[j].z, v[j].w) << 32); } }
    return wave_sum(s);
}
__device__ __forceinline__ void p0_prologue(Frame F) { PHASE_LOCAL(F);
    LAS float* scr = (LAS float*)(F.lds + RING_OFF + F.wave * 16384);
    int rot = 0;
    tr_matrix<0>(F, scr, F.a->in[I_WINA], D, AINW, WSP(bf16, WS_WINA), D, F.a->in[I_NMIX], rot);
    tr_matrix<0>(F, scr, F.a->in[I_WMEM], D, 2048, WSP(bf16, WS_WMEM), D, F.a->in[I_NMEM], rot);
    tr_matrix<0>(F, scr, F.a->in[I_WMEM] + (size_t)D * 2048, D, 2048, WSP(bf16, WS_WMEM) + (size_t)2048 * D, D, F.a->in[I_NMEM] + D, rot);
    tr_matrix<0>(F, scr, F.a->in[I_W2], 96, MIXW, WSP(bf16, WS_W2), 256, nullptr, rot);
    tr_matrix<0>(F, scr, F.a->in[I_A2], 96, MIXW, WSP(bf16, WS_A2), 256, nullptr, rot);
    tr_matrix<0>(F, scr, F.a->in[I_G2], 384, MIXW, WSP(bf16, WS_G2), 384, nullptr, rot);
    tr_matrix<0>(F, scr, F.a->in[I_WOUTA], D, D, WSP(bf16, WS_WOUTA), D, nullptr, rot);
    tr_matrix<1>(F, scr, F.a->in[I_WFI], D, NFI, WSP(bf16, WS_WFI), D, F.a->in[I_NFFN], rot);
    tr_matrix<0>(F, scr, F.a->in[I_WFO], DFF, D, WSP(bf16, WS_WFO), DFF, nullptr, rot);
    tr_matrix<0>(F, scr, F.a->in[I_WINB], D, NB, WSP(bf16, WS_WINB), D, F.a->in[I_NMIX] + D, rot);
    tr_matrix<0>(F, scr, F.a->in[I_WOUTB], 2048, D, WSP(bf16, WS_WOUTB), 2048, nullptr, rot);
    tr_matrix<1>(F, scr, F.a->in[I_WFI] + (size_t)D * NFI, D, NFI, WSP(bf16, WS_WFI) + (size_t)NFI * D, D, F.a->in[I_NFFN] + D, rot);
    tr_matrix<0>(F, scr, F.a->in[I_WFO] + (size_t)DFF * D, DFF, D, WSP(bf16, WS_WFO) + (size_t)D * DFF, DFF, nullptr, rot);
    { GAS v4u* z = (GAS v4u*)(WSP(bf16, WS_WINA) + (size_t)AINW * D); const size_t n16 = (size_t)(NA - AINW) * D * 2 / 16;
      for (size_t i = (size_t)F.gw * 64 + F.lane; i < n16; i += (size_t)F.NGW * 64) z[i] = (v4u){0u, 0u, 0u, 0u}; }
    { const float* C = F.a->in[I_CMEM];
      for (int it = F.gw; it < 2 * 8 * 4 * 32; it += F.NGW) { const int lbh = it >> 5, sub = it & 31, kb = sub >> 3, nb = sub & 7, lb = lbh >> 2, h = lbh & 3;
          tr_item(C + (size_t)lb * 256 * 2048 + 1024 + h * 256, 256, 2048, WSP(bf16, WS_VTS) + (size_t)lbh * 65536, 256, 32 * nb, nullptr, scr, 64 * kb, 32 * nb, F.lane); }
      for (int it = F.gw; it < 2 * 8 * 256; it += F.NGW) { const int lb = it >> 8, key = it & 255; const float* src = C + (size_t)it * 2048;
#pragma unroll
          for (int h = 0; h < 4; ++h) { const f32x4 v = *(const GAS f32x4*)(src + h * 256 + 4 * F.lane);
              *(GAS unsigned long long*)(WSP(bf16, WS_KS) + ((size_t)(lb * 4 + h) * 256 + key) * 256 + 4 * F.lane) = (unsigned long long)pk2(v.x, v.y) | ((unsigned long long)pk2(v.z, v.w) << 32); } } }
    for (int m = F.gw; m < M; m += F.NGW) { const float* xr = m < MP ? F.a->in[I_XP] + (size_t)m * D : F.a->in[I_XS] + (size_t)(m - MP) * D;
        const float s = row_to_bf16(xr, WSP(bf16, WS_XA) + (size_t)m * D, F.lane); WSP(float, WS_SS)[(size_t)m * 64 + F.lane] = F.lane == 0 ? s : 0.f; }
    for (int m = F.gw; m < NBP * NMEM; m += F.NGW) { const float s = row_to_bf16(F.a->in[I_MEM] + (size_t)m * D, WSP(bf16, WS_XM) + (size_t)m * D, F.lane);
        if (F.lane == 0) WSP(float, WS_RSTDM)[m] = 1.0f / sqrtf(s * (1.0f / D) + RMS_EPS); }
    {
#pragma unroll
      for (int g = 0; g < 3; ++g) { const int rows_g = 128 << (2 * g); const float* C = g == 0 ? F.a->in[I_C1] : (g == 1 ? F.a->in[I_C2] : F.a->in[I_C3]); float* o = F.out + (g == 0 ? OUT_SWAS1 : (g == 1 ? OUT_SWAS2 : OUT_SWAS3)); const size_t per = (size_t)(rows_g - 8) * 2048 / 4, full = (size_t)rows_g * 2048;
          for (size_t i = (size_t)F.gw * 64 + F.lane; i < per * NBS; i += (size_t)F.NGW * 64) { const size_t b = i / per, x = i % per;
              *(GAS f32x4*)(o + b * full + 4 * x) = *(const GAS f32x4*)(C + b * full + 16384 + 4 * x); } } }
}
struct ShiftRow { const bf16* u; const bf16* up; const float* st; bool hasprev; bool zero; };
__device__ __forceinline__ ShiftRow shift_row(Frame& F, int row) {
    ShiftRow s; s.u = WSP(bf16, WS_U) + (size_t)row * NA; s.up = s.u - NA;
    const bool isP = row < MP; const int t = isP ? (row & (SEQ - 1)) : ((row - MP) & (DSEQ - 1));
    s.hasprev = t > 0; s.zero = isP; s.st = F.a->in[I_SSHIFT] + (size_t)(isP ? 0 : ((row - MP) >> 3)) * ASW;
    return s;
}
__device__ __forceinline__ float shift_mix(const ShiftRow& s, const float* mu, int c) {
    const float uc = bf2f(s.u[c]); const float pv = s.hasprev ? bf2f(s.up[c]) : (s.zero ? 0.f : s.st[c]);
    return uc + (pv - uc) * mu[c];
}
__device__ __forceinline__ void p2_lora_prep(Frame F) { PHASE_LOCAL(F);
    const float* mu = F.a->in[I_MU];
    for (int row = F.gw; row < M; row += F.NGW) {
        const ShiftRow s = shift_row(F, row);
        bf16* xw = WSP(bf16, WS_XLW) + (size_t)row * 256; bf16* xa = WSP(bf16, WS_XLA) + (size_t)row * 256; bf16* xg = WSP(bf16, WS_XLG) + (size_t)row * 384;
#pragma unroll
        for (int i = 0; i < 9; ++i) { const int j = F.lane + 64 * i; const float x = shift_mix(s, mu, 3 * MIXW + j);
            if (j < 96) xw[j] = (bf16)f2bf(tanhf(x)); else if (j < 192) xa[j - 96] = (bf16)f2bf(x); else xg[j - 192] = (bf16)f2bf(1.0f / (1.0f + expf(-x))); }
        for (int j = 96 + F.lane; j < 256; j += 64) { xw[j] = 0; xa[j] = 0; }
        const bool isP = row < MP; const int t = isP ? (row & (SEQ - 1)) : ((row - MP) & (DSEQ - 1));
        if (t == (isP ? SEQ - 1 : DSEQ - 1)) { float* o = F.out + (isP ? OUT_SHIFTP + (size_t)(row >> 11) * ASW : OUT_SHIFTS + (size_t)((row - MP) >> 3) * ASW);
            for (int c = F.lane; c < ASW; c += 64) o[c] = bf2f(s.u[c]); }
    }
}
__device__ __forceinline__ void p2_memkv_post(Frame F) { PHASE_LOCAL(F);
    LAS float* scr = (LAS float*)(F.lds + RING_OFF + F.wave * 16384);
    const float* RAW = WSP(float, WS_MEMRAW);
    for (int it = F.gw; it < 2 * 4 * 4 * 32; it += F.NGW) { const int lbh = it >> 5, sub = it & 31, kb = sub >> 3, nb = sub & 7, lb = lbh >> 2, h = lbh & 3;
        tr_item(RAW + (size_t)lb * 256 * 2048 + 1024 + h * 256, 256, 2048, WSP(bf16, WS_VTP) + (size_t)lbh * 65536, 256, 32 * nb, nullptr, scr, 64 * kb, 32 * nb, F.lane); }
    for (int it = F.gw; it < 2 * 1024; it += F.NGW) { const int l = it >> 10, row = it & 1023, b = row >> 8, key = row & 255; const float* src = RAW + (size_t)it * 2048; float* o = F.out + OUT_MEMKV + (size_t)it * 2048;
        const float* gk = F.a->in[I_KNM] + l * 256;
#pragma unroll
        for (int h = 0; h < 4; ++h) { const f32x4 v = *(const GAS f32x4*)(src + h * 256 + 4 * F.lane); const f32x4 g = *(const GAS f32x4*)(gk + 4 * F.lane);
            const float ss = wave_sum((v.x * v.x + v.y * v.y) + (v.z * v.z + v.w * v.w)); const float r = 1.0f / sqrtf(ss * (1.0f / 256.0f) + RMS_EPS);
            const f32x4 kn = v * r * g; *(GAS f32x4*)(o + h * 256 + 4 * F.lane) = kn;
            *(GAS unsigned long long*)(WSP(bf16, WS_KP) + ((size_t)((l * 4 + b) * 4 + h) * 256 + key) * 256 + 4 * F.lane) = (unsigned long long)pk2(kn.x, kn.y) | ((unsigned long long)pk2(kn.z, kn.w) << 32);
            *(GAS f32x4*)(o + 1024 + h * 256 + 4 * F.lane) = *(const GAS f32x4*)(src + 1024 + h * 256 + 4 * F.lane); } }
}
__device__ __forceinline__ float* scan_ptr(Frame& F, int row, int h) {
    if (row < MP) return WSP(float, WS_SCANP) + ((size_t)((row >> 11) * AH + h) * SEQ + (row & (SEQ - 1))) * 384;
    const int sr = row - MP; return WSP(float, WS_SCANS) + ((size_t)((sr >> 3) * AH + h) * DSEQ + (sr & (DSEQ - 1))) * 384;
}
__device__ __forceinline__ void p4_scan_prep(Frame F) { PHASE_LOCAL(F);
    const float* mu = F.a->in[I_MU]; const float* kk_a = F.a->in[I_KK]; const float* ka_a = F.a->in[I_KA];
    for (int row = F.gw; row < M; row += F.NGW) {
        const ShiftRow s = shift_row(F, row);
        for (int h = 0; h < AH; ++h) { const int c = 64 * h + F.lane; float* sp = scan_ptr(F, row, h);
            const float r = shift_mix(s, mu, c), k = shift_mix(s, mu, MIXW + c), v = shift_mix(s, mu, 2 * MIXW + c);
            const float a = sp[4 * 64 + F.lane];
            float kk = k * kk_a[c]; const float n2 = wave_sum(kk * kk); kk = kk / fmaxf(sqrtf(n2), 1e-12f);
            const float k2 = k * (1.0f + (a - 1.0f) * ka_a[c]);
            sp[F.lane] = r; sp[2 * 64 + F.lane] = k2; sp[3 * 64 + F.lane] = -kk; sp[4 * 64 + F.lane] = kk * a; sp[5 * 64 + F.lane] = v; }
    }
}
__device__ __forceinline__ void p5_scan_task(Frame F, int task) { PHASE_LOCAL(F);
    LAS float* stage = (LAS float*)(F.lds + RING_OFF + F.wave * 16384);
    const bool isP = task < NBP * AH; const int sh = isP ? task : task - NBP * AH; const int seq = sh / AH, h = sh % AH; const int T = isP ? SEQ : DSEQ;
    const float* buf = (isP ? WSP(float, WS_SCANP) : WSP(float, WS_SCANS)) + (size_t)sh * T * 384;
    const int c = 64 * h + F.lane; const int row0 = isP ? seq * SEQ : MP + seq * DSEQ;
    float S[64];
    if (isP) {
#pragma unroll
        for (int k = 0; k < 64; ++k) S[k] = 0.f;
    } else { const GAS f32x4* s0 = (const GAS f32x4*)(F.a->in[I_SWKV] + ((size_t)sh * 64 + F.lane) * 64);
#pragma unroll
        for (int k4 = 0; k4 < 16; ++k4) { const f32x4 v = s0[k4]; S[4 * k4] = v.x; S[4 * k4 + 1] = v.y; S[4 * k4 + 2] = v.z; S[4 * k4 + 3] = v.w; } }
    const float lg = F.a->in[I_LNG][c], lb = F.a->in[I_LNB][c], rk = F.a->in[I_RK][c];
    const bf16* G = WSP(bf16, WS_G); bf16* O = WSP(bf16, WS_O);
    for (int t0 = 0; t0 < T; t0 += 8) {
        { const GAS f32x4* src = (const GAS f32x4*)(buf + (size_t)t0 * 384); LAS f32x4* dst = (LAS f32x4*)stage;
#pragma unroll
          for (int i = 0; i < 12; ++i) dst[F.lane + 64 * i] = src[F.lane + 64 * i]; }
        LDS_WAIT(); asm volatile("" ::: "memory");
        for (int tt = 0; tt < 8; ++tt) {
            const LAS f32x4* P = (const LAS f32x4*)(stage + tt * 384);
            float sa0 = 0.f, sa1 = 0.f, sa2 = 0.f, sa3 = 0.f;
#pragma unroll
            for (int k4 = 0; k4 < 16; ++k4) { const f32x4 a4 = P[48 + k4]; sa0 += S[4 * k4] * a4.x; sa1 += S[4 * k4 + 1] * a4.y; sa2 += S[4 * k4 + 2] * a4.z; sa3 += S[4 * k4 + 3] * a4.w; }
            const float sa = (sa0 + sa1) + (sa2 + sa3);
            const float vv = stage[tt * 384 + 320 + F.lane];
            float y0 = 0.f, y1 = 0.f, y2 = 0.f, y3 = 0.f;
#pragma unroll
            for (int k4 = 0; k4 < 16; ++k4) { const f32x4 w4 = P[16 + k4], b4 = P[64 + k4], kv = P[32 + k4], r4 = P[k4];
                S[4 * k4] = S[4 * k4] * w4.x + sa * b4.x + vv * kv.x; y0 += S[4 * k4] * r4.x;
                S[4 * k4 + 1] = S[4 * k4 + 1] * w4.y + sa * b4.y + vv * kv.y; y1 += S[4 * k4 + 1] * r4.y;
                S[4 * k4 + 2] = S[4 * k4 + 2] * w4.z + sa * b4.z + vv * kv.z; y2 += S[4 * k4 + 2] * r4.z;
                S[4 * k4 + 3] = S[4 * k4 + 3] * w4.w + sa * b4.w + vv * kv.w; y3 += S[4 * k4 + 3] * r4.w; }
            const float y = (y0 + y1) + (y2 + y3);
            const float mean = wave_sum(y) * (1.0f / 64.0f), dd = y - mean, var = wave_sum(dd * dd) * (1.0f / 64.0f);
            const float yn = dd * (1.0f / sqrtf(var + LNX_EPS)) * lg + lb;
            const float rl = stage[tt * 384 + F.lane], kl = stage[tt * 384 + 128 + F.lane];
            const float bonus = wave_sum(rl * kl * rk) * vv;
            const size_t row = (size_t)row0 + t0 + tt;
            O[row * D + c] = (bf16)f2bf((yn + bonus) * bf2f(G[row * MIXW + c]));
        }
        asm volatile("" ::: "memory");
    }
    float* so = F.out + (isP ? OUT_WKVP : OUT_WKVS) + ((size_t)sh * 64 + F.lane) * 64;
#pragma unroll
    for (int k4 = 0; k4 < 16; ++k4) *(GAS f32x4*)(so + 4 * k4) = (f32x4){S[4 * k4], S[4 * k4 + 1], S[4 * k4 + 2], S[4 * k4 + 3]};
}

__device__ __forceinline__ void mem_attend_task(const bf16* Q, int ldq, int qmask, int nvalid, const float* gq, const bf16* K, const bf16* VT, bf16* Oo, int ldo, int lane) {
    const int q = lane & 15, g = lane >> 4;
    const bf16* qp = Q + (size_t)(q & qmask) * ldq + 8 * g;
    bf16x8 Bq[8]; float ss = 0.f;
    float qf[8][8];
#pragma unroll
    for (int s = 0; s < 8; ++s) { const v4u raw = *(const GAS v4u*)(qp + 32 * s);
        const unsigned w[4] = {raw.x, raw.y, raw.z, raw.w};
#pragma unroll
        for (int j = 0; j < 4; ++j) { qf[s][2 * j] = __builtin_bit_cast(float, w[j] << 16); qf[s][2 * j + 1] = __builtin_bit_cast(float, w[j] & 0xffff0000u); }
#pragma unroll
        for (int j = 0; j < 8; ++j) ss += qf[s][j] * qf[s][j]; }
    ss += __shfl_xor(ss, 16); ss += __shfl_xor(ss, 32);
    const float sc = (1.0f / sqrtf(ss * (1.0f / 256.0f) + RMS_EPS)) * (0.0625f * LOG2E);
#pragma unroll
    for (int s = 0; s < 8; ++s) { const f32x4 g0 = *(const GAS f32x4*)(gq + 32 * s + 8 * g), g1 = *(const GAS f32x4*)(gq + 32 * s + 8 * g + 4);
        v4u w; w.x = pk2(qf[s][0] * sc * g0.x, qf[s][1] * sc * g0.y); w.y = pk2(qf[s][2] * sc * g0.z, qf[s][3] * sc * g0.w);
        w.z = pk2(qf[s][4] * sc * g1.x, qf[s][5] * sc * g1.y); w.w = pk2(qf[s][6] * sc * g1.z, qf[s][7] * sc * g1.w);
        Bq[s] = __builtin_bit_cast(bf16x8, w); }
    f32x4 sT[16];
#pragma unroll
    for (int kt = 0; kt < 16; ++kt) { f32x4 acc = (f32x4){0.f, 0.f, 0.f, 0.f}; const bf16* kp = K + (size_t)(16 * kt + q) * 256 + 8 * g;
#pragma unroll
        for (int s = 0; s < 8; ++s) { const bf16x8 a = *(const GAS bf16x8*)(kp + 32 * s); acc = __builtin_amdgcn_mfma_f32_16x16x32_bf16(a, Bq[s], acc, 0, 0, 0); }
        sT[kt] = acc; }
    float mx = -3.0e38f;
#pragma unroll
    for (int kt = 0; kt < 16; ++kt) mx = fmaxf(mx, fmaxf(fmaxf(sT[kt][0], sT[kt][1]), fmaxf(sT[kt][2], sT[kt][3])));
    mx = fmaxf(mx, __shfl_xor(mx, 16)); mx = fmaxf(mx, __shfl_xor(mx, 32));
    float l = 0.f;
#pragma unroll
    for (int kt = 0; kt < 16; ++kt) {
#pragma unroll
        for (int i = 0; i < 4; ++i) { const float p = __builtin_amdgcn_exp2f(sT[kt][i] - mx); sT[kt][i] = p; l += p; } }
    l += __shfl_xor(l, 16); l += __shfl_xor(l, 32);
    const float inv = 1.0f / l;
    bf16x8 Bp[8];
#pragma unroll
    for (int s = 0; s < 8; ++s) { v4u w; w.x = pk2(sT[2 * s][0], sT[2 * s][1]); w.y = pk2(sT[2 * s][2], sT[2 * s][3]); w.z = pk2(sT[2 * s + 1][0], sT[2 * s + 1][1]); w.w = pk2(sT[2 * s + 1][2], sT[2 * s + 1][3]);
        Bp[s] = __builtin_bit_cast(bf16x8, w); }
#pragma unroll
    for (int dt = 0; dt < 16; ++dt) { f32x4 o = (f32x4){0.f, 0.f, 0.f, 0.f}; const bf16* vp = VT + (size_t)(16 * dt + q) * 256 + 4 * g;
#pragma unroll
        for (int s = 0; s < 8; ++s) { typedef unsigned u2 __attribute__((ext_vector_type(2)));
            const u2 lo = *(const GAS u2*)(vp + 32 * s), hi = *(const GAS u2*)(vp + 32 * s + 16); v4u w; w.x = lo.x; w.y = lo.y; w.z = hi.x; w.w = hi.y;
            o = __builtin_amdgcn_mfma_f32_16x16x32_bf16(__builtin_bit_cast(bf16x8, w), Bp[s], o, 0, 0, 0); }
        if (q < nvalid) { typedef unsigned u2 __attribute__((ext_vector_type(2))); u2 w; w.x = pk2(o[0] * inv, o[1] * inv); w.y = pk2(o[2] * inv, o[3] * inv);
            *(GAS u2*)(Oo + (size_t)q * ldo + 16 * dt + 4 * g) = w; } }
}
__device__ __forceinline__ void mem_attend_phase(Frame F, int layer, const bf16* Usrc, int ldu, int qoff, bf16* Odst, int ldo, int ooff) { PHASE_LOCAL(F);
    const float* gq = F.a->in[I_QNM] + layer * 256;
    const int NT = (MP / 16) * 4 + NBS * 4;
    for (int task = F.gw; task < NT; task += F.NGW) {
        if (task < (MP / 16) * 4) { const int rt = task >> 2, h = task & 3, row0 = rt * 16, b = row0 >> 11; const size_t kv = (size_t)((layer * 4 + b) * 4 + h) * 65536;
            mem_attend_task(Usrc + (size_t)row0 * ldu + qoff + h * 256, ldu, 15, 16, gq, WSP(bf16, WS_KP) + kv, WSP(bf16, WS_VTP) + kv, Odst + (size_t)row0 * ldo + ooff + h * 256, ldo, F.lane);
        } else { const int st = task - (MP / 16) * 4, b = st >> 2, h = st & 3, row0 = MP + b * 8; const size_t kv = (size_t)((layer * 8 + b) * 4 + h) * 65536;
            mem_attend_task(Usrc + (size_t)row0 * ldu + qoff + h * 256, ldu, 7, 8, gq, WSP(bf16, WS_KS) + kv, WSP(bf16, WS_VTS) + kv, Odst + (size_t)row0 * ldo + ooff + h * 256, ldo, F.lane); }
    }
}
constexpr size_t GRP_ELEMS = (size_t)NBP * 8 * SEQ * 128;
__device__ __forceinline__ void p10_qkv_post(Frame F) { PHASE_LOCAL(F);
    const float* gq = F.a->in[I_QNB]; const float* gk = F.a->in[I_KNB];
    const float g0 = gq[2 * F.lane], g1 = gq[2 * F.lane + 1], h0 = gk[2 * F.lane], h1 = gk[2 * F.lane + 1];
    const float qscale = 0.08838834764831845f * LOG2E;
    for (int row = F.gw; row < M; row += F.NGW) {
        const bf16* u = WSP(bf16, WS_U) + (size_t)row * NB; const bool isP = row < MP;
        const int b = isP ? row >> 11 : (row - MP) >> 3, t = isP ? row & (SEQ - 1) : (row - MP) & (DSEQ - 1);
        for (int H = 0; H < 24; ++H) { const int g = H >> 3, h = H & 7, dsh = 2 * g, dil = 1 << dsh, sub = SEQ >> dsh, win = 128 << dsh;
            const unsigned qw = *(const GAS unsigned*)(u + H * 128 + 2 * F.lane), kw = *(const GAS unsigned*)(u + MIXW + H * 128 + 2 * F.lane), vw = *(const GAS unsigned*)(u + 2 * MIXW + H * 128 + 2 * F.lane);
            const float q0 = __builtin_bit_cast(float, qw << 16), q1 = __builtin_bit_cast(float, qw & 0xffff0000u), k0 = __builtin_bit_cast(float, kw << 16), k1 = __builtin_bit_cast(float, kw & 0xffff0000u);
            const float v0 = __builtin_bit_cast(float, vw << 16), v1 = __builtin_bit_cast(float, vw & 0xffff0000u);
            const float rq = 1.0f / sqrtf(wave_sum(q0 * q0 + q1 * q1) * (1.0f / 128.0f) + RMS_EPS), rk = 1.0f / sqrtf(wave_sum(k0 * k0 + k1 * k1) * (1.0f / 128.0f) + RMS_EPS);
            const float qn0 = q0 * rq * g0, qn1 = q1 * rq * g1, kn0 = k0 * rk * h0, kn1 = k1 * rk * h1;
            if (isP) { const int r = t & (dil - 1), j = t >> dsh; const size_t seq = (size_t)((b * 8 + h) * dil + r);
                *(GAS unsigned*)(WSP(bf16, WS_QN) + g * GRP_ELEMS + (seq * sub + j) * 128 + 2 * F.lane) = pk2(qn0 * qscale, qn1 * qscale);
                *(GAS unsigned*)(WSP(bf16, WS_KN) + g * GRP_ELEMS + (seq * sub + j) * 128 + 2 * F.lane) = pk2(kn0, kn1);
                bf16* vt = WSP(bf16, WS_VT) + g * GRP_ELEMS + (seq * 128 + 2 * F.lane) * sub + j; vt[0] = (bf16)(vw & 0xffffu); vt[sub] = (bf16)(vw >> 16);
                const int keep = win < SEQ ? win : SEQ;
                if (t >= SEQ - keep) { float* o = F.out + (g == 0 ? OUT_SWAP1 : (g == 1 ? OUT_SWAP2 : OUT_SWAP3)) + ((size_t)(b * keep + (t - (SEQ - keep))) * 2) * 1024 + h * 128 + 2 * F.lane;
                    *(GAS f32x2*)o = (f32x2){kn0, kn1}; *(GAS f32x2*)(o + 1024) = (f32x2){v0, v1}; }
            } else { float* qs = WSP(float, WS_QS) + ((size_t)(row - MP) * 24 + H) * 128 + 2 * F.lane; *(GAS f32x2*)qs = (f32x2){qn0 * qscale, qn1 * qscale};
                float* o = F.out + (g == 0 ? OUT_SWAS1 : (g == 1 ? OUT_SWAS2 : OUT_SWAS3)) + ((size_t)(b * win + (win - DSEQ + t)) * 2) * 1024 + h * 128 + 2 * F.lane;
                *(GAS f32x2*)o = (f32x2){kn0, kn1}; *(GAS f32x2*)(o + 1024) = (f32x2){v0, v1}; }
        }
    }
}
__device__ __forceinline__ void band_attn_task(const bf16* QNs, const bf16* KNs, const bf16* VTs, int sub, int i0, bf16* OGrow0, size_t ogstride, float* LSErow0, size_t lsestride, int lane) {
    const int q = lane & 15, g = lane >> 4, ks = i0 - 144;
    bf16x8 Bq[4];
#pragma unroll
    for (int s = 0; s < 4; ++s) Bq[s] = *(const GAS bf16x8*)(QNs + (size_t)(i0 + q) * 128 + 32 * s + 8 * g);
    f32x4 sT[10]; float mx = -3.0e38f;
#pragma unroll
    for (int kt = 0; kt < 10; ++kt) { f32x4 acc = (f32x4){0.f, 0.f, 0.f, 0.f}; int kr = ks + 16 * kt + q; kr = kr < 0 ? 0 : kr; const bf16* kp = KNs + (size_t)kr * 128 + 8 * g;
#pragma unroll
        for (int s = 0; s < 4; ++s) { const bf16x8 a = *(const GAS bf16x8*)(kp + 32 * s); acc = __builtin_amdgcn_mfma_f32_16x16x32_bf16(a, Bq[s], acc, 0, 0, 0); }
#pragma unroll
        for (int i = 0; i < 4; ++i) { const int kpos = ks + 16 * kt + 4 * g + i, dist = (i0 + q) - kpos; const bool ok = kpos >= 0 && dist >= 0 && dist <= 128; acc[i] = ok ? acc[i] : -1.0e30f; mx = fmaxf(mx, acc[i]); }
        sT[kt] = acc; }
    mx = fmaxf(mx, __shfl_xor(mx, 16)); mx = fmaxf(mx, __shfl_xor(mx, 32));
    float l = 0.f;
#pragma unroll
    for (int kt = 0; kt < 10; ++kt) {
#pragma unroll
        for (int i = 0; i < 4; ++i) { const float p = __builtin_amdgcn_exp2f(sT[kt][i] - mx); sT[kt][i] = p; l += p; } }
    l += __shfl_xor(l, 16); l += __shfl_xor(l, 32);
    const float inv = 1.0f / l;
    bf16x8 Bp[5];
#pragma unroll
    for (int s = 0; s < 5; ++s) { v4u w; w.x = pk2(sT[2 * s][0], sT[2 * s][1]); w.y = pk2(sT[2 * s][2], sT[2 * s][3]); w.z = pk2(sT[2 * s + 1][0], sT[2 * s + 1][1]); w.w = pk2(sT[2 * s + 1][2], sT[2 * s + 1][3]);
        Bp[s] = __builtin_bit_cast(bf16x8, w); }
    typedef unsigned u2 __attribute__((ext_vector_type(2)));
#pragma unroll
    for (int dt = 0; dt < 8; ++dt) { f32x4 o = (f32x4){0.f, 0.f, 0.f, 0.f}; const bf16* vp = VTs + (size_t)(16 * dt + q) * sub;
#pragma unroll
        for (int s = 0; s < 5; ++s) { int c0 = ks + 32 * s + 4 * g, c1 = c0 + 16; c0 = c0 < 0 ? 0 : c0; c1 = c1 < 0 ? 0 : c1;
            const u2 lo = *(const GAS u2*)(vp + c0), hi = *(const GAS u2*)(vp + c1); v4u w; w.x = lo.x; w.y = lo.y; w.z = hi.x; w.w = hi.y;
            o = __builtin_amdgcn_mfma_f32_16x16x32_bf16(__builtin_bit_cast(bf16x8, w), Bp[s], o, 0, 0, 0); }
        u2 w; w.x = pk2(o[0] * inv, o[1] * inv); w.y = pk2(o[2] * inv, o[3] * inv);
        *(GAS u2*)(OGrow0 + (size_t)q * ogstride + 16 * dt + 4 * g) = w; }
    if (g == 0) LSErow0[(size_t)q * lsestride] = (mx + __builtin_amdgcn_logf(l)) * LN2;
}
__device__ __forceinline__ void band_attn_phase(Frame F) { PHASE_LOCAL(F);
    for (int task = F.gw; task < 3 * 4096; task += F.NGW) { const int g = task >> 12, tt = task & 4095, dsh = 2 * g, dil = 1 << dsh, sub = SEQ >> dsh, tps = sub >> 4;
        const int seq = tt / tps, i0 = (tt % tps) * 16, r = seq & (dil - 1), bh = seq >> dsh, b = bh >> 3, h = bh & 7;
        const size_t row0 = (size_t)b * SEQ + r + (size_t)dil * i0;
        band_attn_task(WSP(bf16, WS_QN) + g * GRP_ELEMS + (size_t)seq * sub * 128, WSP(bf16, WS_KN) + g * GRP_ELEMS + (size_t)seq * sub * 128, WSP(bf16, WS_VT) + g * GRP_ELEMS + (size_t)seq * 128 * sub, sub, i0,
                       WSP(bf16, WS_OG) + (size_t)g * MP * 1024 + row0 * 1024 + h * 128, (size_t)dil * 1024, WSP(float, WS_LSE) + ((size_t)g * MP + row0) * 8 + h, (size_t)dil * 8, F.lane); }
}
__device__ __forceinline__ void sample_attn_phase(Frame F) { PHASE_LOCAL(F);
    LAS float* qs = (LAS float*)(F.lds + RING_OFF + F.wave * 16384);
    for (int task = F.gw; task < MS * 8; task += F.NGW) { const int sr = task >> 3, h = task & 7, b = sr >> 3, t = sr & 7;
        float m = -1.0e30f, l = 0.f, o0 = 0.f, o1 = 0.f;
        for (int g = 0; g < 3; ++g) { const int dsh = 2 * g, dil = 1 << dsh, win = 128 << dsh; const float* C = g == 0 ? F.a->in[I_C1] : (g == 1 ? F.a->in[I_C2] : F.a->in[I_C3]); const float* NO = F.out + (g == 0 ? OUT_SWAS1 : (g == 1 ? OUT_SWAS2 : OUT_SWAS3));
            { const f32x2 qv = *(const GAS f32x2*)(WSP(float, WS_QS) + ((size_t)sr * 24 + g * 8 + h) * 128 + 2 * F.lane); qs[2 * F.lane] = qv.x; qs[2 * F.lane + 1] = qv.y; }
            LDS_WAIT(); asm volatile("" ::: "memory");
            float sc[3];
#pragma unroll
            for (int jj = 0; jj < 3; ++jj) { const int j = F.lane + 64 * jj; const bool ok = j <= 128; const int idx = win + t - dil * (ok ? j : 0);
                const float* kp = idx < win ? C + ((size_t)(b * win + idx) * 2) * 1024 + h * 128 : NO + ((size_t)(b * win + idx - DSEQ) * 2) * 1024 + h * 128;
                float s = 0.f;
                if (jj < 2 || F.lane == 0) {
#pragma unroll 8
                    for (int d4 = 0; d4 < 32; ++d4) { const f32x4 kv = *(const GAS f32x4*)(kp + 4 * d4); const f32x4 qv = *(const LAS f32x4*)(qs + 4 * d4); s += (kv.x * qv.x + kv.y * qv.y) + (kv.z * qv.z + kv.w * qv.w); } }
                sc[jj] = ok ? s : -1.0e30f; }
            const float mn = fmaxf(m, wave_max(fmaxf(fmaxf(sc[0], sc[1]), sc[2]))); const float resc = __builtin_amdgcn_exp2f(m - mn); m = mn; l *= resc; o0 *= resc; o1 *= resc;
            float p[3], ps = 0.f;
#pragma unroll
            for (int jj = 0; jj < 3; ++jj) { p[jj] = __builtin_amdgcn_exp2f(sc[jj] - m); ps += p[jj]; }
            l += wave_sum(ps);
#pragma unroll
            for (int jj = 0; jj < 3; ++jj) { const int nj = jj < 2 ? 64 : 1;
                for (int jl = 0; jl < nj; ++jl) { const int j = jl + 64 * jj, idx = win + t - dil * j; const float pj = __shfl(p[jj], jl);
                    const float* vp = (idx < win ? C + ((size_t)(b * win + idx) * 2 + 1) * 1024 : NO + ((size_t)(b * win + idx - DSEQ) * 2 + 1) * 1024) + h * 128 + 2 * F.lane;
                    const f32x2 vv = *(const GAS f32x2*)vp; o0 += pj * vv.x; o1 += pj * vv.y; } }
            asm volatile("" ::: "memory");
        }
        const float inv = 1.0f / l;
        *(GAS unsigned*)(WSP(bf16, WS_O) + (size_t)(MP + sr) * 2048 + h * 128 + 2 * F.lane) = pk2(o0 * inv, o1 * inv);
    }
}
__device__ __forceinline__ void merge_phase(Frame F) { PHASE_LOCAL(F);
    for (int row = F.gw; row < MP; row += F.NGW) { const int h = F.lane >> 3;
        const float l0 = WSP(float, WS_LSE)[((size_t)0 * MP + row) * 8 + h], l1 = WSP(float, WS_LSE)[((size_t)1 * MP + row) * 8 + h], l2 = WSP(float, WS_LSE)[((size_t)2 * MP + row) * 8 + h];
        const float mm = fmaxf(l0, fmaxf(l1, l2)); float w0 = expf(l0 - mm), w1 = expf(l1 - mm), w2 = expf(l2 - mm); const float is = 1.0f / (w0 + w1 + w2); w0 *= is; w1 *= is; w2 *= is;
        float acc[16];
#pragma unroll
        for (int j = 0; j < 16; ++j) acc[j] = 0.f;
#pragma unroll
        for (int g = 0; g < 3; ++g) { const float w = g == 0 ? w0 : (g == 1 ? w1 : w2); const bf16* src = WSP(bf16, WS_OG) + ((size_t)g * MP + row) * 1024 + 16 * F.lane;
#pragma unroll
            for (int c = 0; c < 2; ++c) { const v4u raw = *(const GAS v4u*)(src + 8 * c); const unsigned ww[4] = {raw.x, raw.y, raw.z, raw.w};
#pragma unroll
                for (int j = 0; j < 4; ++j) { acc[8 * c + 2 * j] += w * __builtin_bit_cast(float, ww[j] << 16); acc[8 * c + 2 * j + 1] += w * __builtin_bit_cast(float, ww[j] & 0xffff0000u); } } }
        bf16* dst = WSP(bf16, WS_O) + (size_t)row * 2048 + 16 * F.lane;
#pragma unroll
        for (int c = 0; c < 2; ++c) { v4u w; w.x = pk2(acc[8 * c], acc[8 * c + 1]); w.y = pk2(acc[8 * c + 2], acc[8 * c + 3]); w.z = pk2(acc[8 * c + 4], acc[8 * c + 5]); w.w = pk2(acc[8 * c + 6], acc[8 * c + 7]);
            *(GAS v4u*)(dst + 8 * c) = w; }
    }
}
#ifndef PH_MASK
#define PH_MASK 0xFFFF
#endif
#ifndef P3_SUB
#define P3_SUB 7
#endif
#ifndef MK_STOP_AFTER
#define MK_STOP_AFTER 99
#endif
__device__ __forceinline__ int rot_c(int c, int G, int used) { int r = c - (used % G); return r < 0 ? r + G : r; }

__global__ void __launch_bounds__(NWAVES * 64, 2) mega_fwd(Args args) {
    extern __shared__ __attribute__((aligned(16))) unsigned char lds[];
    Frame F;
    F.lds = (LAS unsigned char*)lds;
    F.MISC = (volatile LAS unsigned*)(F.lds + MISC_OFF);
    F.tid = threadIdx.x; F.lane = F.tid & 63; F.wave = __builtin_amdgcn_readfirstlane(F.tid >> 6);
    F.G = gridDim.x; { const int bx = blockIdx.x; F.vcu = (F.G % 8 == 0) ? (bx % 8) * (F.G / 8) + bx / 8 : bx; }
    F.gw = F.vcu * NWAVES + F.wave; F.NGW = F.G * NWAVES;
    F.ws = args.ws; F.out = args.out; F.ctl = (gu32*)(args.ws + WS_CTL);
    F.a = &args;
    for (int u = F.tid; u < (LDS_BYTES - LDSCTL_OFF) / 4; u += NWAVES * 64) ((LAS unsigned*)(F.lds + LDSCTL_OFF))[u] = 0u;
    __syncthreads();
    XcdBarrier bar = xcd_barrier_post((unsigned*)(F.ctl + CW_BAR), F.MISC + 8);
    const int lo = args.ph_lo, hi = args.ph_hi;
#define IN(k) (((PH_MASK >> (k)) & 1) && lo <= (k) && (k) < hi && (k) <= MK_STOP_AFTER)
#define SEAM(k) do { if (IN(k) && IN((k) + 1)) xcd_barrier(bar); } while (0)
    const int cb = (int)blockIdx.x;
    LAS unsigned char* ring = F.lds + RING_OFF;

    if (IN(0)) { p0_prologue(F); }
    SEAM(0);
    if (IN(1)) {
        { pg8::Gemm g{WSP(bf16, WS_XA), WSP(bf16, WS_WINA), MPAD, NA, D}; pg8::StaticOrder S; S.init(MPAD, NA, F.G, cb);
          pg8::EpiB16<2> E{WSP(bf16, WS_U), NA, {WSP(float, WS_SS)}};
          pg8::gemm_phase<pg8::EpiB16<2>, pg8::StaticOrder, true, true>(ring, g, S, E); }
        for (int l = 0; l < 2; ++l) { pg8::Gemm g{WSP(bf16, WS_XM), WSP(bf16, WS_WMEM) + (size_t)l * 2048 * D, 1024, 2048, D}; pg8::StaticOrder S; S.init(1024, 2048, F.G, rot_c(cb, F.G, 33 * 43 + 32 * l));
          pg8::EpiF32 E{WSP(float, WS_MEMRAW) + (size_t)l * 1024 * 2048, 2048, {WSP(float, WS_RSTDM)}};
          pg8::gemm_phase<pg8::EpiF32, pg8::StaticOrder, true, true>(ring, g, S, E); }
    }
    SEAM(1);
    if (IN(2)) { p2_lora_prep(F); p2_memkv_post(F); }
    SEAM(2);
    if (IN(3)) {
        if (P3_SUB & 1) { pg8::Gemm g{WSP(bf16, WS_XLW), WSP(bf16, WS_W2), MPAD, MIXW, 256}; pg8::StaticOrder S; S.init(MPAD, MIXW, F.G, cb);
          pg8::EpiScanSlot<0> E{WSP(float, WS_SCANP), WSP(float, WS_SCANS), F.a->in[I_W0], 1, M};
          pg8::gemm_phase<pg8::EpiScanSlot<0>, pg8::StaticOrder, true, true>(ring, g, S, E); }
        if (P3_SUB & 2) { pg8::Gemm g{WSP(bf16, WS_XLA), WSP(bf16, WS_A2), MPAD, MIXW, 256}; pg8::StaticOrder S; S.init(MPAD, MIXW, F.G, rot_c(cb, F.G, 396));
          pg8::EpiScanSlot<1> E{WSP(float, WS_SCANP), WSP(float, WS_SCANS), F.a->in[I_A0], 4, M};
          pg8::gemm_phase<pg8::EpiScanSlot<1>, pg8::StaticOrder, true, true>(ring, g, S, E); }
        if (P3_SUB & 4) { pg8::Gemm g{WSP(bf16, WS_XLG), WSP(bf16, WS_G2), MPAD, MIXW, 384}; pg8::StaticOrder S; S.init(MPAD, MIXW, F.G, rot_c(cb, F.G, 792));
          pg8::EpiB16<0> E{WSP(bf16, WS_G), MIXW, {nullptr}};
          pg8::gemm_phase<pg8::EpiB16<0>, pg8::StaticOrder, true, true>(ring, g, S, E); }
    }
    SEAM(3);
    if (IN(4)) { p4_scan_prep(F); mem_attend_phase(F, 0, WSP(bf16, WS_U), NA, ASW, WSP(bf16, WS_O), D, MIXW); }
    SEAM(4);
    if (IN(5)) {
        if (F.wave == 0) { if (F.vcu < NBP * AH) p5_scan_task(F, F.vcu); }
        else { const int t = F.vcu * (NWAVES - 1) + (F.wave - 1); if (t < NBS * AH) p5_scan_task(F, NBP * AH + t); }
    }
    SEAM(5);
    for (int layer = 0; layer < 2; ++layer) {
        if (layer == 1) {
            if (IN(9)) { pg8::Gemm g{WSP(bf16, WS_XA), WSP(bf16, WS_WINB), MPAD, NB, D}; pg8::StaticOrder S; S.init(MPAD, NB, F.G, cb);
                pg8::EpiB16<2> E{WSP(bf16, WS_U), NB, {WSP(float, WS_SS) + 2 * (SS_STRIDE / 4)}};
                pg8::gemm_phase<pg8::EpiB16<2>, pg8::StaticOrder, true, true>(ring, g, S, E); }
            SEAM(9);
            if (IN(10)) { p10_qkv_post(F); }
            SEAM(10);
            if (IN(11)) { band_attn_phase(F); sample_attn_phase(F); mem_attend_phase(F, 1, WSP(bf16, WS_U), NB, 3 * MIXW, WSP(bf16, WS_O), 2048, 1024); }
            SEAM(11);
            if (IN(12)) { merge_phase(F); }
            SEAM(12);
        }
        const int pb = layer == 0 ? 6 : 13;
        if (IN(pb)) { const int K = layer == 0 ? D : 2048;
            pg8::Gemm g{WSP(bf16, WS_O), layer == 0 ? WSP(bf16, WS_WOUTA) : WSP(bf16, WS_WOUTB), MPAD, D, K}; pg8::StaticOrder S; S.init(MPAD, D, F.G, cb);
            pg8::EpiRes E{layer == 0 ? F.a->in[I_XP] : F.out, layer == 0 ? F.a->in[I_XS] : F.out + (size_t)MP * D, F.out, WSP(bf16, WS_XA), WSP(float, WS_SS) + (size_t)(2 * layer + 1) * (SS_STRIDE / 4), D, M};
            pg8::gemm_phase<pg8::EpiRes, pg8::StaticOrder, true, true>(ring, g, S, E); }
        SEAM(pb);
        if (IN(pb + 1)) { pg8::Gemm g{WSP(bf16, WS_XA), WSP(bf16, WS_WFI) + (size_t)layer * NFI * D, MPAD, NFI, D}; pg8::StaticOrder S; S.init(MPAD, NFI, F.G, cb);
            pg8::EpiSwiGLU E{WSP(bf16, WS_HID), DFF, {WSP(float, WS_SS) + (size_t)(2 * layer + 1) * (SS_STRIDE / 4)}};
            pg8::gemm_phase<pg8::EpiSwiGLU, pg8::StaticOrder, true, true>(ring, g, S, E); }
        SEAM(pb + 1);
        if (IN(pb + 2)) { pg8::Gemm g{WSP(bf16, WS_HID), WSP(bf16, WS_WFO) + (size_t)layer * D * DFF, MPAD, D, DFF}; pg8::StaticOrder S; S.init(MPAD, D, F.G, cb);
            pg8::EpiRes E{F.out, F.out + (size_t)MP * D, F.out, WSP(bf16, WS_XA), WSP(float, WS_SS) + (size_t)(2 * layer + 2) * (SS_STRIDE / 4), D, M};
            pg8::gemm_phase<pg8::EpiRes, pg8::StaticOrder, true, true>(ring, g, S, E); }
        if (layer == 0) SEAM(8);
    }
#undef IN
#undef SEAM
}

extern "C" void kernel_launch(void* const* d_in, const int* in_sizes, int n_in, void* d_out, int out_size, void* d_ws, size_t ws_size, hipStream_t stream) {
    static int grid = 0;
    if (grid == 0) {
        if (n_in != N_IN || (size_t)out_size != OUT_END || ws_size < WS_END) { fprintf(stderr, "kernel_launch: unexpected sizes: n_in %d out %d (want %zu) ws %zu (want %zu)\n", n_in, out_size, (size_t)OUT_END, ws_size, (size_t)WS_END); grid = -1; return; }
        int dev = 0, cus = 0, per_cu = 0;
        if (hipGetDevice(&dev) != hipSuccess || hipDeviceGetAttribute(&cus, hipDeviceAttributeMultiprocessorCount, dev) != hipSuccess) { grid = -1; return; }
        if (hipFuncSetAttribute((const void*)mega_fwd, hipFuncAttributeMaxDynamicSharedMemorySize, LDS_BYTES) != hipSuccess) { fprintf(stderr, "kernel_launch: hipFuncSetAttribute failed\n"); grid = -1; return; }
        if (hipOccupancyMaxActiveBlocksPerMultiprocessor(&per_cu, (const void*)mega_fwd, NWAVES * 64, LDS_BYTES) != hipSuccess || per_cu < 1) fprintf(stderr, "kernel_launch: occupancy query says %d\n", per_cu);
        (void)hipGetLastError();
        grid = cus;
    }
    if (grid < 0) return;
    if (hipMemsetAsync((char*)d_ws + WS_CTL, 0, CTL_ZERO_BYTES, stream) != hipSuccess) return;
    Args a{};
    for (int i = 0; i < N_IN; ++i) a.in[i] = (const float*)d_in[i];
    a.out = (float*)d_out; a.ws = (unsigned char*)d_ws;
#if defined(MK_PER_PHASE)
    for (int p = 0; p <= 15 && p <= MK_STOP_AFTER; ++p) { a.ph_lo = p; a.ph_hi = p + 1; hipLaunchKernelGGL(mega_fwd, dim3(grid), dim3(NWAVES * 64), LDS_BYTES, stream, a); }
#else
    a.ph_lo = 0; a.ph_hi = 16;
    hipLaunchKernelGGL(mega_fwd, dim3(grid), dim3(NWAVES * 64), LDS_BYTES, stream, a);
#endif
    const hipError_t le = hipPeekAtLastError();
    if (le != hipSuccess) fprintf(stderr, "kernel_launch: launch failed: %s\n", hipGetErrorName(le));
}
```

```cpp
#include <hip/hip_runtime.h>
#include <cstdio>
#include <cstdint>
namespace pg8 {
#define PG8_LAS __attribute__((address_space(3)))
typedef unsigned short bf16_t;
typedef short bf16x8 __attribute__((ext_vector_type(8)));
typedef float f32x4 __attribute__((ext_vector_type(4)));
typedef unsigned u32x4 __attribute__((ext_vector_type(4)));
constexpr int BM = 256, BK = 64, HALF = 128, HTB = HALF * BK * 2  , STAGE_BYTES = 8 * HTB, NXCD = 8, WGM = 8;

__host__ __device__ __forceinline__ int lds_byte(int r, int c) { const int st = (r >> 4) * 2 + (c >> 5), rr = r & 15, cc = c & 31, ob = rr * 64 + cc * 2; return st * 1024 + (ob ^ (((ob >> 9) & 1) << 5)); }
__host__ __device__ __forceinline__ void stage_rc(int b, int& R, int& C) { const int st = b / 1024, sb = b % 1024, swz = sb ^ (((sb >> 9) & 1) << 5); R = (st >> 1) * 16 + swz / 64; C = (st & 1) * 32 + (swz % 64) / 2; }
__host__ __device__ __forceinline__ int perm32(int rho) { const int n = rho >> 4, i = rho & 15; return 8 * (i >> 2) + 4 * n + (i & 3); }

struct Unit { int pm, pn; };
struct Gemm { const bf16_t* A; const bf16_t* Bt; int M, N, K; int ld = 0; int ldb = 0; };

struct StaticOrder {
    int nM, nN, nwg, G, c;
    __host__ __device__ void init(int M, int N, int G_, int c_) { nM = M / BM; nN = N / BM; nwg = nM * nN; G = G_; c = c_; }
    __host__ __device__ bool next(int i, Unit& u) const {
        const long L = (long)i * G + c; if (L >= nwg) return false;
        int wgid = (int)L; { const int q = nwg / NXCD, r = nwg % NXCD, xcd = wgid % NXCD, off = wgid / NXCD; wgid = (xcd < r ? xcd * (q + 1) : r * (q + 1) + (xcd - r) * q) + off; }
        const int nig = WGM * nN, gid = wgid / nig, fm = gid * WGM, gsz = (nM - fm) < WGM ? (nM - fm) : WGM;
        u.pm = fm + ((wgid % nig) % gsz); u.pn = (wgid % nig) / gsz; return true;
    }
    __device__ __forceinline__ void a_ready(const Unit&) const {}
    __device__ __forceinline__ void done(const Unit&) const {}
};

__device__ __forceinline__ unsigned cvt_pk_bf16(float lo, float hi) { unsigned r; asm volatile("v_cvt_pk_bf16_f32 %0, %1, %2" : "=v"(r) : "v"(lo), "v"(hi)); return r; }
typedef float f32x2 __attribute__((ext_vector_type(2)));
template <int RS> struct RowScale {
    const float* p; __attribute__((address_space(3))) float* cache;
    __device__ __forceinline__ void prepare(int pm) const {
        if constexpr (RS == 3) {
            volatile __attribute__((address_space(3))) int* tagp = (volatile __attribute__((address_space(3))) int*)(cache + 256);
            if (__builtin_amdgcn_readfirstlane(tagp[0]) != pm) { const int t = (int)threadIdx.x;
                const f32x4* q = (const f32x4*)(p + (size_t)(pm * BM + (t >> 1)) * 64 + (t & 1) * 32);
                f32x4 a[8];
#pragma unroll
                for (int i = 0; i < 8; ++i) a[i] = q[i];
                float s = 0.f;
#pragma unroll
                for (int i = 0; i < 8; ++i) s += (a[i][0] + a[i][1]) + (a[i][2] + a[i][3]);
                s += __shfl_xor(s, 1);
                if ((t & 1) == 0) cache[t >> 1] = 1.0f / sqrtf(s * (1.0f / 4096.0f) + 1e-6f);
                __syncthreads();
                if (t == 0) tagp[0] = pm;
            }
        }
    }
    __device__ __forceinline__ float get(int row, int fq) const {
        if constexpr (RS == 0) { return 1.f; }
        else if constexpr (RS == 1) { return p[row]; }
        else if constexpr (RS == 3) { return cache[row & (BM - 1)]; }
        else {
            const f32x4* q = (const f32x4*)(p + (size_t)row * 64 + fq * 16);
            const f32x4 a = q[0], b = q[1], c = q[2], d = q[3];
            float s = ((a[0] + a[1]) + (a[2] + a[3])) + ((b[0] + b[1]) + (b[2] + b[3])) + ((c[0] + c[1]) + (c[2] + c[3])) + ((d[0] + d[1]) + (d[2] + d[3]));
            s += __shfl_xor(s, 16); s += __shfl_xor(s, 32);
            return 1.0f / sqrtf(s * (1.0f / 4096.0f) + 1e-6f);
        }
    }
};
template <int RS> struct EpiB16 {
    static constexpr bool PERM = true, AFTER_DRAIN = false;
    bf16_t* O; int ldc; RowScale<RS> rs;
    __device__ __forceinline__ void operator()(const f32x4 (&acc)[2][2][4][2], const Unit& u, int wr, int wc, int fr, int fq) const {
        const int row0 = u.pm * BM + wr * 64 + fr, col0 = u.pn * BM + wc * 32 + 8 * fq;
        rs.prepare(u.pm);
        float sc[2][4];
#pragma unroll
        for (int ai = 0; ai < 2; ++ai)
#pragma unroll
            for (int m = 0; m < 4; ++m) sc[ai][m] = rs.get(row0 + ai * HALF + m * 16, fq);
#pragma unroll
        for (int ai = 0; ai < 2; ++ai)
#pragma unroll
            for (int m = 0; m < 4; ++m) { const int row = row0 + ai * HALF + m * 16; bf16_t* rowp = O + (size_t)row * ldc + col0;
#pragma unroll
                for (int bj = 0; bj < 2; ++bj) { const f32x4 v0 = acc[ai][bj][m][0] * sc[ai][m], v1 = acc[ai][bj][m][1] * sc[ai][m];
                    u32x4 w; w.x = cvt_pk_bf16(v0[0], v0[1]); w.y = cvt_pk_bf16(v0[2], v0[3]); w.z = cvt_pk_bf16(v1[0], v1[1]); w.w = cvt_pk_bf16(v1[2], v1[3]);
                    *(u32x4*)(rowp + bj * HALF) = w; } }
    }
};
__device__ __forceinline__ float silu_mul(float g, float u) { return g * u * __builtin_amdgcn_rcpf(1.0f + __builtin_amdgcn_exp2f(-1.44269504089f * g)); }
struct EpiSwiGLU {
    static constexpr bool PERM = true, AFTER_DRAIN = false;
    bf16_t* O; int ldc; RowScale<3> rs;
    __device__ __forceinline__ void operator()(const f32x4 (&acc)[2][2][4][2], const Unit& u, int wr, int wc, int fr, int fq) const {
        const int row0 = u.pm * BM + wr * 64 + fr, col0 = u.pn * HALF + wc * 32 + 8 * fq;
        rs.prepare(u.pm);
        float scv[2][4];
#pragma unroll
        for (int ai = 0; ai < 2; ++ai)
#pragma unroll
            for (int m = 0; m < 4; ++m) scv[ai][m] = rs.get(row0 + ai * HALF + m * 16, fq);
#pragma unroll
        for (int ai = 0; ai < 2; ++ai)
#pragma unroll
            for (int m = 0; m < 4; ++m) { const int row = row0 + ai * HALF + m * 16; const float sc = scv[ai][m];
                const f32x4 g0 = acc[ai][0][m][0] * sc, g1 = acc[ai][0][m][1] * sc, u0 = acc[ai][1][m][0] * sc, u1 = acc[ai][1][m][1] * sc;
                u32x4 w; w.x = cvt_pk_bf16(silu_mul(g0[0], u0[0]), silu_mul(g0[1], u0[1])); w.y = cvt_pk_bf16(silu_mul(g0[2], u0[2]), silu_mul(g0[3], u0[3]));
                w.z = cvt_pk_bf16(silu_mul(g1[0], u1[0]), silu_mul(g1[1], u1[1])); w.w = cvt_pk_bf16(silu_mul(g1[2], u1[2]), silu_mul(g1[3], u1[3]));
                *(u32x4*)(O + (size_t)row * ldc + col0) = w; }
    }
};
struct EpiF32 {
    static constexpr bool PERM = false, AFTER_DRAIN = false;
    float* C; int ldc; RowScale<1> rs;
    __device__ __forceinline__ void operator()(const f32x4 (&acc)[2][2][4][2], const Unit& u, int wr, int wc, int fr, int fq) const {
        const int row0 = u.pm * BM + wr * 64 + fr, col0 = u.pn * BM + wc * 32 + 4 * fq;
#pragma unroll
        for (int ai = 0; ai < 2; ++ai)
#pragma unroll
            for (int m = 0; m < 4; ++m) { const int row = row0 + ai * HALF + m * 16; const float sc = rs.get(row, fq); float* rowp = C + (size_t)row * ldc + col0;
#pragma unroll
                for (int bj = 0; bj < 2; ++bj)
#pragma unroll
                    for (int n = 0; n < 2; ++n) *(f32x4*)(rowp + bj * HALF + n * 16) = acc[ai][bj][m][n] * sc; }
    }
};
__device__ __forceinline__ float decay_fn(float x) {
    const float sg = __builtin_amdgcn_rcpf(1.0f + __builtin_amdgcn_exp2f(-1.44269504089f * x));
    return __builtin_amdgcn_exp2f((-1.44269504089f * 0.60653065971f) * sg);
}
template <int MODE> struct EpiScanSlot {
    static constexpr bool PERM = false, AFTER_DRAIN = false;
    float* bufP; float* bufS; const float* bias; int slot; int mrows;
    __device__ __forceinline__ float fn(float x) const { if constexpr (MODE == 0) return decay_fn(x); else return __builtin_amdgcn_rcpf(1.0f + __builtin_amdgcn_exp2f(-1.44269504089f * x)); }
    __device__ __forceinline__ void operator()(const f32x4 (&acc)[2][2][4][2], const Unit& u, int wr, int wc, int fr, int fq) const {
        const int col0 = u.pn * BM + wc * 32 + 4 * fq;
        if (u.pm < 32) {
            const int t0 = (u.pm & 7) * 256 + wr * 64 + fr; float* b0 = bufP + (size_t)(u.pm >> 3) * 48 * 2048 * 384 + (size_t)slot * 64;
#pragma unroll
            for (int bj = 0; bj < 2; ++bj)
#pragma unroll
                for (int n = 0; n < 2; ++n) { const int c = col0 + bj * HALF + n * 16; const f32x4 bv = *(const f32x4*)(bias + c); float* bc = b0 + ((size_t)(c >> 6) * 2048 + t0) * 384 + (c & 63);
#pragma unroll
                    for (int ai = 0; ai < 2; ++ai)
#pragma unroll
                        for (int m = 0; m < 4; ++m) { const f32x4 x = acc[ai][bj][m][n] + bv; f32x4 o; o[0] = fn(x[0]); o[1] = fn(x[1]); o[2] = fn(x[2]); o[3] = fn(x[3]);
                            *(f32x4*)(bc + (size_t)(ai * HALF + m * 16) * 384) = o; }
                    asm volatile("" ::: "memory"); }
        } else if (wr == 0) {
#pragma unroll
            for (int bj = 0; bj < 2; ++bj)
#pragma unroll
                for (int n = 0; n < 2; ++n) { const int c = col0 + bj * HALF + n * 16; const f32x4 bv = *(const f32x4*)(bias + c);
#pragma unroll
                    for (int m = 0; m < 4; ++m) { const int lr = m * 16 + fr; const f32x4 x = acc[0][bj][m][n] + bv; f32x4 o; o[0] = fn(x[0]); o[1] = fn(x[1]); o[2] = fn(x[2]); o[3] = fn(x[3]);
                        *(f32x4*)(bufS + (((size_t)((lr >> 3) * 48 + (c >> 6)) * 8 + (lr & 7)) * 6 + slot) * 64 + (c & 63)) = o; }
                    asm volatile("" ::: "memory"); }
        }
    }
};
template <int MODE> struct EpiAct {
    static constexpr bool PERM = false, AFTER_DRAIN = false;
    float* C; int ldc; const float* bias;
    __device__ __forceinline__ float fn(float x) const { if constexpr (MODE == 0) return decay_fn(x); else return __builtin_amdgcn_rcpf(1.0f + __builtin_amdgcn_exp2f(-1.44269504089f * x)); }
    __device__ __forceinline__ void operator()(const f32x4 (&acc)[2][2][4][2], const Unit& u, int wr, int wc, int fr, int fq) const {
        const int row0 = u.pm * BM + wr * 64 + fr, col0 = u.pn * BM + wc * 32 + 4 * fq;
        f32x4 bvv[2][2];
#pragma unroll
        for (int bj = 0; bj < 2; ++bj)
#pragma unroll
            for (int n = 0; n < 2; ++n) bvv[bj][n] = *(const f32x4*)(bias + col0 + bj * HALF + n * 16);
#pragma unroll
        for (int bj = 0; bj < 2; ++bj)
#pragma unroll
            for (int n = 0; n < 2; ++n) { const int c = col0 + bj * HALF + n * 16; const f32x4 bv = bvv[bj][n]; float* bc = C + (size_t)row0 * ldc + c;
#pragma unroll
                for (int ai = 0; ai < 2; ++ai)
#pragma unroll
                    for (int m = 0; m < 4; ++m) { const f32x4 x = acc[ai][bj][m][n] + bv; f32x4 o; o[0] = fn(x[0]); o[1] = fn(x[1]); o[2] = fn(x[2]); o[3] = fn(x[3]);
                        *(f32x4*)(bc + (size_t)(ai * HALF + m * 16) * ldc) = o; }
                asm volatile("" ::: "memory"); }
    }
};
template <bool BASE16, bool WY, bool FEED> struct EpiRes {
    static constexpr bool PERM = true, AFTER_DRAIN = false;
    const float* baseP; const float* baseS; float* Y; bf16_t* XA; float* SS; int ldc; int mrows;
    __device__ __forceinline__ void operator()(const f32x4 (&acc)[2][2][4][2], const Unit& u, int wr, int wc, int fr, int fq) const {
        const int row0 = u.pm * BM + wr * 64 + fr, col0 = u.pn * BM + wc * 32 + 8 * fq;
#pragma unroll
        for (int ai = 0; ai < 2; ++ai) {
            u32x4 b16[4][2]; f32x4 b32[4][2][2];
#pragma unroll
            for (int m = 0; m < 4; ++m)
#pragma unroll
                for (int bj = 0; bj < 2; ++bj) { const size_t off = (size_t)(row0 + ai * HALF + m * 16) * ldc + col0 + bj * HALF;
                    if constexpr (BASE16) b16[m][bj] = *(const u32x4*)(XA + off);
                    else { b32[m][bj][0] = *(const f32x4*)(baseP + off); b32[m][bj][1] = *(const f32x4*)(baseP + off + 4); } }
#pragma unroll
            for (int m = 0; m < 4; ++m) { const int row = row0 + ai * HALF + m * 16; float q = 0.f;
#pragma unroll
                for (int bj = 0; bj < 2; ++bj) { const size_t off = (size_t)row * ldc + col0 + bj * HALF; f32x4 s0, s1;
                    if constexpr (BASE16) { const u32x4 w = b16[m][bj];
                        s0 = (f32x4){__builtin_bit_cast(float, w.x << 16), __builtin_bit_cast(float, w.x & 0xffff0000u), __builtin_bit_cast(float, w.y << 16), __builtin_bit_cast(float, w.y & 0xffff0000u)};
                        s1 = (f32x4){__builtin_bit_cast(float, w.z << 16), __builtin_bit_cast(float, w.z & 0xffff0000u), __builtin_bit_cast(float, w.w << 16), __builtin_bit_cast(float, w.w & 0xffff0000u)}; }
                    else { s0 = b32[m][bj][0]; s1 = b32[m][bj][1]; }
                    const f32x4 y0 = s0 + acc[ai][bj][m][0], y1 = s1 + acc[ai][bj][m][1];
                    q += ((y0[0] * y0[0] + y0[1] * y0[1]) + (y0[2] * y0[2] + y0[3] * y0[3])) + ((y1[0] * y1[0] + y1[1] * y1[1]) + (y1[2] * y1[2] + y1[3] * y1[3]));
                    if constexpr (WY) { *(f32x4*)(Y + off) = y0; *(f32x4*)(Y + off + 4) = y1; }
                    if constexpr (FEED) { u32x4 w; w.x = cvt_pk_bf16(y0[0], y0[1]); w.y = cvt_pk_bf16(y0[2], y0[3]); w.z = cvt_pk_bf16(y1[0], y1[1]); w.w = cvt_pk_bf16(y1[2], y1[3]); *(u32x4*)(XA + off) = w; } }
                if constexpr (FEED) { q += __shfl_xor(q, 16); q += __shfl_xor(q, 32);
                    if (fq == 0) SS[(size_t)row * 64 + u.pn * 4 + wc] = q; } }
        }
    }
};
template <class Epi, class Sched, bool ALIGN_EPI = false, bool SP2 = false>
__device__ __forceinline__ void gemm_phase(PG8_LAS unsigned char* lds, const Gemm g, const Sched& S, const Epi& E) {
    int tid = threadIdx.x; asm volatile("" : "+v"(tid));
    const int wid = __builtin_amdgcn_readfirstlane(tid >> 6), lane = tid & 63, wr = wid >> 2, wc = wid & 3, fr = lane & 15, fq = lane >> 4;
    int K = g.K; asm volatile("" : "+s"(K));
    const int nt = K / BK;
    int LD = g.ld ? g.ld : g.K; asm volatile("" : "+s"(LD)); int LDB = g.ldb ? g.ldb : LD; asm volatile("" : "+s"(LDB));
    unsigned voffA[2], voffB[2];
#pragma unroll
    for (int i = 0; i < 2; ++i) { int R, C; stage_rc(tid * 16 + i * 8192, R, C); const int Rb = Epi::PERM ? ((R & ~31) + perm32(R & 31)) : R;
        voffA[i] = (unsigned)(R * LD + C) * 2u; voffB[i] = (unsigned)(Rb * LDB + C) * 2u; }
    const size_t kstep = (size_t)(BK * 2);
    const size_t hstep = (size_t)HALF * LD * 2;
    const size_t tstep = 2 * hstep;
    const size_t hstepB = (size_t)HALF * LDB * 2, tstepB = 2 * hstepB;
    const unsigned ldsw = (unsigned)wid * 1024u;
    const int aoff = lds_byte(wr * 64 + fr, fq * 8), boff = lds_byte(wc * 32 + fr, fq * 8);
#define PG8_SA(b, h) (((b) * 2 + (h)) * HTB)
#define PG8_SB(b, h) ((4 + (b) * 2 + (h)) * HTB)
#define PG8_STAGE(bufoff, gbase, voff) do { _Pragma("unroll") for (int _i = 0; _i < 2; ++_i) \
        __builtin_amdgcn_global_load_lds((const unsigned*)((const char*)(gbase) + (voff)[_i]), (PG8_LAS unsigned*)(lds + (bufoff) + ldsw + _i * 8192), 16, 0, 0); } while (0)
#define PG8_LDA(dst, b, h) do { _Pragma("unroll") for (int m = 0; m < 4; ++m) _Pragma("unroll") for (int k = 0; k < 2; ++k) dst[m][k] = *(const PG8_LAS bf16x8*)(lds + PG8_SA(b, h) + aoff + m * 2048 + k * 1024); } while (0)
#define PG8_LDB(dst, b, h) do { _Pragma("unroll") for (int n = 0; n < 2; ++n) _Pragma("unroll") for (int k = 0; k < 2; ++k) dst[n][k] = *(const PG8_LAS bf16x8*)(lds + PG8_SB(b, h) + boff + n * 2048 + k * 1024); } while (0)
#define PG8_MMA(ai, bj, At, Bt) do { __builtin_amdgcn_s_setprio(1); _Pragma("unroll") for (int m = 0; m < 4; ++m) _Pragma("unroll") for (int n = 0; n < 2; ++n) _Pragma("unroll") for (int k = 0; k < 2; ++k) \
        acc[ai][bj][m][n] = __builtin_amdgcn_mfma_f32_16x16x32_bf16(Bt[n][k], At[m][k], acc[ai][bj][m][n], 0, 0, 0); __builtin_amdgcn_s_setprio(0); } while (0)
#define PG8_WAIT_V(n) asm volatile("s_waitcnt vmcnt(" #n ")" ::: "memory")
#define PG8_WAIT_L(n) asm volatile("s_waitcnt lgkmcnt(" #n ")" ::: "memory")
#define PG8_BAR __builtin_amdgcn_s_barrier()
#define PG8_SCHED __builtin_amdgcn_sched_barrier(0)
    Unit cur, nxt; int ui = 0;
    if (!S.next(0, cur)) return;
    f32x4 acc[2][2][4][2];
#pragma unroll
    for (int a = 0; a < 2; ++a)
#pragma unroll
        for (int b = 0; b < 2; ++b)
#pragma unroll
            for (int m = 0; m < 4; ++m)
#pragma unroll
                for (int n = 0; n < 2; ++n) acc[a][b][m][n] = (f32x4){0.f, 0.f, 0.f, 0.f};
    bf16x8 At[4][2], B0[2][2], B1[2][2];
    const char* cA = (const char*)g.A + (size_t)cur.pm * tstep; const char* cB = (const char*)g.Bt + (size_t)cur.pn * tstepB;
    S.a_ready(cur);
    if constexpr (SP2) {
        PG8_STAGE(PG8_SB(0, 0), cB, voffB); PG8_STAGE(PG8_SB(0, 1), cB + hstepB, voffB); PG8_STAGE(PG8_SA(0, 0), cA, voffA); PG8_STAGE(PG8_SA(0, 1), cA + hstep, voffA);
        if (wr == 1) PG8_BAR;
        PG8_WAIT_V(2); PG8_BAR;
        PG8_STAGE(PG8_SB(1, 0), cB + kstep, voffB); PG8_STAGE(PG8_SA(1, 0), cA + kstep, voffA); PG8_STAGE(PG8_SB(1, 1), cB + hstepB + kstep, voffB);
        PG8_WAIT_V(6); PG8_BAR;
    } else {
        PG8_STAGE(PG8_SB(0, 0), cB, voffB); PG8_STAGE(PG8_SA(0, 0), cA, voffA); PG8_STAGE(PG8_SB(0, 1), cB + hstepB, voffB); PG8_STAGE(PG8_SA(0, 1), cA + hstep, voffA);
        if (wr == 1) PG8_BAR;
        PG8_WAIT_V(4); PG8_BAR;
        PG8_STAGE(PG8_SB(1, 0), cB + kstep, voffB); PG8_STAGE(PG8_SA(1, 0), cA + kstep, voffA); PG8_STAGE(PG8_SB(1, 1), cB + hstepB + kstep, voffB);
        PG8_WAIT_V(6); PG8_BAR;
    }
    for (;;) {
        const bool has_next = S.next(ui + 1, nxt);
        const char* nA = has_next ? (const char*)g.A + (size_t)nxt.pm * tstep : cA; const char* nB = has_next ? (const char*)g.Bt + (size_t)nxt.pn * tstepB : cB;
        for (int t = 0; t < nt; t += 2) {
            const bool last = (t == nt - 2);
            const char* a1 = cA + (size_t)(t + 1) * kstep;
            const char* a2 = last ? nA : cA + (size_t)(t + 2) * kstep; const char* b2 = last ? nB : cB + (size_t)(t + 2) * kstep;
            const char* a3 = a2 + kstep; const char* b3 = b2 + kstep;
            if (last && has_next) S.a_ready(nxt);
            if constexpr (SP2) {
            PG8_LDB(B0, 0, 0); PG8_LDB(B1, 0, 1); PG8_SCHED; PG8_LDA(At, 0, 0); PG8_STAGE(PG8_SA(1, 1), a1 + hstep, voffA);
            PG8_WAIT_V(8); PG8_WAIT_L(0); PG8_BAR; PG8_MMA(0, 0, At, B0); PG8_MMA(0, 1, At, B1); PG8_BAR; PG8_SCHED;
            PG8_LDA(At, 0, 1); PG8_STAGE(PG8_SB(0, 0), b2, voffB); PG8_STAGE(PG8_SB(0, 1), b2 + hstepB, voffB); PG8_STAGE(PG8_SA(0, 0), a2, voffA);
            PG8_WAIT_V(8); PG8_WAIT_L(0); PG8_BAR; PG8_MMA(1, 0, At, B0); PG8_MMA(1, 1, At, B1); PG8_BAR; PG8_SCHED;
            PG8_LDB(B0, 1, 0); PG8_LDB(B1, 1, 1); PG8_SCHED; PG8_LDA(At, 1, 0); PG8_STAGE(PG8_SA(0, 1), a2 + hstep, voffA);
            PG8_WAIT_V(8); PG8_WAIT_L(0); PG8_BAR; PG8_MMA(0, 0, At, B0); PG8_MMA(0, 1, At, B1); PG8_BAR; PG8_SCHED;
            PG8_LDA(At, 1, 1); PG8_STAGE(PG8_SB(1, 0), b3, voffB); PG8_STAGE(PG8_SB(1, 1), b3 + hstepB, voffB); PG8_STAGE(PG8_SA(1, 0), a3, voffA);
            PG8_WAIT_V(8); PG8_WAIT_L(0); PG8_BAR; PG8_MMA(1, 0, At, B0); PG8_MMA(1, 1, At, B1); PG8_BAR; PG8_SCHED;
            } else {
            PG8_LDB(B0, 0, 0); PG8_SCHED; PG8_LDA(At, 0, 0); PG8_STAGE(PG8_SA(1, 1), a1 + hstep, voffA);
            PG8_WAIT_L(8); PG8_BAR; PG8_WAIT_L(0); PG8_MMA(0, 0, At, B0); PG8_BAR; PG8_SCHED;
            PG8_LDB(B1, 0, 1); PG8_STAGE(PG8_SB(0, 0), b2, voffB);
            PG8_BAR; PG8_WAIT_L(0); PG8_MMA(0, 1, At, B1); PG8_BAR;
            PG8_LDA(At, 0, 1); PG8_STAGE(PG8_SA(0, 0), a2, voffA);
            PG8_BAR; PG8_WAIT_L(0); PG8_MMA(1, 0, At, B0); PG8_BAR; PG8_SCHED;
            PG8_STAGE(PG8_SB(0, 1), b2 + hstepB, voffB);
            PG8_WAIT_V(6); PG8_BAR; PG8_MMA(1, 1, At, B1); PG8_BAR;
            PG8_LDB(B0, 1, 0); PG8_SCHED; PG8_LDA(At, 1, 0); PG8_STAGE(PG8_SA(0, 1), a2 + hstep, voffA);
            PG8_WAIT_L(8); PG8_BAR; PG8_WAIT_L(0); PG8_MMA(0, 0, At, B0); PG8_BAR; PG8_SCHED;
            PG8_LDB(B1, 1, 1); PG8_STAGE(PG8_SB(1, 0), b3, voffB);
            PG8_BAR; PG8_WAIT_L(0); PG8_MMA(0, 1, At, B1); PG8_BAR;
            PG8_LDA(At, 1, 1); PG8_STAGE(PG8_SA(1, 0), a3, voffA);
            PG8_BAR; PG8_WAIT_L(0); PG8_MMA(1, 0, At, B0); PG8_BAR; PG8_SCHED;
            PG8_STAGE(PG8_SB(1, 1), b3 + hstepB, voffB);
            PG8_WAIT_V(6); PG8_BAR; PG8_MMA(1, 1, At, B1); PG8_BAR;
            }
        }
        if constexpr (ALIGN_EPI) { if (wr == 0) PG8_BAR; }
        if constexpr (!Epi::AFTER_DRAIN) { E(acc, cur, wr, wc, fr, fq); S.done(cur); }
        if (!has_next) break;
#pragma unroll
        for (int a = 0; a < 2; ++a)
#pragma unroll
            for (int b = 0; b < 2; ++b)
#pragma unroll
                for (int m = 0; m < 4; ++m)
#pragma unroll
                    for (int n = 0; n < 2; ++n) acc[a][b][m][n] = (f32x4){0.f, 0.f, 0.f, 0.f};
        cur = nxt; cA = nA; cB = nB; ++ui;
        if constexpr (ALIGN_EPI) { if (wr == 1) PG8_BAR; }
    }
    PG8_WAIT_V(0);
    if constexpr (!ALIGN_EPI) { if (wr == 0) PG8_BAR; }
    PG8_BAR;
    if constexpr (Epi::AFTER_DRAIN) { E.fused(acc, cur, wr, wc, fr, fq, lds, wid, lane); S.done(cur); }
#undef PG8_SA
#undef PG8_SB
#undef PG8_STAGE
#undef PG8_LDA
#undef PG8_LDB
#undef PG8_MMA
#undef PG8_WAIT_V
#undef PG8_WAIT_L
#undef PG8_BAR
#undef PG8_SCHED
}
}
#define GAS __attribute__((address_space(1)))
#define LAS __attribute__((address_space(3)))
typedef unsigned short bf16;
typedef unsigned v4u __attribute__((ext_vector_type(4)));
typedef float f32x4 __attribute__((ext_vector_type(4)));
typedef short bf16x8 __attribute__((ext_vector_type(8)));
typedef GAS unsigned gu32;
typedef GAS unsigned long long gu64;
#define RLX_AGENT __ATOMIC_RELAXED, __HIP_MEMORY_SCOPE_AGENT
#define LDS_WAIT() asm volatile("s_waitcnt lgkmcnt(0)" ::: "memory")
#define VM_WAIT() asm volatile("s_waitcnt vmcnt(0)" ::: "memory")
__device__ __forceinline__ unsigned long long rt() { return __builtin_amdgcn_s_memrealtime(); }
typedef float f32x2_cv __attribute__((ext_vector_type(2)));
typedef __bf16 bf16x2_cv __attribute__((ext_vector_type(2)));
__device__ __forceinline__ unsigned pk2(float lo, float hi) { const f32x2_cv v = {lo, hi}; return __builtin_bit_cast(unsigned, __builtin_convertvector(v, bf16x2_cv)); }
__device__ __forceinline__ unsigned f2bf(float f) { return pk2(f, 0.f) & 0xffffu; }

#define XB_TMO      128
#define XB_XCNT(j)  (256  + 64 * (j))
#define XB_XSUB(j)  (1280 + 64 * (j))
#define XB_XGEN(j)  (2304 + 64 * (j))
#define XB_TOP      3328
#define XB_TOPGEN   3392
#define XCD_BAR_WORDS 3456
#define XB_SPIN_CAP (1u << 18)

__device__ __forceinline__ unsigned xb_ld(unsigned* p)              { return __hip_atomic_load(p, __ATOMIC_RELAXED, __HIP_MEMORY_SCOPE_AGENT); }
__device__ __forceinline__ unsigned xb_add(unsigned* p, unsigned v) { return __hip_atomic_fetch_add(p, v, __ATOMIC_RELAXED, __HIP_MEMORY_SCOPE_AGENT); }
__device__ __forceinline__ unsigned xb_xcc_id() { return (unsigned)__builtin_amdgcn_s_getreg((3 << 11) | 20) & 0xFu; }
#define XB_SPIN(cond, bar) do { unsigned _sp = 0; while (cond) { __builtin_amdgcn_s_sleep(1); \
    if ((++_sp & 255u) == 0u) { if (xb_ld(&(bar)[XB_TMO])) break; if (_sp > XB_SPIN_CAP) { atomicAdd(&(bar)[XB_TMO], 1u); break; } } } } while (0)

struct XcdBarrier {
    unsigned* bar; unsigned x;
    volatile LAS unsigned* st;
};

__device__ __forceinline__ XcdBarrier xcd_barrier_post(unsigned* bar, volatile LAS unsigned* st) {
    XcdBarrier b; b.bar = bar; b.x = xb_xcc_id(); b.st = st;
    if (threadIdx.x == 0) (void)xb_add(&bar[XB_XCNT(b.x)], 1u);
    return b;
}
__device__ __forceinline__ void xcd_barrier_complete(unsigned* bar, unsigned x, unsigned& nloc, unsigned& nx) {
    const unsigned G = gridDim.x * gridDim.y * gridDim.z;
    unsigned sum, cnt, mine, sp = 0u;
    for (;;) {
        sum = 0u; cnt = 0u; mine = 0u;
#pragma unroll
        for (unsigned j = 0; j < 16; ++j) { const unsigned c = xb_ld(&bar[XB_XCNT(j)]); sum += c; cnt += (c > 0u) ? 1u : 0u; mine = (j == x) ? c : mine; }
        if (sum == G) break;
        __builtin_amdgcn_s_sleep(1);
        if ((++sp & 255u) == 0u) { if (xb_ld(&bar[XB_TMO])) break; if (sp > XB_SPIN_CAP) { atomicAdd(&bar[XB_TMO], 1u); break; } }
    }
    nloc = mine > 0u ? mine : 1u; nx = cnt > 0u ? cnt : 1u;
}

__device__ __forceinline__ void xcd_barrier(const XcdBarrier& b) {
    asm volatile("s_waitcnt vmcnt(0)" ::: "memory");
    __syncthreads();
    if (threadIdx.x == 0) {
        unsigned* bar = b.bar;
        __builtin_amdgcn_s_waitcnt(0);
        unsigned nloc = b.st[0], nx = b.st[1];
        if (nloc == 0u) { xcd_barrier_complete(bar, b.x, nloc, nx); b.st[0] = nloc; b.st[1] = nx; }
        const unsigned old = xb_add(&bar[XB_XSUB(b.x)], 1u);
        const unsigned gen = old / nloc;
        if (old + 1u == (gen + 1u) * nloc) {
            __builtin_amdgcn_fence(__ATOMIC_RELEASE, "agent");
            asm volatile("s_waitcnt vmcnt(0)" ::: "memory");
            const unsigned og = xb_add(&bar[XB_TOP], 1u);
            const unsigned tg = og / nx;
            if (og + 1u == (tg + 1u) * nx) xb_add(&bar[XB_TOPGEN], 1u);
            else XB_SPIN(xb_ld(&bar[XB_TOPGEN]) == tg, bar);
            __builtin_amdgcn_fence(__ATOMIC_ACQUIRE, "agent");
            xb_add(&bar[XB_XGEN(b.x)], 1u);
            asm volatile("s_waitcnt vmcnt(0)" ::: "memory");
        } else {
            XB_SPIN(xb_ld(&bar[XB_XGEN(b.x)]) == gen, bar);
            __builtin_amdgcn_fence(__ATOMIC_ACQUIRE, "agent");
            asm volatile("s_waitcnt vmcnt(0)" ::: "memory");
        }
    }
    __syncthreads();
}
constexpr int NWAVES = 8;
constexpr int D = 4096, MP = 8192, MS = 64, M = MP + MS, MPAD = 8448;
constexpr int SEQ = 2048, DSEQ = 8, NBP = 4, NBS = 8;
constexpr int MIXW = 3072, ASW = 9792, AINW = 10816, NA = 11008;
constexpr int NB = 10240, DFF = 11008, NFI = 22016;
constexpr int NMEM = 256, MEMW = 1024, AH = 48;
constexpr float RMS_EPS = 1e-6f, LNX_EPS = 64e-5f;
constexpr float LOG2E = 1.44269504089f, LN2 = 0.69314718056f;

constexpr size_t MiB = 1u << 20;
constexpr size_t WS_CTL = 0, CTL_ZERO_BYTES = 1 * MiB;
constexpr size_t WS_WMEM = 1 * MiB;
constexpr size_t WS_WINA = WS_WMEM + 32 * MiB;
constexpr size_t WS_WOUTA = WS_WINA + 86 * MiB;
constexpr size_t WS_WINB = WS_WOUTA + 32 * MiB;
constexpr size_t WS_WOUTB = WS_WINB + 80 * MiB;
constexpr size_t WS_WFI = WS_WOUTB + 16 * MiB;
constexpr size_t WS_WFO = WS_WFI + 344 * MiB;
constexpr size_t WS_W2 = WS_WFO + 172 * MiB;
constexpr size_t WS_A2 = WS_W2 + 2 * MiB;
constexpr size_t WS_G2 = WS_A2 + 2 * MiB;
constexpr size_t WS_XA = WS_G2 + 3 * MiB;
constexpr size_t WS_XM = WS_XA + 66 * MiB;
constexpr size_t WS_RSTDM = WS_XM + 8 * MiB;
constexpr size_t WS_SS = WS_RSTDM + 1 * MiB;
constexpr size_t SS_STRIDE = 3 * MiB;
constexpr size_t WS_U = WS_SS + 15 * MiB;
constexpr size_t WS_HID = WS_U + 178 * MiB;
constexpr size_t WS_O = WS_HID + 178 * MiB;
constexpr size_t WS_XLW = WS_O + 66 * MiB;
constexpr size_t WS_XLA = WS_XLW + 5 * MiB;
constexpr size_t WS_XLG = WS_XLA + 5 * MiB;
constexpr size_t WS_G = WS_XLG + 7 * MiB;
constexpr size_t WS_SCANP = WS_G + 50 * MiB;
constexpr size_t WS_SCANS = WS_SCANP + 576 * MiB;
constexpr size_t WS_MEMRAW = WS_SCANS + 5 * MiB;
constexpr size_t WS_KP = WS_MEMRAW + 16 * MiB;
constexpr size_t WS_VTP = WS_KP + 4 * MiB;
constexpr size_t WS_KS = WS_VTP + 4 * MiB;
constexpr size_t WS_VTS = WS_KS + 8 * MiB;
constexpr size_t WS_QN = WS_VTS + 8 * MiB;
constexpr size_t WS_KN = WS_QN + 48 * MiB;
constexpr size_t WS_VT = WS_KN + 48 * MiB;
constexpr size_t WS_OG = WS_VT + 48 * MiB;
constexpr size_t WS_LSE = WS_OG + 48 * MiB;
constexpr size_t WS_QS = WS_LSE + 1 * MiB;
constexpr size_t WS_YRAW = WS_QS + 1 * MiB;
constexpr size_t WS_OGS = WS_YRAW + 97 * MiB;
constexpr size_t WS_SPLITK = WS_OGS + 1 * MiB;
constexpr size_t WS_WARR = WS_SCANP;
constexpr size_t WS_AARR = WS_SCANP + 128 * MiB;
constexpr size_t WS_ZRAW = WS_SPLITK + 4 * MiB;
constexpr size_t WS_END = WS_ZRAW + 97 * MiB;
#ifndef DFFP_V
#define DFFP_V 12288
#endif
constexpr int DFFP = DFFP_V;
#ifndef KFIP_V
#define KFIP_V 4096
#endif
constexpr int KFIP = KFIP_V;
constexpr size_t WS_WFOP = WS_SCANP + 256 * MiB;
constexpr int CW_BAR = 4096;

constexpr size_t OUT_Y = 0;
constexpr size_t OUT_WKVP = (size_t)M * D;
constexpr size_t OUT_SHIFTP = OUT_WKVP + 4 * 48 * 4096;
constexpr size_t OUT_SWAP1 = OUT_SHIFTP + 4 * ASW;
constexpr size_t OUT_SWAP2 = OUT_SWAP1 + (size_t)4 * 128 * 2048;
constexpr size_t OUT_SWAP3 = OUT_SWAP2 + (size_t)4 * 512 * 2048;
constexpr size_t OUT_MEMKV = OUT_SWAP3 + (size_t)4 * 2048 * 2048;
constexpr size_t OUT_WKVS = OUT_MEMKV + (size_t)2 * 1024 * 2048;
constexpr size_t OUT_SHIFTS = OUT_WKVS + 8 * 48 * 4096;
constexpr size_t OUT_SWAS1 = OUT_SHIFTS + 8 * ASW;
constexpr size_t OUT_SWAS2 = OUT_SWAS1 + (size_t)8 * 128 * 2048;
constexpr size_t OUT_SWAS3 = OUT_SWAS2 + (size_t)8 * 512 * 2048;
constexpr size_t OUT_END = OUT_SWAS3 + (size_t)8 * 2048 * 2048;

constexpr int RING_OFF = 0, RING_BYTES = 131072;
constexpr int LDSCTL_OFF = RING_BYTES, MISC_OFF = LDSCTL_OFF + 320;
constexpr int LDS_BYTES = 147456;

enum { I_XP = 0, I_XS, I_SWKV, I_SSHIFT, I_C1, I_C2, I_C3, I_CMEM, I_MEM, I_NMIX, I_NFFN, I_NMEM, I_WMEM, I_QNM, I_KNM,
       I_WINA, I_WOUTA, I_MU, I_W0, I_W2, I_A0, I_A2, I_G2, I_KK, I_KA, I_RK, I_LNG, I_LNB, I_WINB, I_WOUTB, I_QNB, I_KNB, I_WFI, I_WFO, N_IN };

struct Args { const float* in[N_IN]; float* out; unsigned char* ws; };
struct Frame {
    LAS unsigned char* lds;
    volatile LAS unsigned* MISC;
    gu32* ctl;
    int tid, lane, wave;
    int vcu, G;
    int gw, NGW;
    const struct Args* a;
    float* out; unsigned char* ws;
};
#define WSP(T, off) ((T*)(F.ws + (off)))
__device__ __forceinline__ int opaque_v(int x) { asm volatile("" : "+v"(x)); return x; }
__device__ __forceinline__ int opaque_s(int x) { asm volatile("" : "+s"(x)); return x; }
#define PHASE_LOCAL(F) do { F.lane = opaque_v(F.lane); F.gw = opaque_s(F.gw); } while (0)

__device__ __forceinline__ float wave_sum(float v) {
#pragma unroll
    for (int o = 1; o < 64; o <<= 1) v += __shfl_xor(v, o);
    return v;
}
__device__ __forceinline__ float wave_max(float v) {
#pragma unroll
    for (int o = 1; o < 64; o <<= 1) v = fmaxf(v, __shfl_xor(v, o));
    return v;
}
typedef float f32x2 __attribute__((ext_vector_type(2)));
__device__ __forceinline__ float bf2f(unsigned short b) { return __builtin_bit_cast(float, (unsigned)b << 16); }

__device__ __forceinline__ void tr_load(float (&v)[32], const float* W, int Ksrc, int ldw, int k0, int n0, int lane) {
    const float* wp = W + (size_t)(k0 + (lane >> 5)) * ldw + n0 + (lane & 31);
    if (k0 + 64 <= Ksrc) {
#pragma unroll
        for (int i = 0; i < 32; ++i) v[i] = wp[(size_t)(2 * i) * ldw];
    } else {
#pragma unroll
        for (int i = 0; i < 32; ++i) v[i] = (k0 + 2 * i + (lane >> 5)) < Ksrc ? wp[(size_t)(2 * i) * ldw] : 0.f;
    }
}
__device__ __forceinline__ void tr_store(float (&v)[32], int Ksrc, bf16* WT, int Kdst, int drow, const float* gain, LAS float* scr, int k0, int lane) {
    if (gain) {
#pragma unroll
        for (int i = 0; i < 32; ++i) { const int k = k0 + 2 * i + (lane >> 5); v[i] *= (k < Ksrc ? gain[k] : 0.f); }
    }
#pragma unroll
    for (int i = 0; i < 32; ++i) scr[(2 * i + (lane >> 5)) * 33 + (lane & 31)] = v[i];
    LDS_WAIT(); asm volatile("" ::: "memory");
    const int c = lane & 7;
#pragma unroll
    for (int j = 0; j < 4; ++j) { const int n = (lane >> 3) + 8 * j; const LAS float* s = scr + (8 * c) * 33 + n;
        v4u o; o.x = pk2(s[0 * 33], s[1 * 33]); o.y = pk2(s[2 * 33], s[3 * 33]); o.z = pk2(s[4 * 33], s[5 * 33]); o.w = pk2(s[6 * 33], s[7 * 33]);
        *(GAS v4u*)(WT + (size_t)(drow + n) * Kdst + k0 + 8 * c) = o; }
    LDS_WAIT(); asm volatile("" ::: "memory");
}
struct TrBuf { f32x4 v[8]; f32x4 g0, g1; };
__device__ __forceinline__ void tr4_load(TrBuf& b, const float* W, int ldw, const float* gain, int k0, int n0, int lane) {
    const float* gp = gain ? gain + k0 + 8 * (lane & 7) : W;
    b.g0 = *(const GAS f32x4*)gp; b.g1 = *(const GAS f32x4*)(gp + 4);
    const float* wp = W + (size_t)(k0 + (lane >> 3)) * ldw + n0 + 4 * (lane & 7);
#pragma unroll
    for (int i = 0; i < 8; ++i) b.v[i] = *(const GAS f32x4*)(wp + (size_t)(8 * i) * ldw);
}
__device__ __forceinline__ void tr4_store(TrBuf& b, bool hasgain, bf16* WT, int Kdst, int drow, LAS float* scr, int k0, int lane) {
    { const int kr = lane >> 3, n4 = lane & 7, L = (kr >> 2) ^ n4; LAS float* wb = scr + n4 * 256 + (kr & 3);
#pragma unroll
      for (int i = 0; i < 8; ++i) { const int Ci = ((2 * i) & 7) ^ (i >> 2); LAS float* w = wb + 4 * (((2 * i) & 8) | (Ci ^ L));
        w[0] = b.v[i].x; w[64] = b.v[i].y; w[128] = b.v[i].z; w[192] = b.v[i].w; } }
    LDS_WAIT(); asm volatile("" ::: "memory");
    const int c = lane & 7, nn = lane >> 3;
    const f32x4 g0 = hasgain ? b.g0 : (f32x4){1.f, 1.f, 1.f, 1.f}, g1 = hasgain ? b.g1 : (f32x4){1.f, 1.f, 1.f, 1.f};
#pragma unroll
    for (int j = 0; j < 4; ++j) { const int n = nn + 8 * j, q = (nn >> 2) ^ (2 * j) ^ (c >> 2);
        const f32x4 x0 = *(const LAS f32x4*)(scr + n * 64 + 4 * (((2 * c) & 8) | ((((2 * c) & 7) ^ q) & 7))) * g0;
        const f32x4 x1 = *(const LAS f32x4*)(scr + n * 64 + 4 * (((2 * c) & 8) | ((((2 * c + 1) & 7) ^ q) & 7))) * g1;
        v4u o; o.x = pk2(x0.x, x0.y); o.y = pk2(x0.z, x0.w); o.z = pk2(x1.x, x1.y); o.w = pk2(x1.z, x1.w);
        *(GAS v4u*)(WT + (size_t)(drow + n) * Kdst + k0 + 8 * c) = o; }
    LDS_WAIT(); asm volatile("" ::: "memory");
}
__device__ __forceinline__ void tr_item(const float* W, int Ksrc, int ldw, bf16* WT, int Kdst, int drow, const float* gain, LAS float* scr, int k0, int n0, int lane) {
    float v[32]; tr_load(v, W, Ksrc, ldw, k0, n0, lane); tr_store(v, Ksrc, WT, Kdst, drow, gain, scr, k0, lane);
}
template <int MAP> __device__ __forceinline__ void tr_matrix_w(int me, int NW, int lane, LAS float* scr, const float* W, int Ksrc, int N, bf16* WT, int Kdst, const float* gain, int& rot) {
    const int nblk = N / 32, items = (Kdst / 64) * nblk;
    int it = me - rot; if (it < 0) it += NW;
    float v[32];
    if (it < items) tr_load(v, W, Ksrc, N, 64 * (it / nblk), 32 * (it % nblk), lane);
    while (it < items) {
        const int kb = it / nblk, nb = it % nblk, n0 = 32 * nb; int drow = n0;
        if (MAP == 1) { const int up = n0 >= DFF, j = n0 - up * DFF; drow = 256 * (j >> 7) + 128 * up + (j & 127); }
        const int nx = it + NW; float vn[32];
        if (nx < items) tr_load(vn, W, Ksrc, N, 64 * (nx / nblk), 32 * (nx % nblk), lane);
        tr_store(v, Ksrc, WT, Kdst, drow, gain, scr, 64 * kb, lane);
        if (nx < items) {
#pragma unroll
            for (int i = 0; i < 32; ++i) v[i] = vn[i];
        }
        it = nx;
    }
    rot = (rot + items) % NW;
}
template <int MAP> __device__ __forceinline__ void tr4_matrix_w(int me, int NW, int lane, LAS float* scr, const float* W, int N, bf16* WT, int Kdst, const float* gain, int& rot) {
    const int nblk = N / 32, items = (Kdst / 64) * nblk;
    int it = me - rot; if (it < 0) it += NW;
    if (it < items) { const int lastit = it + ((items - 1 - it) / NW) * NW; TrBuf b0, b1, b2;
#define T4_LOAD(b, x) do { const int x_ = min((x), lastit); tr4_load(b, W, N, gain, 64 * (x_ / nblk), 32 * (x_ % nblk), lane); } while (0)
#define T4_STORE(b, x) do { const int x_ = min((x), lastit), kb_ = x_ / nblk, n0_ = 32 * (x_ % nblk); int drow_ = n0_; \
            if (MAP == 1) { const int up_ = n0_ >= DFF, j_ = n0_ - up_ * DFF; drow_ = 256 * (j_ >> 7) + 128 * up_ + (j_ & 127); } \
            tr4_store(b, gain != nullptr, WT, Kdst, drow_, scr, 64 * kb_, lane); } while (0)
        T4_LOAD(b0, it); T4_LOAD(b1, it + NW);
        for (; it < items; it += 3 * NW) { T4_LOAD(b2, it + 2 * NW); T4_STORE(b0, it); T4_LOAD(b0, it + 3 * NW); T4_STORE(b1, it + NW); T4_LOAD(b1, it + 4 * NW); T4_STORE(b2, it + 2 * NW); }
#undef T4_LOAD
#undef T4_STORE
    }
    rot = (rot + items) % NW;
}
template <int MAP> __device__ __forceinline__ void tr_matrix(Frame& F, LAS float* scr, const float* W, int Ksrc, int N, bf16* WT, int Kdst, const float* gain, int& rot) {
    tr_matrix_w<MAP>(F.gw, F.NGW, F.lane, scr, W, Ksrc, N, WT, Kdst, gain, rot);
}
__device__ __forceinline__ float row_to_bf16(const float* xrow, bf16* orow, int lane) {
    const GAS f32x4* xr = (const GAS f32x4*)xrow + lane; float s = 0.f;
#pragma unroll
    for (int h = 0; h < 2; ++h) { f32x4 v[8];
#pragma unroll
        for (int j = 0; j < 8; ++j) v[j] = xr[64 * (8 * h + j)];
#pragma unroll
        for (int j = 0; j < 8; ++j) { s += (v[j].x * v[j].x + v[j].y * v[j].y) + (v[j].z * v[j].z + v[j].w * v[j].w);
            ((GAS unsigned long long*)orow)[lane + 64 * (8 * h + j)] = (unsigned long long)pk2(v[j].x, v[j].y) | ((unsigned long long)pk2(v[j].z, v[j].w) << 32); } }
    return wave_sum(s);
}
__device__ __forceinline__ void p0_prologue(Frame F) { PHASE_LOCAL(F);
    LAS float* scr = (LAS float*)(F.lds + RING_OFF + F.wave * 16384);
    int rot = 0;
    tr4_matrix_w<0>(F.gw, F.NGW, F.lane, scr, F.a->in[I_WINA], AINW, WSP(bf16, WS_WINA), D, F.a->in[I_NMIX], rot);
    tr4_matrix_w<0>(F.gw, F.NGW, F.lane, scr, F.a->in[I_WMEM], 2048, WSP(bf16, WS_WMEM), D, F.a->in[I_NMEM], rot);
    tr4_matrix_w<0>(F.gw, F.NGW, F.lane, scr, F.a->in[I_WMEM] + (size_t)D * 2048, 2048, WSP(bf16, WS_WMEM) + (size_t)2048 * D, D, F.a->in[I_NMEM] + D, rot);
    tr_matrix<0>(F, scr, F.a->in[I_W2], 96, MIXW, WSP(bf16, WS_W2), 256, nullptr, rot);
    tr_matrix<0>(F, scr, F.a->in[I_A2], 96, MIXW, WSP(bf16, WS_A2), 256, nullptr, rot);
    tr_matrix<0>(F, scr, F.a->in[I_G2], 384, MIXW, WSP(bf16, WS_G2), 384, nullptr, rot);
    { GAS v4u* z = (GAS v4u*)(WSP(bf16, WS_WINA) + (size_t)AINW * D); const size_t n16 = (size_t)(NA - AINW) * D * 2 / 16;
      for (size_t i = (size_t)F.gw * 64 + F.lane; i < n16; i += (size_t)F.NGW * 64) z[i] = (v4u){0u, 0u, 0u, 0u}; }
    { const float* C = F.a->in[I_CMEM];
      for (int it = F.gw; it < 2 * 8 * 4 * 32; it += F.NGW) { const int lbh = it >> 5, sub = it & 31, kb = sub >> 3, nb = sub & 7, lb = lbh >> 2, h = lbh & 3;
          tr_item(C + (size_t)lb * 256 * 2048 + 1024 + h * 256, 256, 2048, WSP(bf16, WS_VTS) + (size_t)lbh * 65536, 256, 32 * nb, nullptr, scr, 64 * kb, 32 * nb, F.lane); }
      for (int it = F.gw; it < 2 * 8 * 256; it += F.NGW) { const int lb = it >> 8, key = it & 255; const float* src = C + (size_t)it * 2048;
#pragma unroll
          for (int h = 0; h < 4; ++h) { const f32x4 v = *(const GAS f32x4*)(src + h * 256 + 4 * F.lane);
              *(GAS unsigned long long*)(WSP(bf16, WS_KS) + ((size_t)(lb * 4 + h) * 256 + key) * 256 + 4 * F.lane) = (unsigned long long)pk2(v.x, v.y) | ((unsigned long long)pk2(v.z, v.w) << 32); } } }
    for (int m = F.gw; m < M; m += F.NGW) { const float* xr = m < MP ? F.a->in[I_XP] + (size_t)m * D : F.a->in[I_XS] + (size_t)(m - MP) * D;
        const float s = row_to_bf16(xr, WSP(bf16, WS_XA) + (size_t)m * D, F.lane); WSP(float, WS_SS)[(size_t)m * 64 + F.lane] = F.lane == 0 ? s : 0.f; }
    for (int m = F.gw; m < NBP * NMEM; m += F.NGW) { const float s = row_to_bf16(F.a->in[I_MEM] + (size_t)m * D, WSP(bf16, WS_XM) + (size_t)m * D, F.lane);
        if (F.lane == 0) WSP(float, WS_RSTDM)[m] = 1.0f / sqrtf(s * (1.0f / D) + RMS_EPS); }
}
struct ShiftRow { const bf16* u; const bf16* up; const float* st; bool hasprev; bool zero; };
__device__ __forceinline__ ShiftRow shift_row(Frame& F, int row) {
    ShiftRow s; s.u = WSP(bf16, WS_U) + (size_t)row * NA; s.up = s.u - NA;
    const bool isP = row < MP; const int t = isP ? (row & (SEQ - 1)) : ((row - MP) & (DSEQ - 1));
    s.hasprev = t > 0; s.zero = isP; s.st = F.a->in[I_SSHIFT] + (size_t)(isP ? 0 : ((row - MP) >> 3)) * ASW;
    return s;
}
__device__ __forceinline__ float shift_mix(const ShiftRow& s, const float* mu, int c) {
    const float uc = bf2f(s.u[c]); const float pv = s.hasprev ? bf2f(s.up[c]) : (s.zero ? 0.f : s.st[c]);
    return uc + (pv - uc) * mu[c];
}
template <int CTRL> __device__ __forceinline__ float dpp(float x) { return __builtin_bit_cast(float, __builtin_amdgcn_mov_dpp(__builtin_bit_cast(int, x), CTRL, 0xf, 0xf, true)); }
__device__ __forceinline__ float sum8(float x) { x += dpp<0xB1>(x); x += dpp<0x4E>(x); x += dpp<0x141>(x); return x; }
__device__ __forceinline__ float sum16(float x) { x = sum8(x); x += dpp<0x128>(x); return x; }
__device__ __forceinline__ f32x4 bf4_to_f32(unsigned lo, unsigned hi) { return (f32x4){__builtin_bit_cast(float, lo << 16), __builtin_bit_cast(float, lo & 0xffff0000u), __builtin_bit_cast(float, hi << 16), __builtin_bit_cast(float, hi & 0xffff0000u)}; }
typedef unsigned u32x2 __attribute__((ext_vector_type(2)));
__device__ __forceinline__ f32x4 shift_mix4(const ShiftRow& s, const float* mu, int c) {
    const u32x2 uw = *(const GAS u32x2*)(s.u + c); const f32x4 uc = bf4_to_f32(uw.x, uw.y); f32x4 pv;
    if (s.hasprev) { const u32x2 pw = *(const GAS u32x2*)(s.up + c); pv = bf4_to_f32(pw.x, pw.y); } else if (s.zero) pv = (f32x4){0.f, 0.f, 0.f, 0.f}; else pv = *(const GAS f32x4*)(s.st + c);
    return uc + (pv - uc) * *(const GAS f32x4*)(mu + c);
}
__device__ __forceinline__ void p2_lora_prep(Frame F) { PHASE_LOCAL(F);
    const float* mu = F.a->in[I_MU];
    for (int row = F.gw; row < M; row += F.NGW) {
        const ShiftRow s = shift_row(F, row);
        bf16* xw = WSP(bf16, WS_XLW) + (size_t)row * 256; bf16* xa = WSP(bf16, WS_XLA) + (size_t)row * 256; bf16* xg = WSP(bf16, WS_XLG) + (size_t)row * 384;
#pragma unroll
        for (int i = 0; i < 3; ++i) { const int j = 4 * (F.lane + 64 * i);
            if (j < 576) { const f32x4 x = shift_mix4(s, mu, 3 * MIXW + j); f32x4 y; bf16* dst;
                if (j < 96) { y = (f32x4){tanhf(x.x), tanhf(x.y), tanhf(x.z), tanhf(x.w)}; dst = xw + j; }
                else if (j < 192) { y = x; dst = xa + (j - 96); }
                else { y = (f32x4){1.0f / (1.0f + expf(-x.x)), 1.0f / (1.0f + expf(-x.y)), 1.0f / (1.0f + expf(-x.z)), 1.0f / (1.0f + expf(-x.w))}; dst = xg + (j - 192); }
                u32x2 o; o.x = pk2(y.x, y.y); o.y = pk2(y.z, y.w); *(GAS u32x2*)dst = o; } }
        if (F.lane < 40) { *(GAS u32x2*)(xw + 96 + 4 * F.lane) = (u32x2){0u, 0u}; *(GAS u32x2*)(xa + 96 + 4 * F.lane) = (u32x2){0u, 0u}; }
        const bool isP = row < MP; const int t = isP ? (row & (SEQ - 1)) : ((row - MP) & (DSEQ - 1));
        if (t == (isP ? SEQ - 1 : DSEQ - 1)) { float* o = F.out + (isP ? OUT_SHIFTP + (size_t)(row >> 11) * ASW : OUT_SHIFTS + (size_t)((row - MP) >> 3) * ASW);
            for (int c = 4 * F.lane; c < ASW; c += 256) { const u32x2 uw = *(const GAS u32x2*)(s.u + c); *(GAS f32x4*)(o + c) = bf4_to_f32(uw.x, uw.y); } }
    }
}
__device__ __forceinline__ void p2_memkv_post(Frame F) { PHASE_LOCAL(F);
    LAS float* scr = (LAS float*)(F.lds + RING_OFF + F.wave * 16384);
    const float* RAW = WSP(float, WS_MEMRAW);
    for (int it = F.gw; it < 2 * 4 * 4 * 32; it += F.NGW) { const int lbh = it >> 5, sub = it & 31, kb = sub >> 3, nb = sub & 7, lb = lbh >> 2, h = lbh & 3;
        tr_item(RAW + (size_t)lb * 256 * 2048 + 1024 + h * 256, 256, 2048, WSP(bf16, WS_VTP) + (size_t)lbh * 65536, 256, 32 * nb, nullptr, scr, 64 * kb, 32 * nb, F.lane); }
    for (int it = F.gw; it < 2 * 1024; it += F.NGW) { const int l = it >> 10, row = it & 1023, b = row >> 8, key = row & 255; const float* src = RAW + (size_t)it * 2048; float* o = F.out + OUT_MEMKV + (size_t)it * 2048;
        const float* gk = F.a->in[I_KNM] + l * 256;
#pragma unroll
        for (int h = 0; h < 4; ++h) { const f32x4 v = *(const GAS f32x4*)(src + h * 256 + 4 * F.lane); const f32x4 g = *(const GAS f32x4*)(gk + 4 * F.lane);
            const float ss = wave_sum((v.x * v.x + v.y * v.y) + (v.z * v.z + v.w * v.w)); const float r = 1.0f / sqrtf(ss * (1.0f / 256.0f) + RMS_EPS);
            const f32x4 kn = v * r * g; *(GAS f32x4*)(o + h * 256 + 4 * F.lane) = kn;
            *(GAS unsigned long long*)(WSP(bf16, WS_KP) + ((size_t)((l * 4 + b) * 4 + h) * 256 + key) * 256 + 4 * F.lane) = (unsigned long long)pk2(kn.x, kn.y) | ((unsigned long long)pk2(kn.z, kn.w) << 32);
            *(GAS f32x4*)(o + 1024 + h * 256 + 4 * F.lane) = *(const GAS f32x4*)(src + 1024 + h * 256 + 4 * F.lane); } }
}
__device__ __forceinline__ float* scan_ptr(Frame& F, int row, int h) {
    if (row < MP) return WSP(float, WS_SCANP) + ((size_t)((row >> 11) * AH + h) * SEQ + (row & (SEQ - 1))) * 384;
    const int sr = row - MP; return WSP(float, WS_SCANS) + ((size_t)((sr >> 3) * AH + h) * DSEQ + (sr & (DSEQ - 1))) * 384;
}
struct P4In { u32x2 ur, uk, uv, pr, pk, pv; f32x4 mr, mk, mv, a, kka, kaa; };
__device__ __forceinline__ f32x4 mix4(u32x2 uw, u32x2 pw, f32x4 mu) { const f32x4 uc = bf4_to_f32(uw.x, uw.y), pc = bf4_to_f32(pw.x, pw.y); return uc + (pc - uc) * mu; }
template <bool DRY> __device__ __forceinline__ void p4_scan_prep_t(Frame F) { PHASE_LOCAL(F);
    const float* mu = F.a->in[I_MU]; const float* kk_a = F.a->in[I_KK]; const float* ka_a = F.a->in[I_KA];
    for (int un = F.gw; un < M * 4; un += F.NGW) { const int row = un >> 2, itb = (un & 3) * 3;
        const ShiftRow s = shift_row(F, row);
        if (s.hasprev) {
            for (int it0 = itb; it0 < itb + 3; it0 += 3) { P4In in[3];
#pragma unroll
                for (int j = 0; j < 3; ++j) { const int c = 256 * (it0 + j) + 4 * F.lane; const float* sp = scan_ptr(F, row, 4 * (it0 + j) + (F.lane >> 4)) + 4 * (F.lane & 15);
                    in[j].ur = *(const GAS u32x2*)(s.u + c); in[j].uk = *(const GAS u32x2*)(s.u + MIXW + c); in[j].uv = *(const GAS u32x2*)(s.u + 2 * MIXW + c);
                    in[j].pr = *(const GAS u32x2*)(s.up + c); in[j].pk = *(const GAS u32x2*)(s.up + MIXW + c); in[j].pv = *(const GAS u32x2*)(s.up + 2 * MIXW + c);
                    in[j].mr = *(const GAS f32x4*)(mu + c); in[j].mk = *(const GAS f32x4*)(mu + MIXW + c); in[j].mv = *(const GAS f32x4*)(mu + 2 * MIXW + c);
                    in[j].a = *(const GAS f32x4*)(sp + 256); in[j].kka = *(const GAS f32x4*)(kk_a + c); in[j].kaa = *(const GAS f32x4*)(ka_a + c); }
#pragma unroll
                for (int j = 0; j < 3; ++j) { float* sp = scan_ptr(F, row, 4 * (it0 + j) + (F.lane >> 4)) + 4 * (F.lane & 15);
                    const f32x4 r = mix4(in[j].ur, in[j].pr, in[j].mr), k = mix4(in[j].uk, in[j].pk, in[j].mk), v = mix4(in[j].uv, in[j].pv, in[j].mv), a = in[j].a;
                    f32x4 kk = k * in[j].kka; const float n2 = sum16((kk.x * kk.x + kk.y * kk.y) + (kk.z * kk.z + kk.w * kk.w)); kk = kk * (1.0f / fmaxf(sqrtf(n2), 1e-12f));
                    const f32x4 k2 = k * (1.0f + (a - 1.0f) * in[j].kaa);
                    *(GAS f32x4*)sp = r; *(GAS f32x4*)(sp + 128) = k2; *(GAS f32x4*)(sp + 192) = -kk; if (!DRY) *(GAS f32x4*)(sp + 256) = kk * a; *(GAS f32x4*)(sp + 320) = v;
                    *(GAS f32x4*)(WSP(float, WS_AARR) + (size_t)row * MIXW + 256 * (it0 + j) + 4 * F.lane) = a; }
            }
        } else {
#pragma unroll 3
        for (int it = itb; it < itb + 3; ++it) { const int c = 256 * it + 4 * F.lane; float* sp = scan_ptr(F, row, 4 * it + (F.lane >> 4)) + 4 * (F.lane & 15);
            const f32x4 r = shift_mix4(s, mu, c), k = shift_mix4(s, mu, MIXW + c), v = shift_mix4(s, mu, 2 * MIXW + c);
            const f32x4 a = *(const GAS f32x4*)(sp + 256);
            f32x4 kk = k * *(const GAS f32x4*)(kk_a + c); const float n2 = sum16((kk.x * kk.x + kk.y * kk.y) + (kk.z * kk.z + kk.w * kk.w)); kk = kk * (1.0f / fmaxf(sqrtf(n2), 1e-12f));
            const f32x4 k2 = k * (1.0f + (a - 1.0f) * *(const GAS f32x4*)(ka_a + c));
            *(GAS f32x4*)sp = r; *(GAS f32x4*)(sp + 128) = k2; *(GAS f32x4*)(sp + 192) = -kk; if (!DRY) *(GAS f32x4*)(sp + 256) = kk * a; *(GAS f32x4*)(sp + 320) = v;
            *(GAS f32x4*)(WSP(float, WS_AARR) + (size_t)row * MIXW + c) = a; }
        }
    }
}
struct TrDesc { const float* W; bf16* WT; const float* gain; int Ksrc, N, Kdst, map, nblk; };
constexpr int BG_C0 = 64 * 128, BG_C1 = BG_C0 + 64 * 688, BG_C2 = BG_C1 + 172 * 128, BG_C3 = BG_C2 + 64 * 320, BG_C4 = BG_C3 + 32 * 128, BG_C5 = BG_C4 + 64 * 688, BG_C6 = BG_C5 + 172 * 128;
constexpr int BG_NCOPY = (8 * (120 + 504 + 2040) * 512) / 2048;
constexpr int CW_QA = 64, CW_QB = 128, CW_SKQ = 192;
__device__ __forceinline__ int q_grab(gu32* ctr, int lane) { unsigned v = 0u; if (lane == 0) v = __hip_atomic_fetch_add(ctr, 1u, __ATOMIC_RELAXED, __HIP_MEMORY_SCOPE_AGENT); return (int)__builtin_amdgcn_readfirstlane(v); }
__device__ __forceinline__ void bg_resolve(Frame& F, int it, TrDesc& d, int& loc) {
    if (it < BG_C0) { d = TrDesc{F.a->in[I_WOUTA], WSP(bf16, WS_WOUTA), nullptr, D, D, D, 0, D / 32}; loc = it; }
    else if (it < BG_C1) { d = TrDesc{F.a->in[I_WFI], WSP(bf16, WS_WFI), F.a->in[I_NFFN], D, NFI, KFIP, 1, NFI / 32}; loc = it - BG_C0; }
    else if (it < BG_C2) { d = TrDesc{F.a->in[I_WFO], WSP(bf16, WS_WFOP), nullptr, DFF, D, DFFP, 0, D / 32}; loc = it - BG_C1; }
    else if (it < BG_C3) { d = TrDesc{F.a->in[I_WINB], WSP(bf16, WS_WINB), F.a->in[I_NMIX] + D, D, NB, D, 0, NB / 32}; loc = it - BG_C2; }
    else if (it < BG_C4) { d = TrDesc{F.a->in[I_WOUTB], WSP(bf16, WS_WOUTB), nullptr, 2048, D, 2048, 0, D / 32}; loc = it - BG_C3; }
    else if (it < BG_C5) { d = TrDesc{F.a->in[I_WFI] + (size_t)D * NFI, WSP(bf16, WS_WFI) + (size_t)NFI * KFIP, F.a->in[I_NFFN] + D, D, NFI, KFIP, 1, NFI / 32}; loc = it - BG_C4; }
    else { d = TrDesc{F.a->in[I_WFO] + (size_t)DFF * D, WSP(bf16, WS_WFOP) + (size_t)D * DFFP, nullptr, DFF, D, DFFP, 0, D / 32}; loc = it - BG_C5; }
}
constexpr int BG_GRAB = 32;
__device__ __forceinline__ void bg_load(Frame& F, int it, TrBuf& b) { TrDesc d; int loc; bg_resolve(F, it, d, loc); tr4_load(b, d.W, d.N, d.gain, 64 * (loc / d.nblk), 32 * (loc % d.nblk), F.lane); }
__device__ __forceinline__ void bg_store(Frame& F, int it, TrBuf& b, LAS float* scr) { TrDesc d; int loc; bg_resolve(F, it, d, loc);
    const int kb = loc / d.nblk, n0 = 32 * (loc % d.nblk); int drow = n0;
    if (d.map) { const int up = n0 >= DFF, j = n0 - up * DFF; drow = 256 * (j >> 7) + 128 * up + (j & 127); }
    tr4_store(b, d.gain != nullptr, d.WT, d.Kdst, drow, scr, 64 * kb, F.lane); }
__device__ __forceinline__ void bg_range(Frame& F, int base, int end, LAS float* scr) { const int last = end - 1;
    TrBuf b0, b1, b2, b3;
    bg_load(F, base, b0); bg_load(F, min(base + 1, last), b1); bg_load(F, min(base + 2, last), b2);
    for (int it = base; it < end; it += 4) {
        bg_load(F, min(it + 3, last), b3); bg_store(F, it, b0, scr);
        bg_load(F, min(it + 4, last), b0); bg_store(F, min(it + 1, last), b1, scr);
        bg_load(F, min(it + 5, last), b1); bg_store(F, min(it + 2, last), b2, scr);
        bg_load(F, min(it + 6, last), b2); bg_store(F, min(it + 3, last), b3, scr);
    }
}
constexpr int SCH = 8;
constexpr int P5_SCR_STRIDE = 8704;
template <int SNB> __device__ __forceinline__ void p5_scan_wg(Frame F, int task, int& gch) { PHASE_LOCAL(F);
    constexpr int P5_FLAGS = SNB * SCH * 1536;
    const bool isP = task < NBP * AH; const int sh = isP ? task : task - NBP * AH; const int seq = sh / AH, h = sh % AH; const int T = isP ? SEQ : DSEQ;
    const int steps = T < SCH ? T : SCH, nch = T / steps; const int row0 = isP ? seq * SEQ : MP + seq * DSEQ;
    LAS float* stage = (LAS float*)(F.lds + RING_OFF);
    volatile LAS unsigned* FL = (volatile LAS unsigned*)(F.lds + RING_OFF + P5_FLAGS);
    const int w = F.wave, co = F.lane & 7, rp = F.lane >> 3;
    if (w >= 4) {
        const int L = w - 4, cc = 64 * h + F.lane;
        const float mur = F.a->in[I_MU][cc], muk = F.a->in[I_MU][MIXW + cc], muv = F.a->in[I_MU][2 * MIXW + cc], kka = F.a->in[I_KK][cc], kaa = F.a->in[I_KA][cc], rkc = F.a->in[I_RK][cc];
        volatile LAS float* BS = (volatile LAS float*)(F.lds + RING_OFF + P5_FLAGS + 256);
        const bf16* Ub = WSP(bf16, WS_U) + (size_t)row0 * NA + cc; const float* wb = WSP(float, WS_WARR) + (size_t)row0 * MIXW + cc; const float* ab = WSP(float, WS_AARR) + (size_t)row0 * MIXW + cc;
        const float* st0 = isP ? nullptr : F.a->in[I_SSHIFT] + (size_t)seq * ASW + cc;
        struct LdSet { unsigned u[3][9]; float w[8], a[8]; };
#define LD_ISSUE(S, chx) do { const int t0_ = (chx) * SCH; _Pragma("unroll") for (int j_ = 0; j_ < 9; ++j_) { const int t_ = t0_ + j_ - 1; const bf16* up_ = Ub + (size_t)(t_ < 0 ? 0 : t_) * NA; \
            S.u[0][j_] = up_[0]; S.u[1][j_] = up_[MIXW]; S.u[2][j_] = up_[2 * MIXW]; } \
        _Pragma("unroll") for (int j_ = 0; j_ < 8; ++j_) { S.w[j_] = wb[(size_t)(t0_ + j_) * MIXW]; S.a[j_] = ab[(size_t)(t0_ + j_) * MIXW]; } } while (0)
#define LD_COMPUTE(S, chx) do { const int c_ = gch + (chx), b_ = c_ & (SNB - 1); \
            while ((int)min(min(FL[16], FL[17]), min(FL[18], FL[19])) < c_ - (SNB - 1)) __builtin_amdgcn_s_sleep(1); \
            asm volatile("" ::: "memory"); \
            LAS float* st_ = stage + b_ * SCH * 384 + F.lane; \
            float pr_ = __builtin_bit_cast(float, S.u[0][0] << 16), pk_ = __builtin_bit_cast(float, S.u[1][0] << 16), pv_ = __builtin_bit_cast(float, S.u[2][0] << 16); \
            if ((chx) == 0) { if (isP) { pr_ = 0.f; pk_ = 0.f; pv_ = 0.f; } else { pr_ = st0[0]; pk_ = st0[MIXW]; pv_ = st0[2 * MIXW]; } } \
            _Pragma("unroll") for (int j_ = 0; j_ < 8; ++j_) { const float ur_ = __builtin_bit_cast(float, S.u[0][j_ + 1] << 16), uk_ = __builtin_bit_cast(float, S.u[1][j_ + 1] << 16), uv_ = __builtin_bit_cast(float, S.u[2][j_ + 1] << 16); \
                const float r_ = ur_ + (pr_ - ur_) * mur, k_ = uk_ + (pk_ - uk_) * muk, v_ = uv_ + (pv_ - uv_) * muv; pr_ = ur_; pk_ = uk_; pv_ = uv_; \
                float kk_ = k_ * kka; float n2_ = sum16(kk_ * kk_); n2_ += __shfl_xor(n2_, 16); n2_ += __shfl_xor(n2_, 32); kk_ = kk_ * (1.0f / fmaxf(sqrtf(n2_), 1e-12f)); \
                const float a_ = S.a[j_]; \
                const float k2_ = k_ * (1.0f + (a_ - 1.0f) * kaa); float bs_ = sum16(r_ * k2_ * rkc); bs_ += __shfl_xor(bs_, 16); bs_ += __shfl_xor(bs_, 32); if (F.lane == 0) BS[b_ * SCH + j_] = bs_; \
                st_[j_ * 384] = r_; st_[j_ * 384 + 64] = S.w[j_]; st_[j_ * 384 + 128] = k2_; st_[j_ * 384 + 192] = -kk_; st_[j_ * 384 + 256] = kk_ * a_; st_[j_ * 384 + 320] = v_; } \
            asm volatile("s_waitcnt lgkmcnt(0)" ::: "memory"); \
            if (F.lane == 0) FL[b_] = (unsigned)(c_ + 1); } while (0)
        if (w < 6 && L < nch) { LdSet SA, SB; const int lastc = ((nch - 1 - L) & ~1) + L;
            int ch = L; LD_ISSUE(SA, ch);
            for (; ch < nch; ch += 4) {
                { const int c2 = ch + 2 <= lastc ? ch + 2 : ch; LD_ISSUE(SB, c2); }
                LD_COMPUTE(SA, ch);
                { const int c4 = ch + 4 <= lastc ? ch + 4 : ch; LD_ISSUE(SA, c4); }
                if (ch + 2 < nch) LD_COMPUTE(SB, ch + 2);
            } }
#undef LD_ISSUE
#undef LD_COMPUTE
        if (w == 6) { const int tq = F.lane >> 3, pq = F.lane & 7, cf = 64 * h + 8 * pq;
            const f32x4 lg0 = *(const GAS f32x4*)(F.a->in[I_LNG] + cf), lg1 = *(const GAS f32x4*)(F.a->in[I_LNG] + cf + 4), lb0 = *(const GAS f32x4*)(F.a->in[I_LNB] + cf), lb1 = *(const GAS f32x4*)(F.a->in[I_LNB] + cf + 4);
            const bf16* gp = WSP(bf16, WS_G) + (size_t)(row0 + tq) * MIXW + cf; bf16* op = WSP(bf16, WS_O) + (size_t)(row0 + tq) * D + cf;
            const LAS float* YZ = (const LAS float*)(F.lds + RING_BYTES + 2048) + tq * 128 + 8 * pq;
            int bq_cur = 0, bq_end = 0, bq_it0 = 0, bq_it1 = 0; bool bq_done = !isP; TrBuf bqb0, bqb1; LAS float* bscr = (LAS float*)(F.lds + RING_OFF + P5_FLAGS + 1024 + 6 * P5_SCR_STRIDE);
            if (isP) { bg_load(F, 0, bqb0); bg_load(F, 0, bqb1); }
#define FIN_BODY(chx, BG, bqb, bq_it) do { const int ch_ = (chx), c = gch + ch_, yb = c % 3;                 const v4u gw = *(const GAS v4u*)(gp + (size_t)ch_ * SCH * MIXW); \
                if (BG) { bg_store(F, bq_it, bqb, bscr); \
                    if (bq_cur == bq_end && !bq_done) { const int base_ = q_grab(F.ctl + CW_QA, F.lane) * BG_GRAB; if (base_ >= BG_C6) bq_done = true; else { bq_cur = base_; bq_end = base_ + BG_GRAB < BG_C6 ? base_ + BG_GRAB : BG_C6; } } \
                    bq_it = bq_cur < bq_end ? bq_cur : 0; bq_cur += bq_cur < bq_end ? 1 : 0; bg_load(F, bq_it, bqb); } \
 \
                while ((int)min(min(FL[16], FL[17]), min(FL[18], FL[19])) < c + 1) __builtin_amdgcn_s_sleep(1); \
                asm volatile("" ::: "memory"); \
                const LAS float* yp = YZ + yb * SCH * 128; \
                const f32x4 y0 = *(const LAS f32x4*)yp, y1 = *(const LAS f32x4*)(yp + 4), z0 = *(const LAS f32x4*)(yp + 64), z1 = *(const LAS f32x4*)(yp + 68); \
                const float mean = sum8(((y0.x + y0.y) + (y0.z + y0.w)) + ((y1.x + y1.y) + (y1.z + y1.w))) * (1.0f / 64.0f); const f32x4 d0 = y0 - mean, d1 = y1 - mean; \
                const float var = sum8(((d0.x * d0.x + d0.y * d0.y) + (d0.z * d0.z + d0.w * d0.w)) + ((d1.x * d1.x + d1.y * d1.y) + (d1.z * d1.z + d1.w * d1.w))) * (1.0f / 64.0f); const float rs = 1.0f / sqrtf(var + LNX_EPS); \
                const f32x4 g0 = bf4_to_f32(gw.x, gw.y), g1 = bf4_to_f32(gw.z, gw.w); \
                const f32x4 o0 = (d0 * rs * lg0 + lb0 + z0) * g0, o1 = (d1 * rs * lg1 + lb1 + z1) * g1; \
                v4u ow; ow.x = pk2(o0.x, o0.y); ow.y = pk2(o0.z, o0.w); ow.z = pk2(o1.x, o1.y); ow.w = pk2(o1.z, o1.w); \
                *(GAS v4u*)(op + (size_t)ch_ * SCH * D) = ow; \
                asm volatile("s_waitcnt lgkmcnt(0)" ::: "memory"); \
                if (F.lane == 0) FL[24] = (unsigned)(c + 1); } while (0)
            if (isP) { for (int ch = 0; ch < nch; ch += 2) { FIN_BODY(ch, true, bqb0, bq_it0); FIN_BODY(ch + 1, true, bqb1, bq_it1); }
                bg_store(F, bq_it0, bqb0, bscr); bg_store(F, bq_it1, bqb1, bscr);
                if (bq_cur < bq_end) bg_range(F, bq_cur, bq_end, bscr);
            } else { for (int ch = 0; ch < nch; ++ch) FIN_BODY(ch, false, bqb0, bq_it0); }
#undef FIN_BODY
            }
    } else {
        __builtin_amdgcn_s_setprio(2);
        f32x2 S[2][4];
        if (isP) {
#pragma unroll
            for (int r = 0; r < 2; ++r)
#pragma unroll
                for (int j = 0; j < 4; ++j) S[r][j] = (f32x2){0.f, 0.f};
        } else { const float* s0 = F.a->in[I_SWKV] + ((size_t)sh * 64 + 16 * w + 2 * rp) * 64 + 8 * co;
#pragma unroll
            for (int r = 0; r < 2; ++r) { const f32x4 x0 = *(const GAS f32x4*)(s0 + 64 * r), x1 = *(const GAS f32x4*)(s0 + 64 * r + 4);
                S[r][0] = (f32x2){x0.x, x0.y}; S[r][1] = (f32x2){x0.z, x0.w}; S[r][2] = (f32x2){x1.x, x1.y}; S[r][3] = (f32x2){x1.z, x1.w}; } }
        LAS float* YZw = (LAS float*)(F.lds + RING_BYTES + 2048) + 16 * w + 2 * rp;
        for (int ch = 0; ch < nch; ++ch) { const int c = gch + ch, b = c & (SNB - 1);
            while (FL[b] != (unsigned)(c + 1)) __builtin_amdgcn_s_sleep(1);
            asm volatile("" ::: "memory");
            const LAS float* P0 = stage + b * SCH * 384 + 8 * co; const LAS float* PV = stage + b * SCH * 384 + 320 + 16 * w + 2 * rp;
            f32x4 vec[2][10]; f32x2 vvv[2]; float ys[SCH][2], zs[SCH][2]; const volatile LAS float* BSr = (const volatile LAS float*)(F.lds + RING_OFF + P5_FLAGS + 256) + b * SCH;
#define SC_LOAD(buf, tt) do { const LAS float* P = P0 + (tt) * 384; _Pragma("unroll") for (int i_ = 0; i_ < 5; ++i_) { vec[buf][2 * i_] = *(const LAS f32x4*)(P + 64 * i_); vec[buf][2 * i_ + 1] = *(const LAS f32x4*)(P + 64 * i_ + 4); } \
                vvv[buf] = *(const LAS f32x2*)(PV + (tt) * 384); } while (0)
            SC_LOAD(0, 0);
#pragma unroll
            for (int tt = 0; tt < SCH; ++tt) { const int cb_ = tt & 1;
                if (tt + 1 < SCH) SC_LOAD(cb_ ^ 1, tt + 1);
                const f32x4 r0 = vec[cb_][0], r1 = vec[cb_][1], w0 = vec[cb_][2], w1 = vec[cb_][3], k0 = vec[cb_][4], k1 = vec[cb_][5], a0 = vec[cb_][6], a1 = vec[cb_][7], b0 = vec[cb_][8], b1 = vec[cb_][9]; const f32x2 vv = vvv[cb_];
                const f32x2 av[4] = {{a0.x, a0.y}, {a0.z, a0.w}, {a1.x, a1.y}, {a1.z, a1.w}}, wv[4] = {{w0.x, w0.y}, {w0.z, w0.w}, {w1.x, w1.y}, {w1.z, w1.w}};
                const f32x2 kv[4] = {{k0.x, k0.y}, {k0.z, k0.w}, {k1.x, k1.y}, {k1.z, k1.w}}, bv[4] = {{b0.x, b0.y}, {b0.z, b0.w}, {b1.x, b1.y}, {b1.z, b1.w}}, rv[4] = {{r0.x, r0.y}, {r0.z, r0.w}, {r1.x, r1.y}, {r1.z, r1.w}};
#pragma unroll
                for (int r = 0; r < 2; ++r) { f32x2 sa2 = S[r][0] * av[0]; sa2 += S[r][1] * av[1]; sa2 += S[r][2] * av[2]; sa2 += S[r][3] * av[3];
                    const float sa = sum8(sa2.x + sa2.y); const float vr = r == 0 ? vv.x : vv.y; f32x2 y2 = {0.f, 0.f};
#pragma unroll
                    for (int j = 0; j < 4; ++j) { S[r][j] = S[r][j] * wv[j] + sa * bv[j] + vr * kv[j]; y2 += S[r][j] * rv[j]; }
                    ys[tt][r] = sum8(y2.x + y2.y); }
                { const float bsv = BSr[tt]; zs[tt][0] = bsv * vv.x; zs[tt][1] = bsv * vv.y; }
            }
#undef SC_LOAD
            while ((int)FL[24] < c - 2) __builtin_amdgcn_s_sleep(1);
            asm volatile("" ::: "memory");
            if (co == 0) { const int yb = c % 3;
#pragma unroll
                for (int tt = 0; tt < SCH; ++tt) { *(LAS f32x2*)(YZw + (yb * SCH + tt) * 128) = (f32x2){ys[tt][0], ys[tt][1]}; *(LAS f32x2*)(YZw + (yb * SCH + tt) * 128 + 64) = (f32x2){zs[tt][0], zs[tt][1]}; } }
            asm volatile("s_waitcnt lgkmcnt(0)" ::: "memory");
            if (F.lane == 0) FL[16 + w] = (unsigned)(c + 1);
        }
        __builtin_amdgcn_s_setprio(0);
        float* so = F.out + (isP ? OUT_WKVP : OUT_WKVS) + ((size_t)sh * 64 + 16 * w + 2 * rp) * 64 + 8 * co;
#pragma unroll
        for (int r = 0; r < 2; ++r) { *(GAS f32x4*)(so + 64 * r) = (f32x4){S[r][0].x, S[r][0].y, S[r][1].x, S[r][1].y}; *(GAS f32x4*)(so + 64 * r + 4) = (f32x4){S[r][2].x, S[r][2].y, S[r][3].x, S[r][3].y}; }
    }
    gch += nch;
}
__device__ __forceinline__ void bg_copies(Frame& F, gu32* qb) {
    for (;;) { const int c = q_grab(qb, F.lane); if (c >= BG_NCOPY) break;
        int ci = c, g = 0, ipb = 30;
        if (ci >= 8 * 30) { ci -= 8 * 30; g = 1; ipb = 126; if (ci >= 8 * 126) { ci -= 8 * 126; g = 2; ipb = 510; } }
        const int b = ci / ipb, x0 = (ci - b * ipb) * 2048; const size_t full = (size_t)(128 << (2 * g)) * 2048;
        const float* C = (g == 0 ? F.a->in[I_C1] : (g == 1 ? F.a->in[I_C2] : F.a->in[I_C3])) + b * full + 16384 + 4 * (size_t)(x0 + F.lane);
        float* o = F.out + (g == 0 ? OUT_SWAS1 : (g == 1 ? OUT_SWAS2 : OUT_SWAS3)) + b * full + 4 * (size_t)(x0 + F.lane);
#pragma unroll
        for (int h = 0; h < 2; ++h) { f32x4 v[16];
#pragma unroll
            for (int k = 0; k < 16; ++k) v[k] = *(const GAS f32x4*)(C + (size_t)(16 * h + k) * 256);
#pragma unroll
            for (int k = 0; k < 16; ++k) *(GAS f32x4*)(o + (size_t)(16 * h + k) * 256) = v[k]; } }
}
__device__ __forceinline__ void p5_background(Frame F, int scr_off, bool copies_first) { PHASE_LOCAL(F);
    LAS float* scr = (LAS float*)(F.lds + RING_OFF + scr_off);
    gu32* qa = F.ctl + CW_QA; gu32* qb = F.ctl + CW_QB;
    if (copies_first) bg_copies(F, qb);
    for (;;) { const int base = q_grab(qa, F.lane) * BG_GRAB; if (base >= BG_C6) break;
        bg_range(F, base, base + BG_GRAB < BG_C6 ? base + BG_GRAB : BG_C6, scr); }
    bg_copies(F, qb);
}
struct P5In { f32x4 y, z, lg, lb; u32x2 g; };
__device__ __forceinline__ void p5b_post(Frame F) { PHASE_LOCAL(F);
    const float* lng = F.a->in[I_LNG]; const float* lnb = F.a->in[I_LNB];
    for (int un = F.gw; un < M * 3; un += F.NGW) { const int row = un / 3, itb = (un - 3 * row) * 4;
        const float* yrow = WSP(float, WS_YRAW) + (size_t)row * MIXW; const float* zrow = WSP(float, WS_ZRAW) + (size_t)row * MIXW; const bf16* grow = WSP(bf16, WS_G) + (size_t)row * MIXW; bf16* orow = WSP(bf16, WS_O) + (size_t)row * D;
        P5In in[4];
#pragma unroll
        for (int j = 0; j < 4; ++j) { const int c = 256 * (itb + j) + 4 * F.lane;
            in[j].y = *(const GAS f32x4*)(yrow + c); in[j].z = *(const GAS f32x4*)(zrow + c); in[j].g = *(const GAS u32x2*)(grow + c); in[j].lg = *(const GAS f32x4*)(lng + c); in[j].lb = *(const GAS f32x4*)(lnb + c); }
#pragma unroll
        for (int j = 0; j < 4; ++j) { const int c = 256 * (itb + j) + 4 * F.lane; const f32x4 y = in[j].y, g = bf4_to_f32(in[j].g.x, in[j].g.y);
            const float mean = sum16((y.x + y.y) + (y.z + y.w)) * (1.0f / 64.0f); const f32x4 d = y - mean;
            const float var = sum16((d.x * d.x + d.y * d.y) + (d.z * d.z + d.w * d.w)) * (1.0f / 64.0f); const float rs = 1.0f / sqrtf(var + LNX_EPS);
            const f32x4 o = (d * rs * in[j].lg + in[j].lb + in[j].z) * g;
            u32x2 ow; ow.x = pk2(o.x, o.y); ow.y = pk2(o.z, o.w); *(GAS u32x2*)(orow + c) = ow; }
    }
}

__device__ __forceinline__ void mem_attend_task(const bf16* Q, int ldq, int qmask, int nvalid, const float* gq, const bf16* K, const bf16* VT, bf16* Oo, int ldo, int lane) {
    const int q = lane & 15, g = lane >> 4;
    const bf16* qp = Q + (size_t)(q & qmask) * ldq + 8 * g;
    bf16x8 Bq[8]; float ss = 0.f;
    float qf[8][8];
#pragma unroll
    for (int s = 0; s < 8; ++s) { const v4u raw = *(const GAS v4u*)(qp + 32 * s);
        const unsigned w[4] = {raw.x, raw.y, raw.z, raw.w};
#pragma unroll
        for (int j = 0; j < 4; ++j) { qf[s][2 * j] = __builtin_bit_cast(float, w[j] << 16); qf[s][2 * j + 1] = __builtin_bit_cast(float, w[j] & 0xffff0000u); }
#pragma unroll
        for (int j = 0; j < 8; ++j) ss += qf[s][j] * qf[s][j]; }
    ss += __shfl_xor(ss, 16); ss += __shfl_xor(ss, 32);
    const float sc = (1.0f / sqrtf(ss * (1.0f / 256.0f) + RMS_EPS)) * (0.0625f * LOG2E);
#pragma unroll
    for (int s = 0; s < 8; ++s) { const f32x4 g0 = *(const GAS f32x4*)(gq + 32 * s + 8 * g), g1 = *(const GAS f32x4*)(gq + 32 * s + 8 * g + 4);
        v4u w; w.x = pk2(qf[s][0] * sc * g0.x, qf[s][1] * sc * g0.y); w.y = pk2(qf[s][2] * sc * g0.z, qf[s][3] * sc * g0.w);
        w.z = pk2(qf[s][4] * sc * g1.x, qf[s][5] * sc * g1.y); w.w = pk2(qf[s][6] * sc * g1.z, qf[s][7] * sc * g1.w);
        Bq[s] = __builtin_bit_cast(bf16x8, w); }
    f32x4 sT[16];
#pragma unroll
    for (int kt = 0; kt < 16; ++kt) { f32x4 acc = (f32x4){0.f, 0.f, 0.f, 0.f}; const bf16* kp = K + (size_t)(16 * kt + q) * 256 + 8 * g;
#pragma unroll
        for (int s = 0; s < 8; ++s) { const bf16x8 a = *(const GAS bf16x8*)(kp + 32 * s); acc = __builtin_amdgcn_mfma_f32_16x16x32_bf16(a, Bq[s], acc, 0, 0, 0); }
        sT[kt] = acc; }
    float mx = -3.0e38f;
#pragma unroll
    for (int kt = 0; kt < 16; ++kt) mx = fmaxf(mx, fmaxf(fmaxf(sT[kt][0], sT[kt][1]), fmaxf(sT[kt][2], sT[kt][3])));
    mx = fmaxf(mx, __shfl_xor(mx, 16)); mx = fmaxf(mx, __shfl_xor(mx, 32));
    float l = 0.f;
#pragma unroll
    for (int kt = 0; kt < 16; ++kt) {
#pragma unroll
        for (int i = 0; i < 4; ++i) { const float p = __builtin_amdgcn_exp2f(sT[kt][i] - mx); sT[kt][i] = p; l += p; } }
    l += __shfl_xor(l, 16); l += __shfl_xor(l, 32);
    const float inv = 1.0f / l;
    bf16x8 Bp[8];
#pragma unroll
    for (int s = 0; s < 8; ++s) { v4u w; w.x = pk2(sT[2 * s][0], sT[2 * s][1]); w.y = pk2(sT[2 * s][2], sT[2 * s][3]); w.z = pk2(sT[2 * s + 1][0], sT[2 * s + 1][1]); w.w = pk2(sT[2 * s + 1][2], sT[2 * s + 1][3]);
        Bp[s] = __builtin_bit_cast(bf16x8, w); }
    typedef unsigned u2 __attribute__((ext_vector_type(2)));
    f32x4 o[16];
#pragma unroll
    for (int dt = 0; dt < 16; ++dt) { o[dt] = (f32x4){0.f, 0.f, 0.f, 0.f}; const bf16* vp = VT + (size_t)(16 * dt + q) * 256 + 4 * g;
#pragma unroll
        for (int s = 0; s < 8; ++s) { const u2 lo = *(const GAS u2*)(vp + 32 * s), hi = *(const GAS u2*)(vp + 32 * s + 16); v4u w; w.x = lo.x; w.y = lo.y; w.z = hi.x; w.w = hi.y;
            o[dt] = __builtin_amdgcn_mfma_f32_16x16x32_bf16(__builtin_bit_cast(bf16x8, w), Bp[s], o[dt], 0, 0, 0); } }
    if (q < nvalid) {
#pragma unroll
        for (int dt = 0; dt < 16; ++dt) { u2 w; w.x = pk2(o[dt][0] * inv, o[dt][1] * inv); w.y = pk2(o[dt][2] * inv, o[dt][3] * inv); *(GAS u2*)(Oo + (size_t)q * ldo + 16 * dt + 4 * g) = w; } }
}
__device__ __forceinline__ void mem_img_dma(LAS unsigned char* img, const bf16* src, int w, int lane) {
#pragma unroll
    for (int i = 0; i < 16; ++i) { const int blk = w * 16 + i, P = blk * 64 + lane, row = P >> 5, c = (P & 31) ^ (row & 15);
        __builtin_amdgcn_global_load_lds((const unsigned*)(src + (size_t)row * 256 + c * 8), (LAS unsigned*)(img + blk * 1024), 16, 0, 0); }
}
__device__ __forceinline__ void mem_attend_wg(Frame F, int layer, const bf16* Usrc, int ldu, int qoff, bf16* Odst, int ldo, int ooff, int extra) { PHASE_LOCAL(F);
    LAS unsigned char* img = F.lds + RING_OFF;
    const float* gq = F.a->in[I_QNM] + layer * 256;
    const int w = F.wave;
    typedef unsigned u2 __attribute__((ext_vector_type(2)));
    __syncthreads();
    for (int it = 0; ; ++it) { int unit;
        if (extra >= -1) { if (it == 0) unit = (int)blockIdx.x; else if (it == 1 && extra >= 0) unit = extra; else break; } else { unit = (int)blockIdx.x + it * F.G; if (unit >= 256 + 32) break; }
        const int lane = opaque_v(F.lane), q = lane & 15, g = lane >> 4;
        const bool isS = unit >= 256; int row0, qrow, nvalid, h; const bf16* Kg; const bf16* VTg;
        if (!isS) { const int bh = unit >> 4, qb = unit & 15, b = bh >> 2; h = bh & 3; row0 = b * SEQ + qb * 128 + 16 * w; qrow = q; nvalid = 16; const size_t kv = (size_t)((layer * 4 + b) * 4 + h) * 65536; Kg = WSP(bf16, WS_KP) + kv; VTg = WSP(bf16, WS_VTP) + kv; }
        else { const int st = unit - 256, b = st >> 2; h = st & 3; row0 = MP + b * 8; qrow = q & 7; nvalid = w == 0 ? 8 : 0; const size_t kv = (size_t)((layer * 8 + b) * 4 + h) * 65536; Kg = WSP(bf16, WS_KS) + kv; VTg = WSP(bf16, WS_VTS) + kv; }
        const bool active = nvalid > 0;
        mem_img_dma(img, Kg, w, lane);
        bf16x8 Bq[8];
        { const bf16* qp = Usrc + (size_t)(row0 + qrow) * ldu + qoff + h * 256 + 8 * g; float ss = 0.f; v4u raw[8];
#pragma unroll
          for (int s = 0; s < 8; ++s) { raw[s] = *(const GAS v4u*)(qp + 32 * s); const unsigned ww[4] = {raw[s].x, raw[s].y, raw[s].z, raw[s].w};
#pragma unroll
              for (int j = 0; j < 4; ++j) { const float lo = __builtin_bit_cast(float, ww[j] << 16), hi = __builtin_bit_cast(float, ww[j] & 0xffff0000u); ss += lo * lo + hi * hi; } }
          ss += __shfl_xor(ss, 16); ss += __shfl_xor(ss, 32);
          const float sc = (1.0f / sqrtf(ss * (1.0f / 256.0f) + RMS_EPS)) * (0.0625f * LOG2E);
          const int goff = 8 * g;
#pragma unroll
          for (int s = 0; s < 8; ++s) { const f32x4 g0 = *(const GAS f32x4*)(gq + 32 * s + goff) * sc, g1 = *(const GAS f32x4*)(gq + 32 * s + goff + 4) * sc; const unsigned ww[4] = {raw[s].x, raw[s].y, raw[s].z, raw[s].w};
              float lo[4], hi[4];
#pragma unroll
              for (int j = 0; j < 4; ++j) { lo[j] = __builtin_bit_cast(float, ww[j] << 16); hi[j] = __builtin_bit_cast(float, ww[j] & 0xffff0000u); }
              v4u o; o.x = pk2(lo[0] * g0.x, hi[0] * g0.y); o.y = pk2(lo[1] * g0.z, hi[1] * g0.w); o.z = pk2(lo[2] * g1.x, hi[2] * g1.y); o.w = pk2(lo[3] * g1.z, hi[3] * g1.w);
              Bq[s] = __builtin_bit_cast(bf16x8, o); } }
        asm volatile("s_waitcnt vmcnt(0)" ::: "memory"); __syncthreads();
        bf16x8 Bp[8]; float inv = 0.f;
        if (active) { f32x4 sT[16];
#pragma unroll
            for (int kt = 0; kt < 16; ++kt) { f32x4 acc = (f32x4){0.f, 0.f, 0.f, 0.f}; const LAS unsigned char* kr = img + (16 * kt + q) * 512;
#pragma unroll
                for (int s = 0; s < 8; ++s) { const bf16x8 a = *(const LAS bf16x8*)(kr + (((4 * s + g) ^ q) << 4)); acc = __builtin_amdgcn_mfma_f32_16x16x32_bf16(a, Bq[s], acc, 0, 0, 0); }
                sT[kt] = acc; if (kt & 1) __builtin_amdgcn_sched_barrier(0); }
            float mx = -3.0e38f;
#pragma unroll
            for (int kt = 0; kt < 16; ++kt) mx = fmaxf(mx, fmaxf(fmaxf(sT[kt][0], sT[kt][1]), fmaxf(sT[kt][2], sT[kt][3])));
            mx = fmaxf(mx, __shfl_xor(mx, 16)); mx = fmaxf(mx, __shfl_xor(mx, 32));
            float l = 0.f;
#pragma unroll
            for (int kt = 0; kt < 16; ++kt) {
#pragma unroll
                for (int i = 0; i < 4; ++i) { const float p = __builtin_amdgcn_exp2f(sT[kt][i] - mx); sT[kt][i] = p; l += p; } }
            l += __shfl_xor(l, 16); l += __shfl_xor(l, 32); inv = 1.0f / l;
#pragma unroll
            for (int s = 0; s < 8; ++s) { v4u ww; ww.x = pk2(sT[2 * s][0], sT[2 * s][1]); ww.y = pk2(sT[2 * s][2], sT[2 * s][3]); ww.z = pk2(sT[2 * s + 1][0], sT[2 * s + 1][1]); ww.w = pk2(sT[2 * s + 1][2], sT[2 * s + 1][3]);
                Bp[s] = __builtin_bit_cast(bf16x8, ww); } }
        __syncthreads();
        mem_img_dma(img, VTg, w, lane);
        asm volatile("s_waitcnt vmcnt(0)" ::: "memory"); __syncthreads();
        if (active) { bf16* Oo = Odst + (size_t)row0 * ldo + ooff + h * 256;
#pragma unroll 2
            for (int dt = 0; dt < 16; ++dt) { f32x4 o = (f32x4){0.f, 0.f, 0.f, 0.f}; const LAS unsigned char* vr = img + (16 * dt + q) * 512 + 8 * (g & 1);
#pragma unroll
                for (int s = 0; s < 8; ++s) { const int c0 = 4 * s + (g >> 1); const u2 lo = *(const LAS u2*)(vr + ((c0 ^ q) << 4)), hi = *(const LAS u2*)(vr + (((c0 + 2) ^ q) << 4)); v4u ww; ww.x = lo.x; ww.y = lo.y; ww.z = hi.x; ww.w = hi.y;
                    o = __builtin_amdgcn_mfma_f32_16x16x32_bf16(__builtin_bit_cast(bf16x8, ww), Bp[s], o, 0, 0, 0); }
                if (q < nvalid) { u2 ww; ww.x = pk2(o[0] * inv, o[1] * inv); ww.y = pk2(o[2] * inv, o[3] * inv); *(GAS u2*)(Oo + (size_t)q * ldo + 16 * dt + 4 * g) = ww; }
                __builtin_amdgcn_sched_barrier(0); } }
        __syncthreads();
    }
}
__device__ __forceinline__ void mem_attend_phase(Frame F, int layer, const bf16* Usrc, int ldu, int qoff, bf16* Odst, int ldo, int ooff) { PHASE_LOCAL(F);
    const float* gq = F.a->in[I_QNM] + layer * 256;
    const int NT = (MP / 16) * 4 + NBS * 4;
    for (int task = F.gw; task < NT; task += F.NGW) {
        if (task < (MP / 16) * 4) { const int rt = task >> 2, h = task & 3, row0 = rt * 16, b = row0 >> 11; const size_t kv = (size_t)((layer * 4 + b) * 4 + h) * 65536;
            mem_attend_task(Usrc + (size_t)row0 * ldu + qoff + h * 256, ldu, 15, 16, gq, WSP(bf16, WS_KP) + kv, WSP(bf16, WS_VTP) + kv, Odst + (size_t)row0 * ldo + ooff + h * 256, ldo, F.lane);
        } else { const int st = task - (MP / 16) * 4, b = st >> 2, h = st & 3, row0 = MP + b * 8; const size_t kv = (size_t)((layer * 8 + b) * 4 + h) * 65536;
            mem_attend_task(Usrc + (size_t)row0 * ldu + qoff + h * 256, ldu, 7, 8, gq, WSP(bf16, WS_KS) + kv, WSP(bf16, WS_VTS) + kv, Odst + (size_t)row0 * ldo + ooff + h * 256, ldo, F.lane); }
    }
}
struct SkEpi { bf16* O; int ldo; const float* ss; const float* bias; float* scanS; int slot; const float* base; float* Y; bf16* XA; float* SSo; int base16, wy, feed; };
template <int MODE> __device__ __forceinline__ void skinny_gemm(Frame F, const bf16* A, const bf16* Bt, int K, int nunits, int rot, const SkEpi e, gu32* qc = nullptr, int LDB = 0) { PHASE_LOCAL(F);
    K = opaque_s(K); LDB = opaque_s(LDB ? LDB : K);
    const int w = F.wave, q = F.lane & 15, g = F.lane >> 4, tid = w * 64 + F.lane;
    LAS float* part = (LAS float*)(F.lds + RING_OFF); LAS float* rsl = (LAS float*)(F.lds + RING_BYTES + 1024);
    int first = (int)blockIdx.x - (rot % F.G); if (first < 0) first += F.G;
    volatile LAS unsigned* qslot = (volatile LAS unsigned*)(F.lds + RING_BYTES + 1024 + 512);
    if (qc) { if (tid == 0) qslot[0] = __hip_atomic_fetch_add(qc, 1u, RLX_AGENT); __syncthreads(); first = (int)__builtin_amdgcn_readfirstlane(qslot[0]); }
    for (int unit = first; unit < nunits; ) {
        if ((MODE == 0 || MODE == 5) && w == 0) { const GAS f32x4* sp = (const GAS f32x4*)(e.ss + (size_t)(MP + F.lane) * 64); float s = 0.f;
#pragma unroll
            for (int i = 0; i < 16; ++i) { const f32x4 x = sp[i]; s += (x.x + x.y) + (x.z + x.w); }
            rsl[F.lane] = 1.0f / sqrtf(s * (1.0f / 4096.0f) + RMS_EPS); }
        f32x4 acc[4][4];
#pragma unroll
        for (int rt = 0; rt < 4; ++rt)
#pragma unroll
            for (int ct = 0; ct < 4; ++ct) acc[rt][ct] = (f32x4){0.f, 0.f, 0.f, 0.f};
        const bf16* ap = A + (size_t)q * K + (MODE == 5 ? 8 : 16) * g;
        const bf16* bp[4];
#pragma unroll
        for (int ct = 0; ct < 4; ++ct) { int br;
            if (MODE == 5) { const int j0 = 32 * unit; br = 256 * (j0 >> 7) + (j0 & 127) + (ct >> 1) * 128 + (ct & 1) * 16; } else br = 64 * unit + 16 * ct;
            bp[ct] = Bt + (size_t)(br + q) * LDB + (MODE == 5 ? 8 : 16) * g; }
        if constexpr (MODE == 5) {
            bf16x8 a[3][4], b[4][4];
            const bf16* pa[4]; const bf16* pb[4];
#pragma unroll
            for (int rt = 0; rt < 4; ++rt) pa[rt] = ap + (size_t)(16 * rt) * K + 64 * w;
#pragma unroll
            for (int ct = 0; ct < 4; ++ct) pb[ct] = bp[ct] + 64 * w;
#define SK_LA(buf, dj) do { _Pragma("unroll") for (int rt = 0; rt < 4; ++rt) a[buf][rt] = *(const GAS bf16x8*)(pa[rt] + 512 * ((dj) >> 1) + 32 * ((dj) & 1)); } while (0)
#define SK_LB(buf, dj) do { _Pragma("unroll") for (int ct = 0; ct < 4; ++ct) b[buf][ct] = *(const GAS bf16x8*)(pb[ct] + 512 * ((dj) >> 1) + 32 * ((dj) & 1)); } while (0)
#define SK_MM(j) do { _Pragma("unroll") for (int rt = 0; rt < 4; ++rt) _Pragma("unroll") for (int ct = 0; ct < 4; ++ct) \
            acc[rt][ct] = __builtin_amdgcn_mfma_f32_16x16x32_bf16(b[(j) % 4][ct], a[(j) % 3][rt], acc[rt][ct], 0, 0, 0); } while (0)
            SK_LB(0, 0); SK_LA(0, 0); SK_LB(1, 1); SK_LA(1, 1); SK_LB(2, 2);
            __builtin_amdgcn_sched_barrier(0);
#pragma unroll
            for (int i = 0; i < 8; ++i) { const int j = 2 * i;
                if (j + 2 < 16) SK_LA((j + 2) % 3, 2);
                if (j + 3 < 16) SK_LB((j + 3) % 4, 3);
                __builtin_amdgcn_sched_barrier(0);
                SK_MM(j);
                __builtin_amdgcn_sched_barrier(0);
                if (j + 3 < 16) SK_LA((j + 3) % 3, 3);
                if (j + 4 < 16) SK_LB((j + 4) % 4, 4);
                __builtin_amdgcn_sched_barrier(0);
                SK_MM(j + 1);
                __builtin_amdgcn_sched_barrier(0);
#pragma unroll
                for (int rt = 0; rt < 4; ++rt) { pa[rt] += 512; asm volatile("" : "+v"(pa[rt])); }
#pragma unroll
                for (int ct = 0; ct < 4; ++ct) { pb[ct] += 512; asm volatile("" : "+v"(pb[ct])); }
            }
#undef SK_LA
#undef SK_LB
#undef SK_MM
        } else {
        const int KC = K >> 6;
        bf16x8 a[2][4][2], b[2][4][2];
#define SK_LOAD(buf, s) do { _Pragma("unroll") for (int rt = 0; rt < 4; ++rt) { const bf16* p_ = ap + (size_t)(16 * rt) * K + 64 * (s); a[buf][rt][0] = *(const GAS bf16x8*)p_; a[buf][rt][1] = *(const GAS bf16x8*)(p_ + 8); } \
        _Pragma("unroll") for (int ct = 0; ct < 4; ++ct) { const bf16* p_ = bp[ct] + 64 * (s); b[buf][ct][0] = *(const GAS bf16x8*)p_; b[buf][ct][1] = *(const GAS bf16x8*)(p_ + 8); } } while (0)
#define SK_MMA(buf) do { _Pragma("unroll") for (int h = 0; h < 2; ++h) _Pragma("unroll") for (int rt = 0; rt < 4; ++rt) _Pragma("unroll") for (int ct = 0; ct < 4; ++ct) \
        acc[rt][ct] = __builtin_amdgcn_mfma_f32_16x16x32_bf16(b[buf][ct][h], a[buf][rt][h], acc[rt][ct], 0, 0, 0); } while (0)
        int s = w;
        if (s < KC) { SK_LOAD(0, s);
            for (; s < KC; s += 16) {
                { const int s1 = s + 8 < KC ? s + 8 : s; SK_LOAD(1, s1); }
                __builtin_amdgcn_sched_barrier(0);
                SK_MMA(0);
                __builtin_amdgcn_sched_barrier(0);
                { const int s2 = s + 16 < KC ? s + 16 : s; SK_LOAD(0, s2); }
                __builtin_amdgcn_sched_barrier(0);
                if (s + 8 < KC) SK_MMA(1);
                __builtin_amdgcn_sched_barrier(0);
            } }
#undef SK_LOAD
#undef SK_MMA
        }
#pragma unroll
        for (int rt = 0; rt < 4; ++rt)
#pragma unroll
            for (int ct = 0; ct < 4; ++ct) *(LAS f32x4*)(part + w * 4096 + (16 * rt + q) * 64 + (((4 * ct + g) ^ q) << 2)) = acc[rt][ct];
        __syncthreads();
        if (MODE == 5) { const int m = tid >> 3, c4 = tid & 7; f32x4 gv = (f32x4){0.f, 0.f, 0.f, 0.f}, uv = gv;
#pragma unroll
            for (int ww = 0; ww < 8; ++ww) { gv += *(const LAS f32x4*)(part + ww * 4096 + m * 64 + ((c4 ^ (m & 15)) << 2)); uv += *(const LAS f32x4*)(part + ww * 4096 + m * 64 + (((c4 + 8) ^ (m & 15)) << 2)); }
            const float sc = rsl[m]; gv = gv * sc; uv = uv * sc;
            u32x2 o; o.x = pk2(pg8::silu_mul(gv.x, uv.x), pg8::silu_mul(gv.y, uv.y)); o.y = pk2(pg8::silu_mul(gv.z, uv.z), pg8::silu_mul(gv.w, uv.w));
            *(GAS u32x2*)(e.O + (size_t)(MP + m) * e.ldo + 32 * unit + 4 * c4) = o;
        } else {
#pragma unroll
            for (int it = 0; it < 2; ++it) { const int i = tid + 512 * it, m = i >> 4, c4 = i & 15, col = 64 * unit + 4 * c4; f32x4 v = (f32x4){0.f, 0.f, 0.f, 0.f};
#pragma unroll
                for (int ww = 0; ww < 8; ++ww) v += *(const LAS f32x4*)(part + ww * 4096 + m * 64 + ((c4 ^ (m & 15)) << 2));
                if (MODE == 0 || MODE == 1) { if (MODE == 0) v = v * rsl[m]; u32x2 o; o.x = pk2(v.x, v.y); o.y = pk2(v.z, v.w); *(GAS u32x2*)(e.O + (size_t)(MP + m) * e.ldo + col) = o; }
                else if (MODE == 2 || MODE == 3) { const f32x4 x = v + *(const GAS f32x4*)(e.bias + col); f32x4 o;
#pragma unroll
                    for (int j = 0; j < 4; ++j) o[j] = MODE == 2 ? pg8::decay_fn(x[j]) : __builtin_amdgcn_rcpf(1.0f + __builtin_amdgcn_exp2f(-LOG2E * x[j]));
                    *(GAS f32x4*)(e.scanS + (((size_t)((m >> 3) * AH + (col >> 6)) * DSEQ + (m & 7)) * 6 + e.slot) * 64 + (col & 63)) = o; }
                else { const f32x4 y = *(const GAS f32x4*)(e.base + (size_t)m * D + col) + v; *(GAS f32x4*)(e.Y + (size_t)m * D + col) = y;
                    u32x2 o; o.x = pk2(y.x, y.y); o.y = pk2(y.z, y.w); *(GAS u32x2*)(e.XA + (size_t)(MP + m) * D + col) = o;
                    const float qs = sum16((y.x * y.x + y.y * y.y) + (y.z * y.z + y.w * y.w)); if (c4 == 0) e.SSo[(size_t)(MP + m) * 64 + unit] = qs; }
            }
        }
        __syncthreads();
        if (qc) { if (tid == 0) qslot[0] = __hip_atomic_fetch_add(qc, 1u, RLX_AGENT); __syncthreads(); unit = (int)__builtin_amdgcn_readfirstlane(qslot[0]); } else unit += F.G;
    }
}

constexpr int CW_SPLITK = 65536;
__device__ __forceinline__ void skinny_res_splitk(Frame F, const bf16* A, const bf16* Bt, int K, int cset, const SkEpi e, int LD = 0) { PHASE_LOCAL(F);
    K = opaque_s(K); LD = opaque_s(LD ? LD : K);
    const int w = F.wave, q = F.lane & 15, g = F.lane >> 4, tid = w * 64 + F.lane;
    LAS float* part = (LAS float*)(F.lds + RING_OFF); volatile LAS unsigned* lflag = (volatile LAS unsigned*)(F.lds + RING_BYTES + 1536);
    float* PART = (float*)(F.ws + WS_SPLITK);
    for (int task = (int)blockIdx.x; task < 256; task += F.G) { const int unit = task >> 2, kq = task & 3;
        f32x4 acc[4][4];
#pragma unroll
        for (int rt = 0; rt < 4; ++rt)
#pragma unroll
            for (int ct = 0; ct < 4; ++ct) acc[rt][ct] = (f32x4){0.f, 0.f, 0.f, 0.f};
        const bf16* ap = A + (size_t)q * LD + 16 * g;
        const bf16* bp[4];
#pragma unroll
        for (int ct = 0; ct < 4; ++ct) bp[ct] = Bt + (size_t)(64 * unit + 16 * ct + q) * LD + 16 * g;
        const int KC = K >> 6, c0 = (KC * kq) >> 2, c1 = (KC * (kq + 1)) >> 2;
        bf16x8 a[2][4][2], b[2][4][2];
#define SK_LOAD(buf, s) do { _Pragma("unroll") for (int rt = 0; rt < 4; ++rt) { const bf16* p_ = ap + (size_t)(16 * rt) * LD + 64 * (s); a[buf][rt][0] = *(const GAS bf16x8*)p_; a[buf][rt][1] = *(const GAS bf16x8*)(p_ + 8); } \
        _Pragma("unroll") for (int ct = 0; ct < 4; ++ct) { const bf16* p_ = bp[ct] + 64 * (s); b[buf][ct][0] = *(const GAS bf16x8*)p_; b[buf][ct][1] = *(const GAS bf16x8*)(p_ + 8); } } while (0)
#define SK_MMA(buf) do { _Pragma("unroll") for (int h = 0; h < 2; ++h) _Pragma("unroll") for (int rt = 0; rt < 4; ++rt) _Pragma("unroll") for (int ct = 0; ct < 4; ++ct) \
        acc[rt][ct] = __builtin_amdgcn_mfma_f32_16x16x32_bf16(b[buf][ct][h], a[buf][rt][h], acc[rt][ct], 0, 0, 0); } while (0)
        int s = c0 + w;
        if (s < c1) { SK_LOAD(0, s);
            for (; s < c1; s += 16) {
                { const int s1 = s + 8 < c1 ? s + 8 : s; SK_LOAD(1, s1); }
                __builtin_amdgcn_sched_barrier(0);
                SK_MMA(0);
                __builtin_amdgcn_sched_barrier(0);
                { const int s2 = s + 16 < c1 ? s + 16 : s; SK_LOAD(0, s2); }
                __builtin_amdgcn_sched_barrier(0);
                if (s + 8 < c1) SK_MMA(1);
                __builtin_amdgcn_sched_barrier(0);
            } }
#undef SK_LOAD
#undef SK_MMA
#pragma unroll
        for (int rt = 0; rt < 4; ++rt)
#pragma unroll
            for (int ct = 0; ct < 4; ++ct) *(LAS f32x4*)(part + w * 4096 + (16 * rt + q) * 64 + (((4 * ct + g) ^ q) << 2)) = acc[rt][ct];
        __syncthreads();
        gu64* slab = (gu64*)(PART + ((size_t)unit * 4 + kq) * 4096);
#pragma unroll
        for (int it = 0; it < 2; ++it) { const int i = tid + 512 * it, m = i >> 4, c4 = i & 15; f32x4 v = (f32x4){0.f, 0.f, 0.f, 0.f};
#pragma unroll
            for (int ww = 0; ww < 8; ++ww) v += *(const LAS f32x4*)(part + ww * 4096 + m * 64 + ((c4 ^ (m & 15)) << 2));
            const float vx = v.x, vy = v.y, vz = v.z, vw = v.w;
            __hip_atomic_store(slab + 2 * i, ((unsigned long long)__builtin_bit_cast(unsigned, vy) << 32) | __builtin_bit_cast(unsigned, vx), RLX_AGENT);
            __hip_atomic_store(slab + 2 * i + 1, ((unsigned long long)__builtin_bit_cast(unsigned, vw) << 32) | __builtin_bit_cast(unsigned, vz), RLX_AGENT); }
        asm volatile("s_waitcnt vmcnt(0)" ::: "memory");
        __syncthreads();
        if (tid == 0) { const unsigned old = __hip_atomic_fetch_add(F.ctl + CW_SPLITK + (cset * 64 + unit) * 64, 1u, RLX_AGENT); lflag[0] = old; }
        __syncthreads();
        if (lflag[0] == 3u) {
            __builtin_amdgcn_fence(__ATOMIC_ACQUIRE, "agent");
            const gu64* sl = (const gu64*)(PART + (size_t)unit * 4 * 4096);
#pragma unroll
            for (int it = 0; it < 2; ++it) { const int i = tid + 512 * it, m = i >> 4, c4 = i & 15, col = 64 * unit + 4 * c4; f32x4 v = (f32x4){0.f, 0.f, 0.f, 0.f};
#pragma unroll
                for (int kk = 0; kk < 4; ++kk) { const unsigned long long lo = __hip_atomic_load(sl + (size_t)kk * 2048 + 2 * i, RLX_AGENT), hi = __hip_atomic_load(sl + (size_t)kk * 2048 + 2 * i + 1, RLX_AGENT);
                    v += (f32x4){__builtin_bit_cast(float, (unsigned)lo), __builtin_bit_cast(float, (unsigned)(lo >> 32)), __builtin_bit_cast(float, (unsigned)hi), __builtin_bit_cast(float, (unsigned)(hi >> 32))}; }
                f32x4 bs; if (e.base16) { const u32x2 bw = *(const GAS u32x2*)(e.XA + (size_t)(MP + m) * D + col); bs = bf4_to_f32(bw.x, bw.y); } else bs = *(const GAS f32x4*)(e.base + (size_t)m * D + col);
                const f32x4 y = bs + v; if (e.wy) *(GAS f32x4*)(e.Y + (size_t)m * D + col) = y;
                const float qs = sum16((y.x * y.x + y.y * y.y) + (y.z * y.z + y.w * y.w));
                if (e.feed) { u32x2 o; o.x = pk2(y.x, y.y); o.y = pk2(y.z, y.w); *(GAS u32x2*)(e.XA + (size_t)(MP + m) * D + col) = o; if (c4 == 0) e.SSo[(size_t)(MP + m) * 64 + unit] = qs; } }
        }
        __syncthreads();
    }
}
constexpr size_t GRP_ELEMS = (size_t)NBP * 8 * SEQ * 128;
__device__ __forceinline__ float sum32(float x) { x = sum16(x); return x + __shfl_xor(x, 16); }
__device__ __forceinline__ void p10_qkv_post(Frame F) { PHASE_LOCAL(F);
    const int d = 4 * (F.lane & 31);
    const f32x4 gq = *(const GAS f32x4*)(F.a->in[I_QNB] + d), gk = *(const GAS f32x4*)(F.a->in[I_KNB] + d);
    const float qscale = 0.08838834764831845f * LOG2E;
    for (int un = F.gw; un < M * 2; un += F.NGW) { const int row = un >> 1, itb = (un & 1) * 6;
        const bf16* u = WSP(bf16, WS_U) + (size_t)row * NB; const bool isP = row < MP;
        const int b = isP ? row >> 11 : (row - MP) >> 3, t = isP ? row & (SEQ - 1) : (row - MP) & (DSEQ - 1);
        for (int it0 = itb; it0 < itb + 6; it0 += 6) { u32x2 qw[6], kw[6], vw[6];
#pragma unroll
            for (int j = 0; j < 6; ++j) { const int c = 256 * (it0 + j) + 4 * F.lane; qw[j] = *(const GAS u32x2*)(u + c); kw[j] = *(const GAS u32x2*)(u + MIXW + c); vw[j] = *(const GAS u32x2*)(u + 2 * MIXW + c); }
#pragma unroll
            for (int j = 0; j < 6; ++j) { const int it = it0 + j; const int H = 2 * it + (F.lane >> 5), g = H >> 3, h = H & 7, dsh = 2 * g, dil = 1 << dsh, sub = SEQ >> dsh, win = 128 << dsh;
            const f32x4 q = bf4_to_f32(qw[j].x, qw[j].y), k = bf4_to_f32(kw[j].x, kw[j].y), v = bf4_to_f32(vw[j].x, vw[j].y);
            const float rq = 1.0f / sqrtf(sum32((q.x * q.x + q.y * q.y) + (q.z * q.z + q.w * q.w)) * (1.0f / 128.0f) + RMS_EPS), rk = 1.0f / sqrtf(sum32((k.x * k.x + k.y * k.y) + (k.z * k.z + k.w * k.w)) * (1.0f / 128.0f) + RMS_EPS);
            const f32x4 qn = q * rq * gq, kn = k * rk * gk;
            float* ob;
            if (isP) { const int r = t & (dil - 1), jj = t >> dsh; const size_t seq = (size_t)((b * 8 + h) * dil + r);
                u32x2 o; o.x = pk2(qn.x * qscale, qn.y * qscale); o.y = pk2(qn.z * qscale, qn.w * qscale); *(GAS u32x2*)(WSP(bf16, WS_QN) + g * GRP_ELEMS + (seq * sub + jj) * 128 + d) = o;
                o.x = pk2(kn.x, kn.y); o.y = pk2(kn.z, kn.w); *(GAS u32x2*)(WSP(bf16, WS_KN) + g * GRP_ELEMS + (seq * sub + jj) * 128 + d) = o;
                *(GAS u32x2*)(WSP(bf16, WS_VT) + g * GRP_ELEMS + (seq * sub + jj) * 128 + d) = vw[j];
                const int keep = win < SEQ ? win : SEQ;
                ob = t >= SEQ - keep ? F.out + (g == 0 ? OUT_SWAP1 : (g == 1 ? OUT_SWAP2 : OUT_SWAP3)) + ((size_t)(b * keep + (t - (SEQ - keep))) * 2) * 1024 + h * 128 + d : nullptr;
            } else { *(GAS f32x4*)(WSP(float, WS_QS) + ((size_t)(row - MP) * 24 + H) * 128 + d) = qn * qscale;
                ob = F.out + (g == 0 ? OUT_SWAS1 : (g == 1 ? OUT_SWAS2 : OUT_SWAS3)) + ((size_t)(b * win + (win - DSEQ + t)) * 2) * 1024 + h * 128 + d; }
            if (ob) { *(GAS f32x4*)ob = kn; *(GAS f32x4*)(ob + 1024) = v; }
            } }
    }
}
__device__ __forceinline__ void band_attn_task(const bf16* QNs, const bf16* KNs, const bf16* VTs, int sub, int i0, bf16* OGrow0, size_t ogstride, float* LSErow0, size_t lsestride, int lane) {
    const int q = lane & 15, g = lane >> 4, ks = i0 - 144;
    bf16x8 Bq[4];
#pragma unroll
    for (int s = 0; s < 4; ++s) Bq[s] = *(const GAS bf16x8*)(QNs + (size_t)(i0 + q) * 128 + 32 * s + 8 * g);
    f32x4 sT[10]; float mx = -3.0e38f;
#pragma unroll
    for (int kt = 0; kt < 10; ++kt) { f32x4 acc = (f32x4){0.f, 0.f, 0.f, 0.f}; int kr = ks + 16 * kt + q; kr = kr < 0 ? 0 : kr; const bf16* kp = KNs + (size_t)kr * 128 + 8 * g;
#pragma unroll
        for (int s = 0; s < 4; ++s) { const bf16x8 a = *(const GAS bf16x8*)(kp + 32 * s); acc = __builtin_amdgcn_mfma_f32_16x16x32_bf16(a, Bq[s], acc, 0, 0, 0); }
#pragma unroll
        for (int i = 0; i < 4; ++i) { const int kpos = ks + 16 * kt + 4 * g + i, dist = (i0 + q) - kpos; const bool ok = kpos >= 0 && dist >= 0 && dist <= 128; acc[i] = ok ? acc[i] : -1.0e30f; mx = fmaxf(mx, acc[i]); }
        sT[kt] = acc; }
    mx = fmaxf(mx, __shfl_xor(mx, 16)); mx = fmaxf(mx, __shfl_xor(mx, 32));
    float l = 0.f;
#pragma unroll
    for (int kt = 0; kt < 10; ++kt) {
#pragma unroll
        for (int i = 0; i < 4; ++i) { const float p = __builtin_amdgcn_exp2f(sT[kt][i] - mx); sT[kt][i] = p; l += p; } }
    l += __shfl_xor(l, 16); l += __shfl_xor(l, 32);
    const float inv = 1.0f / l;
    bf16x8 Bp[5];
#pragma unroll
    for (int s = 0; s < 5; ++s) { v4u w; w.x = pk2(sT[2 * s][0], sT[2 * s][1]); w.y = pk2(sT[2 * s][2], sT[2 * s][3]); w.z = pk2(sT[2 * s + 1][0], sT[2 * s + 1][1]); w.w = pk2(sT[2 * s + 1][2], sT[2 * s + 1][3]);
        Bp[s] = __builtin_bit_cast(bf16x8, w); }
    typedef unsigned u2 __attribute__((ext_vector_type(2)));
    f32x4 o[8];
#pragma unroll
    for (int dt = 0; dt < 8; ++dt) { o[dt] = (f32x4){0.f, 0.f, 0.f, 0.f}; const bf16* vp = VTs + (size_t)(16 * dt + q) * sub;
#pragma unroll
        for (int s = 0; s < 5; ++s) { int c0 = ks + 32 * s + 4 * g, c1 = c0 + 16; c0 = c0 < 0 ? 0 : c0; c1 = c1 < 0 ? 0 : c1;
            const u2 lo = *(const GAS u2*)(vp + c0), hi = *(const GAS u2*)(vp + c1); v4u w; w.x = lo.x; w.y = lo.y; w.z = hi.x; w.w = hi.y;
            o[dt] = __builtin_amdgcn_mfma_f32_16x16x32_bf16(__builtin_bit_cast(bf16x8, w), Bp[s], o[dt], 0, 0, 0); } }
#pragma unroll
    for (int dt = 0; dt < 8; ++dt) { u2 w; w.x = pk2(o[dt][0] * inv, o[dt][1] * inv); w.y = pk2(o[dt][2] * inv, o[dt][3] * inv);
        *(GAS u2*)(OGrow0 + (size_t)q * ogstride + 16 * dt + 4 * g) = w; }
    if (g == 0) LSErow0[(size_t)q * lsestride] = (mx + __builtin_amdgcn_logf(l)) * LN2;
}
__device__ __forceinline__ void band_attn_wg(Frame F) { PHASE_LOCAL(F);
    LAS unsigned char* kimg = F.lds + RING_OFF; LAS unsigned char* vimg = F.lds + RING_OFF + 65536;
    const int w = F.wave;
    typedef unsigned u2 __attribute__((ext_vector_type(2))); typedef short v4i16 __attribute__((ext_vector_type(4)));
    __syncthreads();
    for (int unit = (int)blockIdx.x; unit < 1536; unit += F.G) {
        const int lane = opaque_v(F.lane), q = lane & 15, g = lane >> 4;
        const int grp = unit >> 9, uu = unit & 511, dsh = 2 * grp, dil = 1 << dsh, sub = SEQ >> dsh, ups = sub >> 7;
        const int seq = uu / ups, i0 = (uu % ups) * 128, ks0 = i0 - 128, r = seq & (dil - 1), bh = seq >> dsh, b = bh >> 3, h = bh & 7;
        const bf16* QNs = WSP(bf16, WS_QN) + grp * GRP_ELEMS + (size_t)seq * sub * 128; const bf16* KNs = WSP(bf16, WS_KN) + grp * GRP_ELEMS + (size_t)seq * sub * 128;
        const bf16* VNs = WSP(bf16, WS_VT) + grp * GRP_ELEMS + (size_t)seq * sub * 128;
#pragma unroll
        for (int i = 0; i < 8; ++i) { const int blk = w * 8 + i, P = blk * 64 + lane, row = P >> 4, c = (P & 15) ^ (row & 15); int kr = ks0 + row; kr = kr < 0 ? 0 : kr;
            __builtin_amdgcn_global_load_lds((const unsigned*)(KNs + (size_t)kr * 128 + c * 8), (LAS unsigned*)(kimg + blk * 1024), 16, 0, 0); }
        bf16x8 Bq[4];
#pragma unroll
        for (int s = 0; s < 4; ++s) Bq[s] = *(const GAS bf16x8*)(QNs + (size_t)(i0 + 16 * w + q) * 128 + 32 * s + 8 * g);
#pragma unroll
        for (int i = 0; i < 8; ++i) { const int blk = w * 8 + i, P = blk * 64 + lane, row = P >> 4, c = (P & 15) ^ (row & 15); int kr = ks0 + row; kr = kr < 0 ? 0 : kr;
            __builtin_amdgcn_global_load_lds((const unsigned*)(VNs + (size_t)kr * 128 + c * 8), (LAS unsigned*)(vimg + blk * 1024), 16, 0, 0); }
        asm volatile("s_waitcnt vmcnt(8)" ::: "memory"); __syncthreads();
        const int ts = w & ~1, qpos = i0 + 16 * w + q;
        f32x4 sT[10]; float mx = -3.0e38f;
#pragma unroll
        for (int t = 0; t < 10; ++t) { f32x4 acc = (f32x4){0.f, 0.f, 0.f, 0.f}; const LAS unsigned char* kr = kimg + (16 * (ts + t) + q) * 256;
#pragma unroll
            for (int s = 0; s < 4; ++s) { const bf16x8 a = *(const LAS bf16x8*)(kr + (((4 * s + g) ^ q) << 4)); acc = __builtin_amdgcn_mfma_f32_16x16x32_bf16(a, Bq[s], acc, 0, 0, 0); }
#pragma unroll
            for (int i = 0; i < 4; ++i) { const int kpos = ks0 + 16 * (ts + t) + 4 * g + i, dist = qpos - kpos; const bool ok = kpos >= 0 && dist >= 0 && dist <= 128; acc[i] = ok ? acc[i] : -1.0e30f; mx = fmaxf(mx, acc[i]); }
            sT[t] = acc; }
        mx = fmaxf(mx, __shfl_xor(mx, 16)); mx = fmaxf(mx, __shfl_xor(mx, 32));
        float l = 0.f;
#pragma unroll
        for (int t = 0; t < 10; ++t) {
#pragma unroll
            for (int i = 0; i < 4; ++i) { const float p = __builtin_amdgcn_exp2f(sT[t][i] - mx); sT[t][i] = p; l += p; } }
        l += __shfl_xor(l, 16); l += __shfl_xor(l, 32);
        const float inv = 1.0f / l;
        bf16x8 Bp[5];
#pragma unroll
        for (int s = 0; s < 5; ++s) { v4u ww; ww.x = pk2(sT[2 * s][0], sT[2 * s][1]); ww.y = pk2(sT[2 * s][2], sT[2 * s][3]); ww.z = pk2(sT[2 * s + 1][0], sT[2 * s + 1][1]); ww.w = pk2(sT[2 * s + 1][2], sT[2 * s + 1][3]);
            Bp[s] = __builtin_bit_cast(bf16x8, ww); }
        asm volatile("s_waitcnt vmcnt(0)" ::: "memory"); __syncthreads();
        const size_t row0 = (size_t)b * SEQ + r + (size_t)dil * (i0 + 16 * w);
        bf16* OGrow = WSP(bf16, WS_OG) + ((size_t)grp * MP + row0 + (size_t)dil * q) * 1024 + h * 128;
        const int trow = 4 * g + (q >> 2), tp = q & 3;
#pragma unroll 2
        for (int dt = 0; dt < 8; ++dt) { f32x4 o = (f32x4){0.f, 0.f, 0.f, 0.f};
#pragma unroll
            for (int s = 0; s < 5; ++s) { const int row = 16 * (ts + 2 * s) + trow; const LAS unsigned char* va = vimg + row * 256 + (((2 * dt + (tp >> 1)) ^ (row & 15)) << 4) + 8 * (tp & 1);
                const v4i16 lo = __builtin_amdgcn_ds_read_tr16_b64_v4i16((LAS v4i16*)va), hi = __builtin_amdgcn_ds_read_tr16_b64_v4i16((LAS v4i16*)(va + 4096));
                const u2 lw = __builtin_bit_cast(u2, lo), hw = __builtin_bit_cast(u2, hi); v4u ww; ww.x = lw.x; ww.y = lw.y; ww.z = hw.x; ww.w = hw.y;
                o = __builtin_amdgcn_mfma_f32_16x16x32_bf16(__builtin_bit_cast(bf16x8, ww), Bp[s], o, 0, 0, 0); }
            u2 ww; ww.x = pk2(o[0] * inv, o[1] * inv); ww.y = pk2(o[2] * inv, o[3] * inv); *(GAS u2*)(OGrow + 16 * dt + 4 * g) = ww;
            __builtin_amdgcn_sched_barrier(0); }
        if (g == 0) WSP(float, WS_LSE)[((size_t)grp * MP + row0 + (size_t)dil * q) * 8 + h] = (mx + __builtin_amdgcn_logf(l)) * LN2;
        __syncthreads();
    }
}
__device__ __forceinline__ void band_attn_phase(Frame F) { PHASE_LOCAL(F);
    for (int task = F.gw; task < 3 * 4096; task += F.NGW) { const int g = task >> 12, tt = task & 4095, dsh = 2 * g, dil = 1 << dsh, sub = SEQ >> dsh, tps = sub >> 4;
        const int seq = tt / tps, i0 = (tt % tps) * 16, r = seq & (dil - 1), bh = seq >> dsh, b = bh >> 3, h = bh & 7;
        const size_t row0 = (size_t)b * SEQ + r + (size_t)dil * i0;
        band_attn_task(WSP(bf16, WS_QN) + g * GRP_ELEMS + (size_t)seq * sub * 128, WSP(bf16, WS_KN) + g * GRP_ELEMS + (size_t)seq * sub * 128, WSP(bf16, WS_VT) + g * GRP_ELEMS + (size_t)seq * 128 * sub, sub, i0,
                       WSP(bf16, WS_OG) + (size_t)g * MP * 1024 + row0 * 1024 + h * 128, (size_t)dil * 1024, WSP(float, WS_LSE) + ((size_t)g * MP + row0) * 8 + h, (size_t)dil * 8, F.lane); }
}
__device__ __forceinline__ void sample_attn_phase(Frame F) { PHASE_LOCAL(F);
    LAS float* qs = (LAS float*)(F.lds + RING_OFF + F.wave * 16384);
    for (int task = F.gw; task < MS * 8 * 3; task += F.NGW) { const int g = task % 3, sh = task / 3, sr = sh >> 3, h = sh & 7, b = sr >> 3, t = sr & 7;
        const int dsh = 2 * g, dil = 1 << dsh, win = 128 << dsh; const float* C = g == 0 ? F.a->in[I_C1] : (g == 1 ? F.a->in[I_C2] : F.a->in[I_C3]); const float* NO = F.out + (g == 0 ? OUT_SWAS1 : (g == 1 ? OUT_SWAS2 : OUT_SWAS3));
        { const f32x2 qv = *(const GAS f32x2*)(WSP(float, WS_QS) + ((size_t)sr * 24 + g * 8 + h) * 128 + 2 * F.lane); qs[2 * F.lane] = qv.x; qs[2 * F.lane + 1] = qv.y; }
        LDS_WAIT(); asm volatile("" ::: "memory");
        float sc[3];
#pragma unroll
        for (int jj = 0; jj < 3; ++jj) { const int j = F.lane + 64 * jj; const bool ok = j <= 128; const int idx = win + t - dil * (ok ? j : 0);
            const float* kp = idx < win ? C + ((size_t)(b * win + idx) * 2) * 1024 + h * 128 : NO + ((size_t)(b * win + idx - DSEQ) * 2) * 1024 + h * 128;
            float s = 0.f;
            if (jj < 2 || F.lane == 0) {
#pragma unroll 16
                for (int d4 = 0; d4 < 32; ++d4) { const f32x4 kv = *(const GAS f32x4*)(kp + 4 * d4); const f32x4 qv = *(const LAS f32x4*)(qs + 4 * d4); s += (kv.x * qv.x + kv.y * qv.y) + (kv.z * qv.z + kv.w * qv.w); } }
            sc[jj] = ok ? s : -1.0e30f; }
        const float m = wave_max(fmaxf(fmaxf(sc[0], sc[1]), sc[2]));
        float p[3], ps = 0.f;
#pragma unroll
        for (int jj = 0; jj < 3; ++jj) { p[jj] = __builtin_amdgcn_exp2f(sc[jj] - m); ps += p[jj]; }
        const float l = wave_sum(ps); float o0 = 0.f, o1 = 0.f;
#pragma unroll
        for (int jj = 0; jj < 3; ++jj) { const int nj = jj < 2 ? 64 : 1;
#pragma unroll 16
            for (int jl = 0; jl < nj; ++jl) { const int j = jl + 64 * jj, idx = win + t - dil * j; const float pj = __shfl(p[jj], jl);
                const float* vp = (idx < win ? C + ((size_t)(b * win + idx) * 2 + 1) * 1024 : NO + ((size_t)(b * win + idx - DSEQ) * 2 + 1) * 1024) + h * 128 + 2 * F.lane;
                const f32x2 vv = *(const GAS f32x2*)vp; o0 += pj * vv.x; o1 += pj * vv.y; } }
        const float inv = 1.0f / l;
        *(GAS unsigned*)(WSP(bf16, WS_OGS) + ((size_t)g * MS + sr) * 1024 + h * 128 + 2 * F.lane) = pk2(o0 * inv, o1 * inv);
        if (F.lane == 0) ((float*)(F.ws + WS_OGS + 512 * 1024))[((size_t)g * MS + sr) * 8 + h] = (m + __builtin_amdgcn_logf(l)) * LN2;
        asm volatile("" ::: "memory");
    }
}
__device__ __forceinline__ void merge_phase(Frame F) { PHASE_LOCAL(F);
    for (int row = F.gw; row < M; row += F.NGW) { const int h = F.lane >> 3;
        const bool isP = row < MP; const int rr = isP ? row : row - MP; const size_t gs = isP ? MP : MS;
        const float* lse = isP ? WSP(float, WS_LSE) : (const float*)(F.ws + WS_OGS + 512 * 1024); const bf16* og = isP ? WSP(bf16, WS_OG) : WSP(bf16, WS_OGS);
        const float l0 = lse[((size_t)0 * gs + rr) * 8 + h], l1 = lse[((size_t)1 * gs + rr) * 8 + h], l2 = lse[((size_t)2 * gs + rr) * 8 + h];
        const float mm = fmaxf(l0, fmaxf(l1, l2)); float w0 = expf(l0 - mm), w1 = expf(l1 - mm), w2 = expf(l2 - mm); const float is = 1.0f / (w0 + w1 + w2); w0 *= is; w1 *= is; w2 *= is;
        float acc[16];
#pragma unroll
        for (int j = 0; j < 16; ++j) acc[j] = 0.f;
#pragma unroll
        for (int g = 0; g < 3; ++g) { const float w = g == 0 ? w0 : (g == 1 ? w1 : w2); const bf16* src = og + ((size_t)g * gs + rr) * 1024 + 16 * F.lane;
#pragma unroll
            for (int c = 0; c < 2; ++c) { const v4u raw = *(const GAS v4u*)(src + 8 * c); const unsigned ww[4] = {raw.x, raw.y, raw.z, raw.w};
#pragma unroll
                for (int j = 0; j < 4; ++j) { acc[8 * c + 2 * j] += w * __builtin_bit_cast(float, ww[j] << 16); acc[8 * c + 2 * j + 1] += w * __builtin_bit_cast(float, ww[j] & 0xffff0000u); } } }
        bf16* dst = WSP(bf16, WS_O) + (size_t)row * 2048 + 16 * F.lane;
#pragma unroll
        for (int c = 0; c < 2; ++c) { v4u w; w.x = pk2(acc[8 * c], acc[8 * c + 1]); w.y = pk2(acc[8 * c + 2], acc[8 * c + 3]); w.z = pk2(acc[8 * c + 4], acc[8 * c + 5]); w.w = pk2(acc[8 * c + 6], acc[8 * c + 7]);
            *(GAS v4u*)(dst + 8 * c) = w; }
    }
}
#ifndef PH_MASK
#define PH_MASK 0xFFFF
#endif
#ifndef P3_SUB
#define P3_SUB 7
#endif
#ifndef REP_MASK
#define REP_MASK 0
#endif
#define REP(k) (((REP_MASK >> (k)) & 1) ? 2 : 1)
#ifndef P6_SK
#define P6_SK 1
#endif
#ifndef MK_STOP_AFTER
#define MK_STOP_AFTER 99
#endif
__device__ __forceinline__ int rot_c(int c, int G, int used) { int r = c - (used % G); return r < 0 ? r + G : r; }

#define RS_CACHE(F) ((LAS float*)((F).lds + RING_BYTES + 4096))
#define RS_RESET(F) do { __syncthreads(); if ((F).tid == 0) ((volatile LAS int*)RS_CACHE(F))[256] = -1; __syncthreads(); } while (0)
#define IN(k) (((PH_MASK >> (k)) & 1) && (k) <= MK_STOP_AFTER)
#define SEAM(k) do { if (IN(k) && IN((k) + 1)) xcd_barrier(bar); } while (0)
template <int layer> __device__ __forceinline__ void tail_phases(Frame F, const XcdBarrier bar) {
    const int cb = (int)blockIdx.x; LAS unsigned char* ring = F.lds + RING_OFF;
        const int pb = layer == 0 ? 6 : 13;
        if (IN(pb)) { const int K = layer == 0 ? D : 2048; const bf16* Wt = layer == 0 ? WSP(bf16, WS_WOUTA) : WSP(bf16, WS_WOUTB); float* SSo = WSP(float, WS_SS) + (size_t)(2 * layer + 1) * (SS_STRIDE / 4);
            { pg8::Gemm g{WSP(bf16, WS_O), Wt, MP, D, K}; pg8::StaticOrder S; S.init(MP, D, F.G, cb);
              typedef pg8::EpiRes<layer != 0, false, true> EpiO;
              EpiO E{F.a->in[I_XP], F.a->in[I_XS], F.out, WSP(bf16, WS_XA), SSo, D, M};
              pg8::gemm_phase<EpiO, pg8::StaticOrder, true, true>(ring, g, S, E); }
            { SkEpi e{}; e.base = F.a->in[I_XS]; e.base16 = layer != 0; e.wy = 0; e.feed = 1; e.Y = F.out + (size_t)MP * D; e.XA = WSP(bf16, WS_XA); e.SSo = SSo;
              skinny_res_splitk(F, WSP(bf16, WS_O) + (size_t)MP * K, Wt, K, 2 * layer, e); }
            if (layer == 0 && REP(6) == 2) {
            { pg8::Gemm g{WSP(bf16, WS_O), Wt, MP, D, K}; pg8::StaticOrder S; S.init(MP, D, F.G, cb);
              typedef pg8::EpiRes<layer != 0, false, true> EpiO;
              EpiO E{F.a->in[I_XP], F.a->in[I_XS], F.out, WSP(bf16, WS_XA), SSo, D, M};
              pg8::gemm_phase<EpiO, pg8::StaticOrder, true, true>(ring, g, S, E); }
            if (P6_SK) { SkEpi e{}; e.base = F.a->in[I_XS]; e.base16 = layer != 0; e.wy = 0; e.feed = 1; e.Y = F.out + (size_t)MP * D; e.XA = WSP(bf16, WS_XA); e.SSo = SSo;
              skinny_res_splitk(F, WSP(bf16, WS_O) + (size_t)MP * K, Wt, K, 2 * layer, e); } } }
        SEAM(pb);
        if (IN(pb + 1)) { const bf16* Wt = WSP(bf16, WS_WFI) + (size_t)layer * NFI * KFIP; const float* SSi = WSP(float, WS_SS) + (size_t)(2 * layer + 1) * (SS_STRIDE / 4);
            { pg8::Gemm g{WSP(bf16, WS_XA), Wt, MP, NFI, D, D, KFIP}; pg8::StaticOrder S; S.init(MP, NFI, F.G, cb);
              RS_RESET(F); pg8::EpiSwiGLU E{WSP(bf16, WS_U), DFFP, {SSi, RS_CACHE(F)}};
              pg8::gemm_phase<pg8::EpiSwiGLU, pg8::StaticOrder, true, true>(ring, g, S, E); }
            { SkEpi e{}; e.O = WSP(bf16, WS_U); e.ldo = DFFP; e.ss = SSi; skinny_gemm<5>(F, WSP(bf16, WS_XA) + (size_t)MP * D, Wt, D, DFF / 32, 32 * 86, e, F.ctl + CW_SKQ + 64 * layer, KFIP); }
            if (REP(pb + 1) == 2) { { pg8::Gemm g{WSP(bf16, WS_XA), Wt, MP, NFI, D, D, KFIP}; pg8::StaticOrder S; S.init(MP, NFI, F.G, cb);
              RS_RESET(F); pg8::EpiSwiGLU E{WSP(bf16, WS_U), DFFP, {SSi, RS_CACHE(F)}};
              pg8::gemm_phase<pg8::EpiSwiGLU, pg8::StaticOrder, true, true>(ring, g, S, E); }
            { SkEpi e{}; e.O = WSP(bf16, WS_U); e.ldo = DFFP; e.ss = SSi; skinny_gemm<5>(F, WSP(bf16, WS_XA) + (size_t)MP * D, Wt, D, DFF / 32, 32 * 86, e, nullptr, KFIP); } } }
        SEAM(pb + 1);
        if (IN(pb + 2)) { const bf16* Wt = WSP(bf16, WS_WFOP) + (size_t)layer * D * DFFP; float* SSo = WSP(float, WS_SS) + (size_t)(2 * layer + 2) * (SS_STRIDE / 4);
            { pg8::Gemm g{WSP(bf16, WS_U), Wt, MP, D, DFF, DFFP}; pg8::StaticOrder S; S.init(MP, D, F.G, cb);
              typedef pg8::EpiRes<true, layer == 1, layer == 0> EpiF;
              EpiF E{nullptr, nullptr, F.out, WSP(bf16, WS_XA), SSo, D, M};
              pg8::gemm_phase<EpiF, pg8::StaticOrder, true, true>(ring, g, S, E); }
            { SkEpi e{}; e.base16 = 1; e.wy = layer == 1; e.feed = layer == 0; e.Y = F.out + (size_t)MP * D; e.XA = WSP(bf16, WS_XA); e.SSo = SSo;
              skinny_res_splitk(F, WSP(bf16, WS_U) + (size_t)MP * DFFP, Wt, DFF, 2 * layer + 1, e, DFFP); }
            if (layer == 0 && REP(15) == 2) { SkEpi e{}; e.base16 = 1; e.wy = 1; e.feed = 0; e.Y = WSP(float, WS_WARR); e.XA = WSP(bf16, WS_XA); e.SSo = SSo;
              skinny_res_splitk(F, WSP(bf16, WS_U) + (size_t)MP * DFFP, Wt, DFF, 5, e, DFFP); }
            if (layer == 0 && REP(8) == 2) { pg8::Gemm g{WSP(bf16, WS_U), Wt, MP, D, DFF, DFFP}; pg8::StaticOrder S; S.init(MP, D, F.G, cb);
              typedef pg8::EpiRes<true, true, false> EpiP;
              EpiP E{nullptr, nullptr, WSP(float, WS_WARR), WSP(bf16, WS_XA), SSo, D, M};
              pg8::gemm_phase<EpiP, pg8::StaticOrder, true, true>(ring, g, S, E); } }
}
__global__ void __launch_bounds__(NWAVES * 64, 2) mega_fwd(Args args) {
    extern __shared__ __attribute__((aligned(16))) unsigned char lds[];
    Frame F;
    F.lds = (LAS unsigned char*)lds;
    F.MISC = (volatile LAS unsigned*)(F.lds + MISC_OFF);
    F.tid = threadIdx.x; F.lane = F.tid & 63; F.wave = __builtin_amdgcn_readfirstlane(F.tid >> 6);
    F.G = gridDim.x; { const int bx = blockIdx.x; F.vcu = (F.G % 8 == 0) ? (bx % 8) * (F.G / 8) + bx / 8 : bx; }
    F.gw = F.vcu * NWAVES + F.wave; F.NGW = F.G * NWAVES;
    F.ws = args.ws; F.out = args.out; F.ctl = (gu32*)(args.ws + WS_CTL);
    F.a = &args;
    for (int u = F.tid; u < (LDS_BYTES - LDSCTL_OFF) / 4; u += NWAVES * 64) ((LAS unsigned*)(F.lds + LDSCTL_OFF))[u] = 0u;
    __syncthreads();
    XcdBarrier bar = xcd_barrier_post((unsigned*)(F.ctl + CW_BAR), F.MISC + 8);
    const int cb = (int)blockIdx.x;
    LAS unsigned char* ring = F.lds + RING_OFF;

    if (IN(0)) { for (int rep = 0; rep < REP(0); ++rep) p0_prologue(F); }
    SEAM(0);
    if (IN(1)) {
        { pg8::Gemm g{WSP(bf16, WS_XA), WSP(bf16, WS_WINA), MPAD, NA, D}; pg8::StaticOrder S; S.init(MPAD, NA, F.G, cb);
          RS_RESET(F); pg8::EpiB16<3> E{WSP(bf16, WS_U), NA, {WSP(float, WS_SS), RS_CACHE(F)}};
          pg8::gemm_phase<pg8::EpiB16<3>, pg8::StaticOrder, true, true>(ring, g, S, E); }
        for (int l = 0; l < 2; ++l) { pg8::Gemm g{WSP(bf16, WS_XM), WSP(bf16, WS_WMEM) + (size_t)l * 2048 * D, 1024, 2048, D}; pg8::StaticOrder S; S.init(1024, 2048, F.G, rot_c(cb, F.G, 33 * 43 + 32 * l));
          pg8::EpiF32 E{WSP(float, WS_MEMRAW) + (size_t)l * 1024 * 2048, 2048, {WSP(float, WS_RSTDM)}};
          pg8::gemm_phase<pg8::EpiF32, pg8::StaticOrder, true, true>(ring, g, S, E); }
        if (REP(1) == 2) {
        { pg8::Gemm g{WSP(bf16, WS_XA), WSP(bf16, WS_WINA), MPAD, NA, D}; pg8::StaticOrder S; S.init(MPAD, NA, F.G, cb);
          RS_RESET(F); pg8::EpiB16<3> E{WSP(bf16, WS_U), NA, {WSP(float, WS_SS), RS_CACHE(F)}};
          pg8::gemm_phase<pg8::EpiB16<3>, pg8::StaticOrder, true, true>(ring, g, S, E); }
        for (int l = 0; l < 2; ++l) { pg8::Gemm g{WSP(bf16, WS_XM), WSP(bf16, WS_WMEM) + (size_t)l * 2048 * D, 1024, 2048, D}; pg8::StaticOrder S; S.init(1024, 2048, F.G, rot_c(cb, F.G, 33 * 43 + 32 * l));
          pg8::EpiF32 E{WSP(float, WS_MEMRAW) + (size_t)l * 1024 * 2048, 2048, {WSP(float, WS_RSTDM)}};
          pg8::gemm_phase<pg8::EpiF32, pg8::StaticOrder, true, true>(ring, g, S, E); } }
    }
    SEAM(1);
    if (IN(2)) { p2_lora_prep(F); p2_memkv_post(F); if (REP(2) == 2) { p2_lora_prep(F); p2_memkv_post(F); } }
    SEAM(2);
    if (IN(3)) {
        { pg8::Gemm g{WSP(bf16, WS_XLW), WSP(bf16, WS_W2), MPAD, MIXW, 256}; pg8::StaticOrder S; S.init(MPAD, MIXW, F.G, cb);
          pg8::EpiAct<0> E{WSP(float, WS_WARR), MIXW, F.a->in[I_W0]};
          pg8::gemm_phase<pg8::EpiAct<0>, pg8::StaticOrder, true, true>(ring, g, S, E); }
        { pg8::Gemm g{WSP(bf16, WS_XLA), WSP(bf16, WS_A2), MPAD, MIXW, 256}; pg8::StaticOrder S; S.init(MPAD, MIXW, F.G, rot_c(cb, F.G, 396));
          pg8::EpiAct<1> E{WSP(float, WS_AARR), MIXW, F.a->in[I_A0]};
          pg8::gemm_phase<pg8::EpiAct<1>, pg8::StaticOrder, true, true>(ring, g, S, E); }
        { pg8::Gemm g{WSP(bf16, WS_XLG), WSP(bf16, WS_G2), MPAD, MIXW, 384}; pg8::StaticOrder S; S.init(MPAD, MIXW, F.G, rot_c(cb, F.G, 792));
          pg8::EpiB16<0> E{WSP(bf16, WS_G), MIXW, {nullptr}};
          pg8::gemm_phase<pg8::EpiB16<0>, pg8::StaticOrder, true, true>(ring, g, S, E); }
        mem_attend_wg(F, 0, WSP(bf16, WS_U), NA, ASW, WSP(bf16, WS_O), D, MIXW, F.G == 256 ? (cb >= 224 ? 256 + cb - 224 : -1) : -2);
    }
    SEAM(4);
    if (IN(5)) {
        const bool spread = F.G == 256; const bool scanwg = spread ? (F.vcu & 31) < 24 : F.vcu < NBP * AH; int gch = 0;
        const int sidx = spread ? (scanwg ? (F.vcu >> 5) * 24 + (F.vcu & 31) : (F.vcu >> 5) * 8 + (F.vcu & 31) - 24) : (scanwg ? F.vcu : F.vcu - NBP * AH);
        constexpr int SNB = 4, P5_SCR = SNB * SCH * 1536 + 1024;
        if (F.tid < 32) ((volatile LAS unsigned*)(F.lds + RING_OFF + SNB * SCH * 1536))[F.tid] = 0u;
        __syncthreads();
        if (F.wave < 7) { if (scanwg) p5_scan_wg<SNB>(F, sidx, gch);
            else { for (int i = 0; i < 6; ++i) { const int t = sidx + (F.G - NBP * AH) * i; if (t < NBS * AH) p5_scan_wg<SNB>(F, NBP * AH + t, gch); } } }
        p5_background(F, P5_SCR + F.wave * P5_SCR_STRIDE, scanwg && F.wave == 7);
    }
    SEAM(5);
    tail_phases<0>(F, bar);
    SEAM(8);

            if (IN(9)) { { pg8::Gemm g{WSP(bf16, WS_XA), WSP(bf16, WS_WINB), MP, NB, D}; pg8::StaticOrder S; S.init(MP, NB, F.G, cb);
                RS_RESET(F); pg8::EpiB16<3> E{WSP(bf16, WS_U), NB, {WSP(float, WS_SS) + 2 * (SS_STRIDE / 4), RS_CACHE(F)}};
                pg8::gemm_phase<pg8::EpiB16<3>, pg8::StaticOrder, true, true>(ring, g, S, E); }
                { SkEpi e{}; e.O = WSP(bf16, WS_U); e.ldo = NB; e.ss = WSP(float, WS_SS) + 2 * (SS_STRIDE / 4);
                  skinny_gemm<0>(F, WSP(bf16, WS_XA) + (size_t)MP * D, WSP(bf16, WS_WINB), D, NB / 64, 32 * 40, e); }
                if (REP(9) == 2) { { pg8::Gemm g{WSP(bf16, WS_XA), WSP(bf16, WS_WINB), MP, NB, D}; pg8::StaticOrder S; S.init(MP, NB, F.G, cb);
                RS_RESET(F); pg8::EpiB16<3> E{WSP(bf16, WS_U), NB, {WSP(float, WS_SS) + 2 * (SS_STRIDE / 4), RS_CACHE(F)}};
                pg8::gemm_phase<pg8::EpiB16<3>, pg8::StaticOrder, true, true>(ring, g, S, E); }
                { SkEpi e{}; e.O = WSP(bf16, WS_U); e.ldo = NB; e.ss = WSP(float, WS_SS) + 2 * (SS_STRIDE / 4);
                  skinny_gemm<0>(F, WSP(bf16, WS_XA) + (size_t)MP * D, WSP(bf16, WS_WINB), D, NB / 64, 32 * 40, e); } } }
            SEAM(9);
            if (IN(10)) { p10_qkv_post(F); if (REP(10) == 2) p10_qkv_post(F); }
            SEAM(10);
#define P11_BODY do { sample_attn_phase(F); band_attn_wg(F); mem_attend_wg(F, 1, WSP(bf16, WS_U), NB, 3 * MIXW, WSP(bf16, WS_O), 2048, 1024, F.G == 256 ? ((cb & 7) == 7 ? 256 + (cb >> 3) : -1) : -2); } while (0)
            if (IN(11)) { P11_BODY; if (REP(11) == 2) { P11_BODY; } }
            SEAM(11);
            if (IN(12)) { merge_phase(F); if (REP(12) == 2) merge_phase(F); }
            SEAM(12);
            tail_phases<1>(F, bar);
#undef IN
#undef SEAM
}

extern "C" void kernel_launch(void* const* d_in, const int* in_sizes, int n_in, void* d_out, int out_size, void* d_ws, size_t ws_size, hipStream_t stream) {
    static int grid = 0;
    if (grid == 0) {
        if (n_in != N_IN || (size_t)out_size != OUT_END || ws_size < WS_END) { fprintf(stderr, "kernel_launch: unexpected sizes: n_in %d out %d (want %zu) ws %zu (want %zu)\n", n_in, out_size, (size_t)OUT_END, ws_size, (size_t)WS_END); grid = -1; return; }
        int dev = 0, cus = 0, per_cu = 0;
        if (hipGetDevice(&dev) != hipSuccess || hipDeviceGetAttribute(&cus, hipDeviceAttributeMultiprocessorCount, dev) != hipSuccess) { grid = -1; return; }
        if (hipFuncSetAttribute((const void*)mega_fwd, hipFuncAttributeMaxDynamicSharedMemorySize, LDS_BYTES) != hipSuccess) { fprintf(stderr, "kernel_launch: hipFuncSetAttribute failed\n"); grid = -1; return; }
        if (hipOccupancyMaxActiveBlocksPerMultiprocessor(&per_cu, (const void*)mega_fwd, NWAVES * 64, LDS_BYTES) != hipSuccess || per_cu < 1) fprintf(stderr, "kernel_launch: occupancy query says %d\n", per_cu);
        (void)hipGetLastError();
        grid = cus;
    }
    if (grid < 0) return;
    if (hipMemsetAsync((char*)d_ws + WS_CTL, 0, CTL_ZERO_BYTES, stream) != hipSuccess) return;
    Args a{};
    for (int i = 0; i < N_IN; ++i) a.in[i] = (const float*)d_in[i];
    a.out = (float*)d_out; a.ws = (unsigned char*)d_ws;
    hipLaunchKernelGGL(mega_fwd, dim3(grid), dim3(NWAVES * 64), LDS_BYTES, stream, a);
    const hipError_t le = hipPeekAtLastError();
    if (le != hipSuccess) fprintf(stderr, "kernel_launch: launch failed: %s\n", hipGetErrorName(le));
}
```

```cpp
#include <hip/hip_runtime.h>
#include <cstdio>
#include <cstdint>
namespace pg8 {
#define PG8_LAS __attribute__((address_space(3)))
typedef unsigned short bf16_t;
typedef short bf16x8 __attribute__((ext_vector_type(8)));
typedef float f32x4 __attribute__((ext_vector_type(4)));
typedef unsigned u32x4 __attribute__((ext_vector_type(4)));
constexpr int BM = 256, BK = 64, HALF = 128, HTB = HALF * BK * 2  , STAGE_BYTES = 8 * HTB, NXCD = 8, WGM = 8;

__host__ __device__ __forceinline__ int lds_byte(int r, int c) { const int st = (r >> 4) * 2 + (c >> 5), rr = r & 15, cc = c & 31, ob = rr * 64 + cc * 2; return st * 1024 + (ob ^ (((ob >> 9) & 1) << 5)); }
__host__ __device__ __forceinline__ void stage_rc(int b, int& R, int& C) { const int st = b / 1024, sb = b % 1024, swz = sb ^ (((sb >> 9) & 1) << 5); R = (st >> 1) * 16 + swz / 64; C = (st & 1) * 32 + (swz % 64) / 2; }
__host__ __device__ __forceinline__ int perm32(int rho) { const int n = rho >> 4, i = rho & 15; return 8 * (i >> 2) + 4 * n + (i & 3); }

struct Unit { int pm, pn; };
struct Gemm { const bf16_t* A; const bf16_t* Bt; int M, N, K; int ld = 0; int ldb = 0; };

struct StaticOrder {
    int nM, nN, nwg, G, c;
    __host__ __device__ void init(int M, int N, int G_, int c_) { nM = M / BM; nN = N / BM; nwg = nM * nN; G = G_; c = c_; }
    __host__ __device__ bool next(int i, Unit& u) const {
        const long L = (long)i * G + c; if (L >= nwg) return false;
        int wgid = (int)L; { const int q = nwg / NXCD, r = nwg % NXCD, xcd = wgid % NXCD, off = wgid / NXCD; wgid = (xcd < r ? xcd * (q + 1) : r * (q + 1) + (xcd - r) * q) + off; }
        const int nig = WGM * nN, gid = wgid / nig, fm = gid * WGM, gsz = (nM - fm) < WGM ? (nM - fm) : WGM;
        u.pm = fm + ((wgid % nig) % gsz); u.pn = (wgid % nig) / gsz; return true;
    }
    __device__ __forceinline__ void a_ready(const Unit&) const {}
    __device__ __forceinline__ void done(const Unit&) const {}
};

__device__ __forceinline__ unsigned cvt_pk_bf16(float lo, float hi) { unsigned r; asm volatile("v_cvt_pk_bf16_f32 %0, %1, %2" : "=v"(r) : "v"(lo), "v"(hi)); return r; }
typedef float f32x2 __attribute__((ext_vector_type(2)));
template <int RS> struct RowScale {
    const float* p; __attribute__((address_space(3))) float* cache;
    __device__ __forceinline__ void prepare(int pm) const {
        if constexpr (RS == 3) {
            volatile __attribute__((address_space(3))) int* tagp = (volatile __attribute__((address_space(3))) int*)(cache + 256);
            if (__builtin_amdgcn_readfirstlane(tagp[0]) != pm) { const int t = (int)threadIdx.x;
                const f32x4* q = (const f32x4*)(p + (size_t)(pm * BM + (t >> 1)) * 64 + (t & 1) * 32);
                f32x4 a[8];
#pragma unroll
                for (int i = 0; i < 8; ++i) a[i] = q[i];
                float s = 0.f;
#pragma unroll
                for (int i = 0; i < 8; ++i) s += (a[i][0] + a[i][1]) + (a[i][2] + a[i][3]);
                s += __shfl_xor(s, 1);
                if ((t & 1) == 0) cache[t >> 1] = 1.0f / sqrtf(s * (1.0f / 4096.0f) + 1e-6f);
                __syncthreads();
                if (t == 0) tagp[0] = pm;
            }
        }
    }
    __device__ __forceinline__ float get(int row, int fq) const {
        if constexpr (RS == 0) { return 1.f; }
        else if constexpr (RS == 1) { return p[row]; }
        else if constexpr (RS == 3) { return cache[row & (BM - 1)]; }
        else {
            const f32x4* q = (const f32x4*)(p + (size_t)row * 64 + fq * 16);
            const f32x4 a = q[0], b = q[1], c = q[2], d = q[3];
            float s = ((a[0] + a[1]) + (a[2] + a[3])) + ((b[0] + b[1]) + (b[2] + b[3])) + ((c[0] + c[1]) + (c[2] + c[3])) + ((d[0] + d[1]) + (d[2] + d[3]));
            s += __shfl_xor(s, 16); s += __shfl_xor(s, 32);
            return 1.0f / sqrtf(s * (1.0f / 4096.0f) + 1e-6f);
        }
    }
};
template <int RS> struct EpiB16 {
    static constexpr bool PERM = true, AFTER_DRAIN = false;
    bf16_t* O; int ldc; RowScale<RS> rs;
    __device__ __forceinline__ void operator()(const f32x4 (&acc)[2][2][4][2], const Unit& u, int wr, int wc, int fr, int fq) const {
        const int row0 = u.pm * BM + wr * 64 + fr, col0 = u.pn * BM + wc * 32 + 8 * fq;
        rs.prepare(u.pm);
        float sc[2][4];
#pragma unroll
        for (int ai = 0; ai < 2; ++ai)
#pragma unroll
            for (int m = 0; m < 4; ++m) sc[ai][m] = rs.get(row0 + ai * HALF + m * 16, fq);
#pragma unroll
        for (int ai = 0; ai < 2; ++ai)
#pragma unroll
            for (int m = 0; m < 4; ++m) { const int row = row0 + ai * HALF + m * 16; bf16_t* rowp = O + (size_t)row * ldc + col0;
#pragma unroll
                for (int bj = 0; bj < 2; ++bj) { const f32x4 v0 = acc[ai][bj][m][0] * sc[ai][m], v1 = acc[ai][bj][m][1] * sc[ai][m];
                    u32x4 w; w.x = cvt_pk_bf16(v0[0], v0[1]); w.y = cvt_pk_bf16(v0[2], v0[3]); w.z = cvt_pk_bf16(v1[0], v1[1]); w.w = cvt_pk_bf16(v1[2], v1[3]);
                    *(u32x4*)(rowp + bj * HALF) = w; } }
    }
};
__device__ __forceinline__ float silu_mul(float g, float u) { return g * u * __builtin_amdgcn_rcpf(1.0f + __builtin_amdgcn_exp2f(-1.44269504089f * g)); }
struct EpiSwiGLU {
    static constexpr bool PERM = true, AFTER_DRAIN = false;
    bf16_t* O; int ldc; RowScale<3> rs;
    __device__ __forceinline__ void operator()(const f32x4 (&acc)[2][2][4][2], const Unit& u, int wr, int wc, int fr, int fq) const {
        const int row0 = u.pm * BM + wr * 64 + fr, col0 = u.pn * HALF + wc * 32 + 8 * fq;
        rs.prepare(u.pm);
        float scv[2][4];
#pragma unroll
        for (int ai = 0; ai < 2; ++ai)
#pragma unroll
            for (int m = 0; m < 4; ++m) scv[ai][m] = rs.get(row0 + ai * HALF + m * 16, fq);
#pragma unroll
        for (int ai = 0; ai < 2; ++ai)
#pragma unroll
            for (int m = 0; m < 4; ++m) { const int row = row0 + ai * HALF + m * 16; const float sc = scv[ai][m];
                const f32x4 g0 = acc[ai][0][m][0] * sc, g1 = acc[ai][0][m][1] * sc, u0 = acc[ai][1][m][0] * sc, u1 = acc[ai][1][m][1] * sc;
                u32x4 w; w.x = cvt_pk_bf16(silu_mul(g0[0], u0[0]), silu_mul(g0[1], u0[1])); w.y = cvt_pk_bf16(silu_mul(g0[2], u0[2]), silu_mul(g0[3], u0[3]));
                w.z = cvt_pk_bf16(silu_mul(g1[0], u1[0]), silu_mul(g1[1], u1[1])); w.w = cvt_pk_bf16(silu_mul(g1[2], u1[2]), silu_mul(g1[3], u1[3]));
                *(u32x4*)(O + (size_t)row * ldc + col0) = w; }
    }
};
struct EpiF32 {
    static constexpr bool PERM = false, AFTER_DRAIN = false;
    float* C; int ldc; RowScale<1> rs;
    __device__ __forceinline__ void operator()(const f32x4 (&acc)[2][2][4][2], const Unit& u, int wr, int wc, int fr, int fq) const {
        const int row0 = u.pm * BM + wr * 64 + fr, col0 = u.pn * BM + wc * 32 + 4 * fq;
        float scv[2][4];
#pragma unroll
        for (int ai = 0; ai < 2; ++ai)
#pragma unroll
            for (int m = 0; m < 4; ++m) scv[ai][m] = rs.get(row0 + ai * HALF + m * 16, fq);
#pragma unroll
        for (int ai = 0; ai < 2; ++ai)
#pragma unroll
            for (int m = 0; m < 4; ++m) { const int row = row0 + ai * HALF + m * 16; const float sc = scv[ai][m]; float* rowp = C + (size_t)row * ldc + col0;
#pragma unroll
                for (int bj = 0; bj < 2; ++bj)
#pragma unroll
                    for (int n = 0; n < 2; ++n) *(f32x4*)(rowp + bj * HALF + n * 16) = acc[ai][bj][m][n] * sc; }
    }
};
__device__ __forceinline__ float decay_fn(float x) {
    const float sg = __builtin_amdgcn_rcpf(1.0f + __builtin_amdgcn_exp2f(-1.44269504089f * x));
    return __builtin_amdgcn_exp2f((-1.44269504089f * 0.60653065971f) * sg);
}
template <int MODE> struct EpiScanSlot {
    static constexpr bool PERM = false, AFTER_DRAIN = false;
    float* bufP; float* bufS; const float* bias; int slot; int mrows;
    __device__ __forceinline__ float fn(float x) const { if constexpr (MODE == 0) return decay_fn(x); else return __builtin_amdgcn_rcpf(1.0f + __builtin_amdgcn_exp2f(-1.44269504089f * x)); }
    __device__ __forceinline__ void operator()(const f32x4 (&acc)[2][2][4][2], const Unit& u, int wr, int wc, int fr, int fq) const {
        const int col0 = u.pn * BM + wc * 32 + 4 * fq;
        if (u.pm < 32) {
            const int t0 = (u.pm & 7) * 256 + wr * 64 + fr; float* b0 = bufP + (size_t)(u.pm >> 3) * 48 * 2048 * 384 + (size_t)slot * 64;
#pragma unroll
            for (int bj = 0; bj < 2; ++bj)
#pragma unroll
                for (int n = 0; n < 2; ++n) { const int c = col0 + bj * HALF + n * 16; const f32x4 bv = *(const f32x4*)(bias + c); float* bc = b0 + ((size_t)(c >> 6) * 2048 + t0) * 384 + (c & 63);
#pragma unroll
                    for (int ai = 0; ai < 2; ++ai)
#pragma unroll
                        for (int m = 0; m < 4; ++m) { const f32x4 x = acc[ai][bj][m][n] + bv; f32x4 o; o[0] = fn(x[0]); o[1] = fn(x[1]); o[2] = fn(x[2]); o[3] = fn(x[3]);
                            *(f32x4*)(bc + (size_t)(ai * HALF + m * 16) * 384) = o; }
                    asm volatile("" ::: "memory"); }
        } else if (wr == 0) {
#pragma unroll
            for (int bj = 0; bj < 2; ++bj)
#pragma unroll
                for (int n = 0; n < 2; ++n) { const int c = col0 + bj * HALF + n * 16; const f32x4 bv = *(const f32x4*)(bias + c);
#pragma unroll
                    for (int m = 0; m < 4; ++m) { const int lr = m * 16 + fr; const f32x4 x = acc[0][bj][m][n] + bv; f32x4 o; o[0] = fn(x[0]); o[1] = fn(x[1]); o[2] = fn(x[2]); o[3] = fn(x[3]);
                        *(f32x4*)(bufS + (((size_t)((lr >> 3) * 48 + (c >> 6)) * 8 + (lr & 7)) * 6 + slot) * 64 + (c & 63)) = o; }
                    asm volatile("" ::: "memory"); }
        }
    }
};
template <int MODE> struct EpiAct {
    static constexpr bool PERM = false, AFTER_DRAIN = false;
    float* C; int ldc; const float* bias;
    __device__ __forceinline__ float fn(float x) const { if constexpr (MODE == 0) return decay_fn(x); else return __builtin_amdgcn_rcpf(1.0f + __builtin_amdgcn_exp2f(-1.44269504089f * x)); }
    __device__ __forceinline__ void operator()(const f32x4 (&acc)[2][2][4][2], const Unit& u, int wr, int wc, int fr, int fq) const {
        const int row0 = u.pm * BM + wr * 64 + fr, col0 = u.pn * BM + wc * 32 + 4 * fq;
        f32x4 bvv[2][2];
#pragma unroll
        for (int bj = 0; bj < 2; ++bj)
#pragma unroll
            for (int n = 0; n < 2; ++n) bvv[bj][n] = *(const f32x4*)(bias + col0 + bj * HALF + n * 16);
#pragma unroll
        for (int bj = 0; bj < 2; ++bj)
#pragma unroll
            for (int n = 0; n < 2; ++n) { const int c = col0 + bj * HALF + n * 16; const f32x4 bv = bvv[bj][n]; float* bc = C + (size_t)row0 * ldc + c;
#pragma unroll
                for (int ai = 0; ai < 2; ++ai)
#pragma unroll
                    for (int m = 0; m < 4; ++m) { const f32x4 x = acc[ai][bj][m][n] + bv; f32x4 o; o[0] = fn(x[0]); o[1] = fn(x[1]); o[2] = fn(x[2]); o[3] = fn(x[3]);
                        *(f32x4*)(bc + (size_t)(ai * HALF + m * 16) * ldc) = o; }
                asm volatile("" ::: "memory"); }
    }
};
template <bool BASE16, bool WY, bool FEED> struct EpiRes {
    static constexpr bool PERM = true, AFTER_DRAIN = false;
    const float* baseP; const float* baseS; float* Y; bf16_t* XA; float* SS; int ldc; int mrows;
    __device__ __forceinline__ void operator()(const f32x4 (&acc)[2][2][4][2], const Unit& u, int wr, int wc, int fr, int fq) const {
        const int row0 = u.pm * BM + wr * 64 + fr, col0 = u.pn * BM + wc * 32 + 8 * fq;
#pragma unroll
        for (int ai = 0; ai < 2; ++ai) {
            u32x4 b16[4][2]; f32x4 b32[4][2][2];
#pragma unroll
            for (int m = 0; m < 4; ++m)
#pragma unroll
                for (int bj = 0; bj < 2; ++bj) { const size_t off = (size_t)(row0 + ai * HALF + m * 16) * ldc + col0 + bj * HALF;
                    if constexpr (BASE16) b16[m][bj] = *(const u32x4*)(XA + off);
                    else { b32[m][bj][0] = *(const f32x4*)(baseP + off); b32[m][bj][1] = *(const f32x4*)(baseP + off + 4); } }
#pragma unroll
            for (int m = 0; m < 4; ++m) { const int row = row0 + ai * HALF + m * 16; float q = 0.f;
#pragma unroll
                for (int bj = 0; bj < 2; ++bj) { const size_t off = (size_t)row * ldc + col0 + bj * HALF; f32x4 s0, s1;
                    if constexpr (BASE16) { const u32x4 w = b16[m][bj];
                        s0 = (f32x4){__builtin_bit_cast(float, w.x << 16), __builtin_bit_cast(float, w.x & 0xffff0000u), __builtin_bit_cast(float, w.y << 16), __builtin_bit_cast(float, w.y & 0xffff0000u)};
                        s1 = (f32x4){__builtin_bit_cast(float, w.z << 16), __builtin_bit_cast(float, w.z & 0xffff0000u), __builtin_bit_cast(float, w.w << 16), __builtin_bit_cast(float, w.w & 0xffff0000u)}; }
                    else { s0 = b32[m][bj][0]; s1 = b32[m][bj][1]; }
                    const f32x4 y0 = s0 + acc[ai][bj][m][0], y1 = s1 + acc[ai][bj][m][1];
                    q += ((y0[0] * y0[0] + y0[1] * y0[1]) + (y0[2] * y0[2] + y0[3] * y0[3])) + ((y1[0] * y1[0] + y1[1] * y1[1]) + (y1[2] * y1[2] + y1[3] * y1[3]));
                    if constexpr (WY) { *(f32x4*)(Y + off) = y0; *(f32x4*)(Y + off + 4) = y1; }
                    if constexpr (FEED) { u32x4 w; w.x = cvt_pk_bf16(y0[0], y0[1]); w.y = cvt_pk_bf16(y0[2], y0[3]); w.z = cvt_pk_bf16(y1[0], y1[1]); w.w = cvt_pk_bf16(y1[2], y1[3]); *(u32x4*)(XA + off) = w; } }
                if constexpr (FEED) { q += __shfl_xor(q, 16); q += __shfl_xor(q, 32);
                    if (fq == 0) SS[(size_t)row * 64 + u.pn * 4 + wc] = q; } }
        }
    }
};
template <class Epi, class Sched, bool ALIGN_EPI = false, bool SP2 = false>
__device__ __forceinline__ void gemm_phase(PG8_LAS unsigned char* lds, const Gemm g, const Sched& S, const Epi& E) {
    int tid = threadIdx.x; asm volatile("" : "+v"(tid));
    const int wid = __builtin_amdgcn_readfirstlane(tid >> 6), lane = tid & 63, wr = wid >> 2, wc = wid & 3, fr = lane & 15, fq = lane >> 4;
    int K = g.K; asm volatile("" : "+s"(K));
    const int nt = K / BK;
    int LD = g.ld ? g.ld : g.K; asm volatile("" : "+s"(LD)); int LDB = g.ldb ? g.ldb : LD; asm volatile("" : "+s"(LDB));
    unsigned voffA[2], voffB[2];
#pragma unroll
    for (int i = 0; i < 2; ++i) { int R, C; stage_rc(tid * 16 + i * 8192, R, C); const int Rb = Epi::PERM ? ((R & ~31) + perm32(R & 31)) : R;
        voffA[i] = (unsigned)(R * LD + C) * 2u; voffB[i] = (unsigned)(Rb * LDB + C) * 2u; }
    const size_t kstep = (size_t)(BK * 2);
    const size_t hstep = (size_t)HALF * LD * 2;
    const size_t tstep = 2 * hstep;
    const size_t hstepB = (size_t)HALF * LDB * 2, tstepB = 2 * hstepB;
    const unsigned ldsw = (unsigned)wid * 1024u;
    const int aoff = lds_byte(wr * 64 + fr, fq * 8), boff = lds_byte(wc * 32 + fr, fq * 8);
#define PG8_SA(b, h) (((b) * 2 + (h)) * HTB)
#define PG8_SB(b, h) ((4 + (b) * 2 + (h)) * HTB)
#define PG8_STAGE(bufoff, gbase, voff) do { _Pragma("unroll") for (int _i = 0; _i < 2; ++_i) \
        __builtin_amdgcn_global_load_lds((const unsigned*)((const char*)(gbase) + (voff)[_i]), (PG8_LAS unsigned*)(lds + (bufoff) + ldsw + _i * 8192), 16, 0, 0); } while (0)
#define PG8_LDA(dst, b, h) do { _Pragma("unroll") for (int m = 0; m < 4; ++m) _Pragma("unroll") for (int k = 0; k < 2; ++k) dst[m][k] = *(const PG8_LAS bf16x8*)(lds + PG8_SA(b, h) + aoff + m * 2048 + k * 1024); } while (0)
#define PG8_LDB(dst, b, h) do { _Pragma("unroll") for (int n = 0; n < 2; ++n) _Pragma("unroll") for (int k = 0; k < 2; ++k) dst[n][k] = *(const PG8_LAS bf16x8*)(lds + PG8_SB(b, h) + boff + n * 2048 + k * 1024); } while (0)
#define PG8_MMA(ai, bj, At, Bt) do { __builtin_amdgcn_s_setprio(1); _Pragma("unroll") for (int m = 0; m < 4; ++m) _Pragma("unroll") for (int n = 0; n < 2; ++n) _Pragma("unroll") for (int k = 0; k < 2; ++k) \
        acc[ai][bj][m][n] = __builtin_amdgcn_mfma_f32_16x16x32_bf16(Bt[n][k], At[m][k], acc[ai][bj][m][n], 0, 0, 0); __builtin_amdgcn_s_setprio(0); } while (0)
#define PG8_WAIT_V(n) asm volatile("s_waitcnt vmcnt(" #n ")" ::: "memory")
#define PG8_WAIT_L(n) asm volatile("s_waitcnt lgkmcnt(" #n ")" ::: "memory")
#define PG8_BAR __builtin_amdgcn_s_barrier()
#define PG8_SCHED __builtin_amdgcn_sched_barrier(0)
    Unit cur, nxt; int ui = 0;
    if (!S.next(0, cur)) return;
    f32x4 acc[2][2][4][2];
#pragma unroll
    for (int a = 0; a < 2; ++a)
#pragma unroll
        for (int b = 0; b < 2; ++b)
#pragma unroll
            for (int m = 0; m < 4; ++m)
#pragma unroll
                for (int n = 0; n < 2; ++n) acc[a][b][m][n] = (f32x4){0.f, 0.f, 0.f, 0.f};
    bf16x8 At[4][2], B0[2][2], B1[2][2];
    const char* cA = (const char*)g.A + (size_t)cur.pm * tstep; const char* cB = (const char*)g.Bt + (size_t)cur.pn * tstepB;
    S.a_ready(cur);
    if constexpr (SP2) {
        PG8_STAGE(PG8_SB(0, 0), cB, voffB); PG8_STAGE(PG8_SB(0, 1), cB + hstepB, voffB); PG8_STAGE(PG8_SA(0, 0), cA, voffA); PG8_STAGE(PG8_SA(0, 1), cA + hstep, voffA);
        if (wr == 1) PG8_BAR;
        PG8_WAIT_V(2); PG8_BAR;
        PG8_STAGE(PG8_SB(1, 0), cB + kstep, voffB); PG8_STAGE(PG8_SA(1, 0), cA + kstep, voffA); PG8_STAGE(PG8_SB(1, 1), cB + hstepB + kstep, voffB);
        PG8_WAIT_V(6); PG8_BAR;
    } else {
        PG8_STAGE(PG8_SB(0, 0), cB, voffB); PG8_STAGE(PG8_SA(0, 0), cA, voffA); PG8_STAGE(PG8_SB(0, 1), cB + hstepB, voffB); PG8_STAGE(PG8_SA(0, 1), cA + hstep, voffA);
        if (wr == 1) PG8_BAR;
        PG8_WAIT_V(4); PG8_BAR;
        PG8_STAGE(PG8_SB(1, 0), cB + kstep, voffB); PG8_STAGE(PG8_SA(1, 0), cA + kstep, voffA); PG8_STAGE(PG8_SB(1, 1), cB + hstepB + kstep, voffB);
        PG8_WAIT_V(6); PG8_BAR;
    }
    for (;;) {
        const bool has_next = S.next(ui + 1, nxt);
        const char* nA = has_next ? (const char*)g.A + (size_t)nxt.pm * tstep : cA; const char* nB = has_next ? (const char*)g.Bt + (size_t)nxt.pn * tstepB : cB;
        for (int t = 0; t < nt; t += 2) {
            const bool last = (t == nt - 2);
            const char* a1 = cA + (size_t)(t + 1) * kstep;
            const char* a2 = last ? nA : cA + (size_t)(t + 2) * kstep; const char* b2 = last ? nB : cB + (size_t)(t + 2) * kstep;
            const char* a3 = a2 + kstep; const char* b3 = b2 + kstep;
            if (last && has_next) S.a_ready(nxt);
            if constexpr (SP2) {
            PG8_LDB(B0, 0, 0); PG8_LDB(B1, 0, 1); PG8_SCHED; PG8_LDA(At, 0, 0); PG8_STAGE(PG8_SA(1, 1), a1 + hstep, voffA);
            PG8_WAIT_V(8); PG8_WAIT_L(0); PG8_BAR; PG8_MMA(0, 0, At, B0); PG8_MMA(0, 1, At, B1); PG8_BAR; PG8_SCHED;
            PG8_LDA(At, 0, 1); PG8_STAGE(PG8_SB(0, 0), b2, voffB); PG8_STAGE(PG8_SB(0, 1), b2 + hstepB, voffB); PG8_STAGE(PG8_SA(0, 0), a2, voffA);
            PG8_WAIT_V(8); PG8_WAIT_L(0); PG8_BAR; PG8_MMA(1, 0, At, B0); PG8_MMA(1, 1, At, B1); PG8_BAR; PG8_SCHED;
            PG8_LDB(B0, 1, 0); PG8_LDB(B1, 1, 1); PG8_SCHED; PG8_LDA(At, 1, 0); PG8_STAGE(PG8_SA(0, 1), a2 + hstep, voffA);
            PG8_WAIT_V(8); PG8_WAIT_L(0); PG8_BAR; PG8_MMA(0, 0, At, B0); PG8_MMA(0, 1, At, B1); PG8_BAR; PG8_SCHED;
            PG8_LDA(At, 1, 1); PG8_STAGE(PG8_SB(1, 0), b3, voffB); PG8_STAGE(PG8_SB(1, 1), b3 + hstepB, voffB); PG8_STAGE(PG8_SA(1, 0), a3, voffA);
            PG8_WAIT_V(8); PG8_WAIT_L(0); PG8_BAR; PG8_MMA(1, 0, At, B0); PG8_MMA(1, 1, At, B1); PG8_BAR; PG8_SCHED;
            } else {
            PG8_LDB(B0, 0, 0); PG8_SCHED; PG8_LDA(At, 0, 0); PG8_STAGE(PG8_SA(1, 1), a1 + hstep, voffA);
            PG8_WAIT_L(8); PG8_BAR; PG8_WAIT_L(0); PG8_MMA(0, 0, At, B0); PG8_BAR; PG8_SCHED;
            PG8_LDB(B1, 0, 1); PG8_STAGE(PG8_SB(0, 0), b2, voffB);
            PG8_BAR; PG8_WAIT_L(0); PG8_MMA(0, 1, At, B1); PG8_BAR;
            PG8_LDA(At, 0, 1); PG8_STAGE(PG8_SA(0, 0), a2, voffA);
            PG8_BAR; PG8_WAIT_L(0); PG8_MMA(1, 0, At, B0); PG8_BAR; PG8_SCHED;
            PG8_STAGE(PG8_SB(0, 1), b2 + hstepB, voffB);
            PG8_WAIT_V(6); PG8_BAR; PG8_MMA(1, 1, At, B1); PG8_BAR;
            PG8_LDB(B0, 1, 0); PG8_SCHED; PG8_LDA(At, 1, 0); PG8_STAGE(PG8_SA(0, 1), a2 + hstep, voffA);
            PG8_WAIT_L(8); PG8_BAR; PG8_WAIT_L(0); PG8_MMA(0, 0, At, B0); PG8_BAR; PG8_SCHED;
            PG8_LDB(B1, 1, 1); PG8_STAGE(PG8_SB(1, 0), b3, voffB);
            PG8_BAR; PG8_WAIT_L(0); PG8_MMA(0, 1, At, B1); PG8_BAR;
            PG8_LDA(At, 1, 1); PG8_STAGE(PG8_SA(1, 0), a3, voffA);
            PG8_BAR; PG8_WAIT_L(0); PG8_MMA(1, 0, At, B0); PG8_BAR; PG8_SCHED;
            PG8_STAGE(PG8_SB(1, 1), b3 + hstepB, voffB);
            PG8_WAIT_V(6); PG8_BAR; PG8_MMA(1, 1, At, B1); PG8_BAR;
            }
        }
        if constexpr (ALIGN_EPI) { if (wr == 0) PG8_BAR; }
        if constexpr (!Epi::AFTER_DRAIN) { E(acc, cur, wr, wc, fr, fq); S.done(cur); }
        if (!has_next) break;
#pragma unroll
        for (int a = 0; a < 2; ++a)
#pragma unroll
            for (int b = 0; b < 2; ++b)
#pragma unroll
                for (int m = 0; m < 4; ++m)
#pragma unroll
                    for (int n = 0; n < 2; ++n) acc[a][b][m][n] = (f32x4){0.f, 0.f, 0.f, 0.f};
        cur = nxt; cA = nA; cB = nB; ++ui;
        if constexpr (ALIGN_EPI) { if (wr == 1) PG8_BAR; }
    }
    PG8_WAIT_V(0);
    if constexpr (!ALIGN_EPI) { if (wr == 0) PG8_BAR; }
    PG8_BAR;
    if constexpr (Epi::AFTER_DRAIN) { E.fused(acc, cur, wr, wc, fr, fq, lds, wid, lane); S.done(cur); }
#undef PG8_SA
#undef PG8_SB
#undef PG8_STAGE
#undef PG8_LDA
#undef PG8_LDB
#undef PG8_MMA
#undef PG8_WAIT_V
#undef PG8_WAIT_L
#undef PG8_BAR
#undef PG8_SCHED
}
}
#define GAS __attribute__((address_space(1)))
#define LAS __attribute__((address_space(3)))
typedef unsigned short bf16;
typedef unsigned v4u __attribute__((ext_vector_type(4)));
typedef float f32x4 __attribute__((ext_vector_type(4)));
typedef short bf16x8 __attribute__((ext_vector_type(8)));
typedef GAS unsigned gu32;
typedef GAS unsigned long long gu64;
#define RLX_AGENT __ATOMIC_RELAXED, __HIP_MEMORY_SCOPE_AGENT
#define LDS_WAIT() asm volatile("s_waitcnt lgkmcnt(0)" ::: "memory")
#define VM_WAIT() asm volatile("s_waitcnt vmcnt(0)" ::: "memory")
__device__ __forceinline__ unsigned long long rt() { return __builtin_amdgcn_s_memrealtime(); }
typedef float f32x2_cv __attribute__((ext_vector_type(2)));
typedef __bf16 bf16x2_cv __attribute__((ext_vector_type(2)));
__device__ __forceinline__ unsigned pk2(float lo, float hi) { const f32x2_cv v = {lo, hi}; return __builtin_bit_cast(unsigned, __builtin_convertvector(v, bf16x2_cv)); }
__device__ __forceinline__ unsigned f2bf(float f) { return pk2(f, 0.f) & 0xffffu; }

#define XB_TMO      128
#define XB_XCNT(j)  (256  + 64 * (j))
#define XB_XSUB(j)  (1280 + 64 * (j))
#define XB_XGEN(j)  (2304 + 64 * (j))
#define XB_TOP      3328
#define XB_TOPGEN   3392
#define XCD_BAR_WORDS 3456
#define XB_SPIN_CAP (1u << 18)

__device__ __forceinline__ unsigned xb_ld(unsigned* p)              { return __hip_atomic_load(p, __ATOMIC_RELAXED, __HIP_MEMORY_SCOPE_AGENT); }
__device__ __forceinline__ unsigned xb_add(unsigned* p, unsigned v) { return __hip_atomic_fetch_add(p, v, __ATOMIC_RELAXED, __HIP_MEMORY_SCOPE_AGENT); }
__device__ __forceinline__ unsigned xb_xcc_id() { return (unsigned)__builtin_amdgcn_s_getreg((3 << 11) | 20) & 0xFu; }
#define XB_SPIN(cond, bar) do { unsigned _sp = 0; while (cond) { __builtin_amdgcn_s_sleep(1); \
    if ((++_sp & 255u) == 0u) { if (xb_ld(&(bar)[XB_TMO])) break; if (_sp > XB_SPIN_CAP) { atomicAdd(&(bar)[XB_TMO], 1u); break; } } } } while (0)

struct XcdBarrier {
    unsigned* bar; unsigned x;
    volatile LAS unsigned* st;
};

__device__ __forceinline__ XcdBarrier xcd_barrier_post(unsigned* bar, volatile LAS unsigned* st) {
    XcdBarrier b; b.bar = bar; b.x = xb_xcc_id(); b.st = st;
    if (threadIdx.x == 0) (void)xb_add(&bar[XB_XCNT(b.x)], 1u);
    return b;
}
__device__ __forceinline__ void xcd_barrier_complete(unsigned* bar, unsigned x, unsigned& nloc, unsigned& nx) {
    const unsigned G = gridDim.x * gridDim.y * gridDim.z;
    unsigned sum, cnt, mine, sp = 0u;
    for (;;) {
        sum = 0u; cnt = 0u; mine = 0u;
#pragma unroll
        for (unsigned j = 0; j < 16; ++j) { const unsigned c = xb_ld(&bar[XB_XCNT(j)]); sum += c; cnt += (c > 0u) ? 1u : 0u; mine = (j == x) ? c : mine; }
        if (sum == G) break;
        __builtin_amdgcn_s_sleep(1);
        if ((++sp & 255u) == 0u) { if (xb_ld(&bar[XB_TMO])) break; if (sp > XB_SPIN_CAP) { atomicAdd(&bar[XB_TMO], 1u); break; } }
    }
    nloc = mine > 0u ? mine : 1u; nx = cnt > 0u ? cnt : 1u;
}

__device__ __forceinline__ void xcd_barrier(const XcdBarrier& b) {
    asm volatile("s_waitcnt vmcnt(0)" ::: "memory");
    __syncthreads();
    if (threadIdx.x == 0) {
        unsigned* bar = b.bar;
        __builtin_amdgcn_s_waitcnt(0);
        unsigned nloc = b.st[0], nx = b.st[1];
        if (nloc == 0u) { xcd_barrier_complete(bar, b.x, nloc, nx); b.st[0] = nloc; b.st[1] = nx; }
        const unsigned old = xb_add(&bar[XB_XSUB(b.x)], 1u);
        const unsigned gen = old / nloc;
        if (old + 1u == (gen + 1u) * nloc) {
            __builtin_amdgcn_fence(__ATOMIC_RELEASE, "agent");
            asm volatile("s_waitcnt vmcnt(0)" ::: "memory");
            const unsigned og = xb_add(&bar[XB_TOP], 1u);
            const unsigned tg = og / nx;
            if (og + 1u == (tg + 1u) * nx) xb_add(&bar[XB_TOPGEN], 1u);
            else XB_SPIN(xb_ld(&bar[XB_TOPGEN]) == tg, bar);
            __builtin_amdgcn_fence(__ATOMIC_ACQUIRE, "agent");
            xb_add(&bar[XB_XGEN(b.x)], 1u);
            asm volatile("s_waitcnt vmcnt(0)" ::: "memory");
        } else {
            XB_SPIN(xb_ld(&bar[XB_XGEN(b.x)]) == gen, bar);
            __builtin_amdgcn_fence(__ATOMIC_ACQUIRE, "agent");
            asm volatile("s_waitcnt vmcnt(0)" ::: "memory");
        }
    }
    __syncthreads();
}
constexpr int NWAVES = 8;
constexpr int D = 4096, MP = 8192, MS = 64, M = MP + MS, MPAD = 8448;
constexpr int SEQ = 2048, DSEQ = 8, NBP = 4, NBS = 8;
constexpr int MIXW = 3072, ASW = 9792, AINW = 10816, NA = 11008;
constexpr int NB = 10240, DFF = 11008, NFI = 22016;
constexpr int NMEM = 256, MEMW = 1024, AH = 48;
constexpr float RMS_EPS = 1e-6f, LNX_EPS = 64e-5f;
constexpr float LOG2E = 1.44269504089f, LN2 = 0.69314718056f;

constexpr size_t MiB = 1u << 20;
constexpr size_t WS_CTL = 0, CTL_ZERO_BYTES = 1 * MiB;
constexpr size_t WS_WMEM = 1 * MiB;
constexpr size_t WS_WINA = WS_WMEM + 32 * MiB;
constexpr size_t WS_WOUTA = WS_WINA + 86 * MiB;
constexpr size_t WS_WINB = WS_WOUTA + 32 * MiB;
constexpr size_t WS_WOUTB = WS_WINB + 80 * MiB;
constexpr size_t WS_WFI = WS_WOUTB + 16 * MiB;
constexpr size_t WS_WFO = WS_WFI + 344 * MiB;
constexpr size_t WS_W2 = WS_WFO + 172 * MiB;
constexpr size_t WS_A2 = WS_W2 + 2 * MiB;
constexpr size_t WS_G2 = WS_A2 + 2 * MiB;
constexpr size_t WS_XA = WS_G2 + 3 * MiB;
constexpr size_t WS_XM = WS_XA + 66 * MiB;
constexpr size_t WS_RSTDM = WS_XM + 8 * MiB;
constexpr size_t WS_SS = WS_RSTDM + 1 * MiB;
constexpr size_t SS_STRIDE = 3 * MiB;
constexpr size_t WS_U = WS_SS + 15 * MiB;
constexpr size_t WS_HID = WS_U + 178 * MiB;
constexpr size_t WS_O = WS_HID + 178 * MiB;
constexpr size_t WS_XLW = WS_O + 66 * MiB;
constexpr size_t WS_XLA = WS_XLW + 5 * MiB;
constexpr size_t WS_XLG = WS_XLA + 5 * MiB;
constexpr size_t WS_G = WS_XLG + 7 * MiB;
constexpr size_t WS_SCANP = WS_G + 50 * MiB;
constexpr size_t WS_SCANS = WS_SCANP + 576 * MiB;
constexpr size_t WS_MEMRAW = WS_SCANS + 5 * MiB;
constexpr size_t WS_KP = WS_MEMRAW + 16 * MiB;
constexpr size_t WS_VTP = WS_KP + 4 * MiB;
constexpr size_t WS_KS = WS_VTP + 4 * MiB;
constexpr size_t WS_VTS = WS_KS + 8 * MiB;
constexpr size_t WS_QN = WS_VTS + 8 * MiB;
constexpr size_t WS_KN = WS_QN + 48 * MiB;
constexpr size_t WS_VT = WS_KN + 48 * MiB;
constexpr size_t WS_OG = WS_VT + 48 * MiB;
constexpr size_t WS_LSE = WS_OG + 48 * MiB;
constexpr size_t WS_QS = WS_LSE + 1 * MiB;
constexpr size_t WS_YRAW = WS_QS + 1 * MiB;
constexpr size_t WS_OGS = WS_YRAW + 97 * MiB;
constexpr size_t WS_SPLITK = WS_OGS + 1 * MiB;
constexpr size_t WS_WARR = WS_SCANP;
constexpr size_t WS_AARR = WS_SCANP + 128 * MiB;
constexpr size_t WS_ZRAW = WS_SPLITK + 4 * MiB;
constexpr size_t WS_END = WS_ZRAW + 97 * MiB;
#ifndef DFFP_V
#define DFFP_V 12288
#endif
constexpr int DFFP = DFFP_V;
#ifndef KFIP_V
#define KFIP_V 4096
#endif
constexpr int KFIP = KFIP_V;
constexpr size_t WS_WFOP = WS_SCANP + 256 * MiB;
constexpr int CW_BAR = 4096;

constexpr size_t OUT_Y = 0;
constexpr size_t OUT_WKVP = (size_t)M * D;
constexpr size_t OUT_SHIFTP = OUT_WKVP + 4 * 48 * 4096;
constexpr size_t OUT_SWAP1 = OUT_SHIFTP + 4 * ASW;
constexpr size_t OUT_SWAP2 = OUT_SWAP1 + (size_t)4 * 128 * 2048;
constexpr size_t OUT_SWAP3 = OUT_SWAP2 + (size_t)4 * 512 * 2048;
constexpr size_t OUT_MEMKV = OUT_SWAP3 + (size_t)4 * 2048 * 2048;
constexpr size_t OUT_WKVS = OUT_MEMKV + (size_t)2 * 1024 * 2048;
constexpr size_t OUT_SHIFTS = OUT_WKVS + 8 * 48 * 4096;
constexpr size_t OUT_SWAS1 = OUT_SHIFTS + 8 * ASW;
constexpr size_t OUT_SWAS2 = OUT_SWAS1 + (size_t)8 * 128 * 2048;
constexpr size_t OUT_SWAS3 = OUT_SWAS2 + (size_t)8 * 512 * 2048;
constexpr size_t OUT_END = OUT_SWAS3 + (size_t)8 * 2048 * 2048;

constexpr int RING_OFF = 0, RING_BYTES = 131072;
constexpr int LDSCTL_OFF = RING_BYTES, MISC_OFF = LDSCTL_OFF + 320;
constexpr int LDS_BYTES = 147456;

enum { I_XP = 0, I_XS, I_SWKV, I_SSHIFT, I_C1, I_C2, I_C3, I_CMEM, I_MEM, I_NMIX, I_NFFN, I_NMEM, I_WMEM, I_QNM, I_KNM,
       I_WINA, I_WOUTA, I_MU, I_W0, I_W2, I_A0, I_A2, I_G2, I_KK, I_KA, I_RK, I_LNG, I_LNB, I_WINB, I_WOUTB, I_QNB, I_KNB, I_WFI, I_WFO, N_IN };

struct Args { const float* in[N_IN]; float* out; unsigned char* ws; };
struct Frame {
    LAS unsigned char* lds;
    volatile LAS unsigned* MISC;
    gu32* ctl;
    int tid, lane, wave;
    int vcu, G;
    int gw, NGW;
    const struct Args* a;
    float* out; unsigned char* ws;
};
#define WSP(T, off) ((T*)(F.ws + (off)))
__device__ __forceinline__ int opaque_v(int x) { asm volatile("" : "+v"(x)); return x; }
__device__ __forceinline__ int opaque_s(int x) { asm volatile("" : "+s"(x)); return x; }
#define PHASE_LOCAL(F) do { F.lane = opaque_v(F.lane); F.gw = opaque_s(F.gw); } while (0)

__device__ __forceinline__ float wave_sum(float v) {
#pragma unroll
    for (int o = 1; o < 64; o <<= 1) v += __shfl_xor(v, o);
    return v;
}
__device__ __forceinline__ float wave_max(float v) {
#pragma unroll
    for (int o = 1; o < 64; o <<= 1) v = fmaxf(v, __shfl_xor(v, o));
    return v;
}
typedef float f32x2 __attribute__((ext_vector_type(2)));
__device__ __forceinline__ float bf2f(unsigned short b) { return __builtin_bit_cast(float, (unsigned)b << 16); }

__device__ __forceinline__ void tr_load(float (&v)[32], const float* W, int Ksrc, int ldw, int k0, int n0, int lane) {
    const float* wp = W + (size_t)(k0 + (lane >> 5)) * ldw + n0 + (lane & 31);
    if (k0 + 64 <= Ksrc) {
#pragma unroll
        for (int i = 0; i < 32; ++i) v[i] = wp[(size_t)(2 * i) * ldw];
    } else {
#pragma unroll
        for (int i = 0; i < 32; ++i) v[i] = (k0 + 2 * i + (lane >> 5)) < Ksrc ? wp[(size_t)(2 * i) * ldw] : 0.f;
    }
}
__device__ __forceinline__ void tr_store(float (&v)[32], int Ksrc, bf16* WT, int Kdst, int drow, const float* gain, LAS float* scr, int k0, int lane) {
    if (gain) {
#pragma unroll
        for (int i = 0; i < 32; ++i) { const int k = k0 + 2 * i + (lane >> 5); v[i] *= (k < Ksrc ? gain[k] : 0.f); }
    }
#pragma unroll
    for (int i = 0; i < 32; ++i) scr[(2 * i + (lane >> 5)) * 33 + (lane & 31)] = v[i];
    LDS_WAIT(); asm volatile("" ::: "memory");
    const int c = lane & 7;
#pragma unroll
    for (int j = 0; j < 4; ++j) { const int n = (lane >> 3) + 8 * j; const LAS float* s = scr + (8 * c) * 33 + n;
        v4u o; o.x = pk2(s[0 * 33], s[1 * 33]); o.y = pk2(s[2 * 33], s[3 * 33]); o.z = pk2(s[4 * 33], s[5 * 33]); o.w = pk2(s[6 * 33], s[7 * 33]);
        *(GAS v4u*)(WT + (size_t)(drow + n) * Kdst + k0 + 8 * c) = o; }
    LDS_WAIT(); asm volatile("" ::: "memory");
}
struct TrBuf { f32x4 v[8]; f32x4 g0, g1; };
__device__ __forceinline__ void tr4_load(TrBuf& b, const float* W, int ldw, const float* gain, int k0, int n0, int lane) {
    const float* gp = gain ? gain + k0 + 8 * (lane & 7) : W;
    b.g0 = *(const GAS f32x4*)gp; b.g1 = *(const GAS f32x4*)(gp + 4);
    const float* wp = W + (size_t)(k0 + (lane >> 3)) * ldw + n0 + 4 * (lane & 7);
#pragma unroll
    for (int i = 0; i < 8; ++i) b.v[i] = *(const GAS f32x4*)(wp + (size_t)(8 * i) * ldw);
}
__device__ __forceinline__ void tr4_store(TrBuf& b, bool hasgain, bf16* WT, int Kdst, int drow, LAS float* scr, int k0, int lane) {
    { const int kr = lane >> 3, n4 = lane & 7, L = (kr >> 2) ^ n4; LAS float* wb = scr + n4 * 256 + (kr & 3);
#pragma unroll
      for (int i = 0; i < 8; ++i) { const int Ci = ((2 * i) & 7) ^ (i >> 2); LAS float* w = wb + 4 * (((2 * i) & 8) | (Ci ^ L));
        w[0] = b.v[i].x; w[64] = b.v[i].y; w[128] = b.v[i].z; w[192] = b.v[i].w; } }
    LDS_WAIT(); asm volatile("" ::: "memory");
    const int c = lane & 7, nn = lane >> 3;
    const f32x4 g0 = hasgain ? b.g0 : (f32x4){1.f, 1.f, 1.f, 1.f}, g1 = hasgain ? b.g1 : (f32x4){1.f, 1.f, 1.f, 1.f};
#pragma unroll
    for (int j = 0; j < 4; ++j) { const int n = nn + 8 * j, q = (nn >> 2) ^ (2 * j) ^ (c >> 2);
        const f32x4 x0 = *(const LAS f32x4*)(scr + n * 64 + 4 * (((2 * c) & 8) | ((((2 * c) & 7) ^ q) & 7))) * g0;
        const f32x4 x1 = *(const LAS f32x4*)(scr + n * 64 + 4 * (((2 * c) & 8) | ((((2 * c + 1) & 7) ^ q) & 7))) * g1;
        v4u o; o.x = pk2(x0.x, x0.y); o.y = pk2(x0.z, x0.w); o.z = pk2(x1.x, x1.y); o.w = pk2(x1.z, x1.w);
        *(GAS v4u*)(WT + (size_t)(drow + n) * Kdst + k0 + 8 * c) = o; }
    LDS_WAIT(); asm volatile("" ::: "memory");
}
__device__ __forceinline__ void tr_item(const float* W, int Ksrc, int ldw, bf16* WT, int Kdst, int drow, const float* gain, LAS float* scr, int k0, int n0, int lane) {
    float v[32]; tr_load(v, W, Ksrc, ldw, k0, n0, lane); tr_store(v, Ksrc, WT, Kdst, drow, gain, scr, k0, lane);
}
template <int MAP> __device__ __forceinline__ void tr_matrix_w(int me, int NW, int lane, LAS float* scr, const float* W, int Ksrc, int N, bf16* WT, int Kdst, const float* gain, int& rot) {
    const int nblk = N / 32, items = (Kdst / 64) * nblk;
    int it = me - rot; if (it < 0) it += NW;
    float v[32];
    if (it < items) tr_load(v, W, Ksrc, N, 64 * (it / nblk), 32 * (it % nblk), lane);
    while (it < items) {
        const int kb = it / nblk, nb = it % nblk, n0 = 32 * nb; int drow = n0;
        if (MAP == 1) { const int up = n0 >= DFF, j = n0 - up * DFF; drow = 256 * (j >> 7) + 128 * up + (j & 127); }
        const int nx = it + NW; float vn[32];
        if (nx < items) tr_load(vn, W, Ksrc, N, 64 * (nx / nblk), 32 * (nx % nblk), lane);
        tr_store(v, Ksrc, WT, Kdst, drow, gain, scr, 64 * kb, lane);
        if (nx < items) {
#pragma unroll
            for (int i = 0; i < 32; ++i) v[i] = vn[i];
        }
        it = nx;
    }
    rot = (rot + items) % NW;
}
template <int MAP> __device__ __forceinline__ void tr4_matrix_w(int me, int NW, int lane, LAS float* scr, const float* W, int N, bf16* WT, int Kdst, const float* gain, int& rot) {
    const int nblk = N / 32, items = (Kdst / 64) * nblk;
    int it = me - rot; if (it < 0) it += NW;
    if (it < items) { const int lastit = it + ((items - 1 - it) / NW) * NW; TrBuf b0, b1, b2;
#define T4_LOAD(b, x) do { const int x_ = min((x), lastit); tr4_load(b, W, N, gain, 64 * (x_ / nblk), 32 * (x_ % nblk), lane); } while (0)
#define T4_STORE(b, x) do { const int x_ = min((x), lastit), kb_ = x_ / nblk, n0_ = 32 * (x_ % nblk); int drow_ = n0_; \
            if (MAP == 1) { const int up_ = n0_ >= DFF, j_ = n0_ - up_ * DFF; drow_ = 256 * (j_ >> 7) + 128 * up_ + (j_ & 127); } \
            tr4_store(b, gain != nullptr, WT, Kdst, drow_, scr, 64 * kb_, lane); } while (0)
        T4_LOAD(b0, it); T4_LOAD(b1, it + NW);
        for (; it < items; it += 3 * NW) { T4_LOAD(b2, it + 2 * NW); T4_STORE(b0, it); T4_LOAD(b0, it + 3 * NW); T4_STORE(b1, it + NW); T4_LOAD(b1, it + 4 * NW); T4_STORE(b2, it + 2 * NW); }
#undef T4_LOAD
#undef T4_STORE
    }
    rot = (rot + items) % NW;
}
template <int MAP> __device__ __forceinline__ void tr_matrix(Frame& F, LAS float* scr, const float* W, int Ksrc, int N, bf16* WT, int Kdst, const float* gain, int& rot) {
    tr_matrix_w<MAP>(F.gw, F.NGW, F.lane, scr, W, Ksrc, N, WT, Kdst, gain, rot);
}
__device__ __forceinline__ float row_to_bf16(const float* xrow, bf16* orow, int lane) {
    const GAS f32x4* xr = (const GAS f32x4*)xrow + lane; float s = 0.f;
#pragma unroll
    for (int h = 0; h < 2; ++h) { f32x4 v[8];
#pragma unroll
        for (int j = 0; j < 8; ++j) v[j] = xr[64 * (8 * h + j)];
#pragma unroll
        for (int j = 0; j < 8; ++j) { s += (v[j].x * v[j].x + v[j].y * v[j].y) + (v[j].z * v[j].z + v[j].w * v[j].w);
            ((GAS unsigned long long*)orow)[lane + 64 * (8 * h + j)] = (unsigned long long)pk2(v[j].x, v[j].y) | ((unsigned long long)pk2(v[j].z, v[j].w) << 32); } }
    return wave_sum(s);
}
__device__ __forceinline__ void p0_prologue(Frame F) { PHASE_LOCAL(F);
    LAS float* scr = (LAS float*)(F.lds + RING_OFF + F.wave * 16384);
    int rot = 0;
    tr4_matrix_w<0>(F.gw, F.NGW, F.lane, scr, F.a->in[I_WINA], AINW, WSP(bf16, WS_WINA), D, F.a->in[I_NMIX], rot);
    tr4_matrix_w<0>(F.gw, F.NGW, F.lane, scr, F.a->in[I_WMEM], 2048, WSP(bf16, WS_WMEM), D, F.a->in[I_NMEM], rot);
    tr4_matrix_w<0>(F.gw, F.NGW, F.lane, scr, F.a->in[I_WMEM] + (size_t)D * 2048, 2048, WSP(bf16, WS_WMEM) + (size_t)2048 * D, D, F.a->in[I_NMEM] + D, rot);
    tr_matrix<0>(F, scr, F.a->in[I_W2], 96, MIXW, WSP(bf16, WS_W2), 256, nullptr, rot);
    tr_matrix<0>(F, scr, F.a->in[I_A2], 96, MIXW, WSP(bf16, WS_A2), 256, nullptr, rot);
    tr_matrix<0>(F, scr, F.a->in[I_G2], 384, MIXW, WSP(bf16, WS_G2), 384, nullptr, rot);
    { GAS v4u* z = (GAS v4u*)(WSP(bf16, WS_WINA) + (size_t)AINW * D); const size_t n16 = (size_t)(NA - AINW) * D * 2 / 16;
      for (size_t i = (size_t)F.gw * 64 + F.lane; i < n16; i += (size_t)F.NGW * 64) z[i] = (v4u){0u, 0u, 0u, 0u}; }
    { const float* C = F.a->in[I_CMEM];
      for (int it = F.gw; it < 2 * 8 * 4 * 32; it += F.NGW) { const int lbh = it >> 5, sub = it & 31, kb = sub >> 3, nb = sub & 7, lb = lbh >> 2, h = lbh & 3;
          tr_item(C + (size_t)lb * 256 * 2048 + 1024 + h * 256, 256, 2048, WSP(bf16, WS_VTS) + (size_t)lbh * 65536, 256, 32 * nb, nullptr, scr, 64 * kb, 32 * nb, F.lane); }
      for (int it = F.gw; it < 2 * 8 * 256; it += F.NGW) { const int lb = it >> 8, key = it & 255; const float* src = C + (size_t)it * 2048;
#pragma unroll
          for (int h = 0; h < 4; ++h) { const f32x4 v = *(const GAS f32x4*)(src + h * 256 + 4 * F.lane);
              *(GAS unsigned long long*)(WSP(bf16, WS_KS) + ((size_t)(lb * 4 + h) * 256 + key) * 256 + 4 * F.lane) = (unsigned long long)pk2(v.x, v.y) | ((unsigned long long)pk2(v.z, v.w) << 32); } } }
    for (int m = F.gw; m < M; m += F.NGW) { const float* xr = m < MP ? F.a->in[I_XP] + (size_t)m * D : F.a->in[I_XS] + (size_t)(m - MP) * D;
        const float s = row_to_bf16(xr, WSP(bf16, WS_XA) + (size_t)m * D, F.lane); WSP(float, WS_SS)[(size_t)m * 64 + F.lane] = F.lane == 0 ? s : 0.f; }
    for (int m = F.gw; m < NBP * NMEM; m += F.NGW) { const float s = row_to_bf16(F.a->in[I_MEM] + (size_t)m * D, WSP(bf16, WS_XM) + (size_t)m * D, F.lane);
        if (F.lane == 0) WSP(float, WS_RSTDM)[m] = 1.0f / sqrtf(s * (1.0f / D) + RMS_EPS); }
}
struct ShiftRow { const bf16* u; const bf16* up; const float* st; bool hasprev; bool zero; };
__device__ __forceinline__ ShiftRow shift_row(Frame& F, int row) {
    ShiftRow s; s.u = WSP(bf16, WS_U) + (size_t)row * NA; s.up = s.u - NA;
    const bool isP = row < MP; const int t = isP ? (row & (SEQ - 1)) : ((row - MP) & (DSEQ - 1));
    s.hasprev = t > 0; s.zero = isP; s.st = F.a->in[I_SSHIFT] + (size_t)(isP ? 0 : ((row - MP) >> 3)) * ASW;
    return s;
}
__device__ __forceinline__ float shift_mix(const ShiftRow& s, const float* mu, int c) {
    const float uc = bf2f(s.u[c]); const float pv = s.hasprev ? bf2f(s.up[c]) : (s.zero ? 0.f : s.st[c]);
    return uc + (pv - uc) * mu[c];
}
template <int CTRL> __device__ __forceinline__ float dpp(float x) { return __builtin_bit_cast(float, __builtin_amdgcn_mov_dpp(__builtin_bit_cast(int, x), CTRL, 0xf, 0xf, true)); }
__device__ __forceinline__ float sum8(float x) { x += dpp<0xB1>(x); x += dpp<0x4E>(x); x += dpp<0x141>(x); return x; }
__device__ __forceinline__ float sum16(float x) { x = sum8(x); x += dpp<0x128>(x); return x; }
__device__ __forceinline__ f32x4 bf4_to_f32(unsigned lo, unsigned hi) { return (f32x4){__builtin_bit_cast(float, lo << 16), __builtin_bit_cast(float, lo & 0xffff0000u), __builtin_bit_cast(float, hi << 16), __builtin_bit_cast(float, hi & 0xffff0000u)}; }
typedef unsigned u32x2 __attribute__((ext_vector_type(2)));
__device__ __forceinline__ f32x4 shift_mix4(const ShiftRow& s, const float* mu, int c) {
    const u32x2 uw = *(const GAS u32x2*)(s.u + c); const f32x4 uc = bf4_to_f32(uw.x, uw.y); f32x4 pv;
    if (s.hasprev) { const u32x2 pw = *(const GAS u32x2*)(s.up + c); pv = bf4_to_f32(pw.x, pw.y); } else if (s.zero) pv = (f32x4){0.f, 0.f, 0.f, 0.f}; else pv = *(const GAS f32x4*)(s.st + c);
    return uc + (pv - uc) * *(const GAS f32x4*)(mu + c);
}
__device__ __forceinline__ void p2_lora_prep(Frame F) { PHASE_LOCAL(F);
    const float* mu = F.a->in[I_MU];
    for (int row = F.gw; row < M; row += F.NGW) {
        const ShiftRow s = shift_row(F, row);
        bf16* xw = WSP(bf16, WS_XLW) + (size_t)row * 256; bf16* xa = WSP(bf16, WS_XLA) + (size_t)row * 256; bf16* xg = WSP(bf16, WS_XLG) + (size_t)row * 384;
#pragma unroll
        for (int i = 0; i < 3; ++i) { const int j = 4 * (F.lane + 64 * i);
            if (j < 576) { const f32x4 x = shift_mix4(s, mu, 3 * MIXW + j); f32x4 y; bf16* dst;
                if (j < 96) { y = (f32x4){tanhf(x.x), tanhf(x.y), tanhf(x.z), tanhf(x.w)}; dst = xw + j; }
                else if (j < 192) { y = x; dst = xa + (j - 96); }
                else { y = (f32x4){1.0f / (1.0f + expf(-x.x)), 1.0f / (1.0f + expf(-x.y)), 1.0f / (1.0f + expf(-x.z)), 1.0f / (1.0f + expf(-x.w))}; dst = xg + (j - 192); }
                u32x2 o; o.x = pk2(y.x, y.y); o.y = pk2(y.z, y.w); *(GAS u32x2*)dst = o; } }
        if (F.lane < 40) { *(GAS u32x2*)(xw + 96 + 4 * F.lane) = (u32x2){0u, 0u}; *(GAS u32x2*)(xa + 96 + 4 * F.lane) = (u32x2){0u, 0u}; }
        const bool isP = row < MP; const int t = isP ? (row & (SEQ - 1)) : ((row - MP) & (DSEQ - 1));
        if (t == (isP ? SEQ - 1 : DSEQ - 1)) { float* o = F.out + (isP ? OUT_SHIFTP + (size_t)(row >> 11) * ASW : OUT_SHIFTS + (size_t)((row - MP) >> 3) * ASW);
            for (int c = 4 * F.lane; c < ASW; c += 256) { const u32x2 uw = *(const GAS u32x2*)(s.u + c); *(GAS f32x4*)(o + c) = bf4_to_f32(uw.x, uw.y); } }
    }
}
__device__ __forceinline__ void p2_memkv_post(Frame F) { PHASE_LOCAL(F);
    LAS float* scr = (LAS float*)(F.lds + RING_OFF + F.wave * 16384);
    const float* RAW = WSP(float, WS_MEMRAW);
    for (int it = F.gw; it < 2 * 4 * 4 * 32; it += F.NGW) { const int lbh = it >> 5, sub = it & 31, kb = sub >> 3, nb = sub & 7, lb = lbh >> 2, h = lbh & 3;
        tr_item(RAW + (size_t)lb * 256 * 2048 + 1024 + h * 256, 256, 2048, WSP(bf16, WS_VTP) + (size_t)lbh * 65536, 256, 32 * nb, nullptr, scr, 64 * kb, 32 * nb, F.lane); }
    for (int it = F.gw; it < 2 * 1024; it += F.NGW) { const int l = it >> 10, row = it & 1023, b = row >> 8, key = row & 255; const float* src = RAW + (size_t)it * 2048; float* o = F.out + OUT_MEMKV + (size_t)it * 2048;
        const float* gk = F.a->in[I_KNM] + l * 256;
#pragma unroll
        for (int h = 0; h < 4; ++h) { const f32x4 v = *(const GAS f32x4*)(src + h * 256 + 4 * F.lane); const f32x4 g = *(const GAS f32x4*)(gk + 4 * F.lane);
            const float ss = wave_sum((v.x * v.x + v.y * v.y) + (v.z * v.z + v.w * v.w)); const float r = 1.0f / sqrtf(ss * (1.0f / 256.0f) + RMS_EPS);
            const f32x4 kn = v * r * g; *(GAS f32x4*)(o + h * 256 + 4 * F.lane) = kn;
            *(GAS unsigned long long*)(WSP(bf16, WS_KP) + ((size_t)((l * 4 + b) * 4 + h) * 256 + key) * 256 + 4 * F.lane) = (unsigned long long)pk2(kn.x, kn.y) | ((unsigned long long)pk2(kn.z, kn.w) << 32);
            *(GAS f32x4*)(o + 1024 + h * 256 + 4 * F.lane) = *(const GAS f32x4*)(src + 1024 + h * 256 + 4 * F.lane); } }
}
__device__ __forceinline__ float* scan_ptr(Frame& F, int row, int h) {
    if (row < MP) return WSP(float, WS_SCANP) + ((size_t)((row >> 11) * AH + h) * SEQ + (row & (SEQ - 1))) * 384;
    const int sr = row - MP; return WSP(float, WS_SCANS) + ((size_t)((sr >> 3) * AH + h) * DSEQ + (sr & (DSEQ - 1))) * 384;
}
struct P4In { u32x2 ur, uk, uv, pr, pk, pv; f32x4 mr, mk, mv, a, kka, kaa; };
__device__ __forceinline__ f32x4 mix4(u32x2 uw, u32x2 pw, f32x4 mu) { const f32x4 uc = bf4_to_f32(uw.x, uw.y), pc = bf4_to_f32(pw.x, pw.y); return uc + (pc - uc) * mu; }
template <bool DRY> __device__ __forceinline__ void p4_scan_prep_t(Frame F) { PHASE_LOCAL(F);
    const float* mu = F.a->in[I_MU]; const float* kk_a = F.a->in[I_KK]; const float* ka_a = F.a->in[I_KA];
    for (int un = F.gw; un < M * 4; un += F.NGW) { const int row = un >> 2, itb = (un & 3) * 3;
        const ShiftRow s = shift_row(F, row);
        if (s.hasprev) {
            for (int it0 = itb; it0 < itb + 3; it0 += 3) { P4In in[3];
#pragma unroll
                for (int j = 0; j < 3; ++j) { const int c = 256 * (it0 + j) + 4 * F.lane; const float* sp = scan_ptr(F, row, 4 * (it0 + j) + (F.lane >> 4)) + 4 * (F.lane & 15);
                    in[j].ur = *(const GAS u32x2*)(s.u + c); in[j].uk = *(const GAS u32x2*)(s.u + MIXW + c); in[j].uv = *(const GAS u32x2*)(s.u + 2 * MIXW + c);
                    in[j].pr = *(const GAS u32x2*)(s.up + c); in[j].pk = *(const GAS u32x2*)(s.up + MIXW + c); in[j].pv = *(const GAS u32x2*)(s.up + 2 * MIXW + c);
                    in[j].mr = *(const GAS f32x4*)(mu + c); in[j].mk = *(const GAS f32x4*)(mu + MIXW + c); in[j].mv = *(const GAS f32x4*)(mu + 2 * MIXW + c);
                    in[j].a = *(const GAS f32x4*)(sp + 256); in[j].kka = *(const GAS f32x4*)(kk_a + c); in[j].kaa = *(const GAS f32x4*)(ka_a + c); }
#pragma unroll
                for (int j = 0; j < 3; ++j) { float* sp = scan_ptr(F, row, 4 * (it0 + j) + (F.lane >> 4)) + 4 * (F.lane & 15);
                    const f32x4 r = mix4(in[j].ur, in[j].pr, in[j].mr), k = mix4(in[j].uk, in[j].pk, in[j].mk), v = mix4(in[j].uv, in[j].pv, in[j].mv), a = in[j].a;
                    f32x4 kk = k * in[j].kka; const float n2 = sum16((kk.x * kk.x + kk.y * kk.y) + (kk.z * kk.z + kk.w * kk.w)); kk = kk * (1.0f / fmaxf(sqrtf(n2), 1e-12f));
                    const f32x4 k2 = k * (1.0f + (a - 1.0f) * in[j].kaa);
                    *(GAS f32x4*)sp = r; *(GAS f32x4*)(sp + 128) = k2; *(GAS f32x4*)(sp + 192) = -kk; if (!DRY) *(GAS f32x4*)(sp + 256) = kk * a; *(GAS f32x4*)(sp + 320) = v;
                    *(GAS f32x4*)(WSP(float, WS_AARR) + (size_t)row * MIXW + 256 * (it0 + j) + 4 * F.lane) = a; }
            }
        } else {
#pragma unroll 3
        for (int it = itb; it < itb + 3; ++it) { const int c = 256 * it + 4 * F.lane; float* sp = scan_ptr(F, row, 4 * it + (F.lane >> 4)) + 4 * (F.lane & 15);
            const f32x4 r = shift_mix4(s, mu, c), k = shift_mix4(s, mu, MIXW + c), v = shift_mix4(s, mu, 2 * MIXW + c);
            const f32x4 a = *(const GAS f32x4*)(sp + 256);
            f32x4 kk = k * *(const GAS f32x4*)(kk_a + c); const float n2 = sum16((kk.x * kk.x + kk.y * kk.y) + (kk.z * kk.z + kk.w * kk.w)); kk = kk * (1.0f / fmaxf(sqrtf(n2), 1e-12f));
            const f32x4 k2 = k * (1.0f + (a - 1.0f) * *(const GAS f32x4*)(ka_a + c));
            *(GAS f32x4*)sp = r; *(GAS f32x4*)(sp + 128) = k2; *(GAS f32x4*)(sp + 192) = -kk; if (!DRY) *(GAS f32x4*)(sp + 256) = kk * a; *(GAS f32x4*)(sp + 320) = v;
            *(GAS f32x4*)(WSP(float, WS_AARR) + (size_t)row * MIXW + c) = a; }
        }
    }
}
struct TrDesc { const float* W; bf16* WT; const float* gain; int Ksrc, N, Kdst, map, nblk; };
constexpr int BG_C0 = 64 * 128, BG_C1 = BG_C0 + 64 * 688, BG_C2 = BG_C1 + 172 * 128, BG_C3 = BG_C2 + 64 * 320, BG_C4 = BG_C3 + 32 * 128, BG_C5 = BG_C4 + 64 * 688, BG_C6 = BG_C5 + 172 * 128;
constexpr int BG_NCOPY = (8 * (120 + 504 + 2040) * 512) / 2048;
constexpr int CW_QA = 64, CW_QB = 128, CW_SKQ = 192;
__device__ __forceinline__ int q_grab(gu32* ctr, int lane) { unsigned v = 0u; if (lane == 0) v = __hip_atomic_fetch_add(ctr, 1u, __ATOMIC_RELAXED, __HIP_MEMORY_SCOPE_AGENT); return (int)__builtin_amdgcn_readfirstlane(v); }
__device__ __forceinline__ void bg_resolve(Frame& F, int it, TrDesc& d, int& loc) {
    if (it < BG_C0) { d = TrDesc{F.a->in[I_WOUTA], WSP(bf16, WS_WOUTA), nullptr, D, D, D, 0, D / 32}; loc = it; }
    else if (it < BG_C1) { d = TrDesc{F.a->in[I_WFI], WSP(bf16, WS_WFI), F.a->in[I_NFFN], D, NFI, KFIP, 1, NFI / 32}; loc = it - BG_C0; }
    else if (it < BG_C2) { d = TrDesc{F.a->in[I_WFO], WSP(bf16, WS_WFOP), nullptr, DFF, D, DFFP, 0, D / 32}; loc = it - BG_C1; }
    else if (it < BG_C3) { d = TrDesc{F.a->in[I_WINB], WSP(bf16, WS_WINB), F.a->in[I_NMIX] + D, D, NB, D, 0, NB / 32}; loc = it - BG_C2; }
    else if (it < BG_C4) { d = TrDesc{F.a->in[I_WOUTB], WSP(bf16, WS_WOUTB), nullptr, 2048, D, 2048, 0, D / 32}; loc = it - BG_C3; }
    else if (it < BG_C5) { d = TrDesc{F.a->in[I_WFI] + (size_t)D * NFI, WSP(bf16, WS_WFI) + (size_t)NFI * KFIP, F.a->in[I_NFFN] + D, D, NFI, KFIP, 1, NFI / 32}; loc = it - BG_C4; }
    else { d = TrDesc{F.a->in[I_WFO] + (size_t)DFF * D, WSP(bf16, WS_WFOP) + (size_t)D * DFFP, nullptr, DFF, D, DFFP, 0, D / 32}; loc = it - BG_C5; }
}
constexpr int BG_GRAB = 32;
__device__ __forceinline__ void bg_load(Frame& F, int it, TrBuf& b) { TrDesc d; int loc; bg_resolve(F, it, d, loc); tr4_load(b, d.W, d.N, d.gain, 64 * (loc / d.nblk), 32 * (loc % d.nblk), F.lane); }
__device__ __forceinline__ void bg_store(Frame& F, int it, TrBuf& b, LAS float* scr) { TrDesc d; int loc; bg_resolve(F, it, d, loc);
    const int kb = loc / d.nblk, n0 = 32 * (loc % d.nblk); int drow = n0;
    if (d.map) { const int up = n0 >= DFF, j = n0 - up * DFF; drow = 256 * (j >> 7) + 128 * up + (j & 127); }
    tr4_store(b, d.gain != nullptr, d.WT, d.Kdst, drow, scr, 64 * kb, F.lane); }
__device__ __forceinline__ void bg_range(Frame& F, int base, int end, LAS float* scr) { const int last = end - 1;
    TrBuf b0, b1, b2, b3;
    bg_load(F, base, b0); bg_load(F, min(base + 1, last), b1); bg_load(F, min(base + 2, last), b2);
    for (int it = base; it < end; it += 4) {
        bg_load(F, min(it + 3, last), b3); bg_store(F, it, b0, scr);
        bg_load(F, min(it + 4, last), b0); bg_store(F, min(it + 1, last), b1, scr);
        bg_load(F, min(it + 5, last), b1); bg_store(F, min(it + 2, last), b2, scr);
        bg_load(F, min(it + 6, last), b2); bg_store(F, min(it + 3, last), b3, scr);
    }
}
constexpr int SCH = 8;
constexpr int P5_SCR_STRIDE = 8704;
template <int SNB> __device__ __forceinline__ void p5_scan_wg(Frame F, int task, int& gch) { PHASE_LOCAL(F);
    constexpr int P5_FLAGS = SNB * SCH * 1536;
    const bool isP = task < NBP * AH; const int sh = isP ? task : task - NBP * AH; const int seq = sh / AH, h = sh % AH; const int T = isP ? SEQ : DSEQ;
    const int steps = T < SCH ? T : SCH, nch = T / steps; const int row0 = isP ? seq * SEQ : MP + seq * DSEQ;
    LAS float* stage = (LAS float*)(F.lds + RING_OFF);
    volatile LAS unsigned* FL = (volatile LAS unsigned*)(F.lds + RING_OFF + P5_FLAGS);
    const int w = F.wave, co = F.lane & 7, rp = F.lane >> 3;
    if (w >= 4) {
        const int L = w - 4, cc = 64 * h + F.lane;
        const float mur = F.a->in[I_MU][cc], muk = F.a->in[I_MU][MIXW + cc], muv = F.a->in[I_MU][2 * MIXW + cc], kka = F.a->in[I_KK][cc], kaa = F.a->in[I_KA][cc], rkc = F.a->in[I_RK][cc];
        volatile LAS float* BS = (volatile LAS float*)(F.lds + RING_OFF + P5_FLAGS + 256);
        const bf16* Ub = WSP(bf16, WS_U) + (size_t)row0 * NA + cc; const float* wb = WSP(float, WS_WARR) + (size_t)row0 * MIXW + cc; const float* ab = WSP(float, WS_AARR) + (size_t)row0 * MIXW + cc;
        const float* st0 = isP ? nullptr : F.a->in[I_SSHIFT] + (size_t)seq * ASW + cc;
        struct LdSet { unsigned u[3][9]; float w[8], a[8]; };
#define LD_ISSUE(S, chx) do { const int t0_ = (chx) * SCH; _Pragma("unroll") for (int j_ = 0; j_ < 9; ++j_) { const int t_ = t0_ + j_ - 1; const bf16* up_ = Ub + (size_t)(t_ < 0 ? 0 : t_) * NA; \
            S.u[0][j_] = up_[0]; S.u[1][j_] = up_[MIXW]; S.u[2][j_] = up_[2 * MIXW]; } \
        _Pragma("unroll") for (int j_ = 0; j_ < 8; ++j_) { S.w[j_] = wb[(size_t)(t0_ + j_) * MIXW]; S.a[j_] = ab[(size_t)(t0_ + j_) * MIXW]; } } while (0)
#define LD_COMPUTE(S, chx) do { const int c_ = gch + (chx), b_ = c_ & (SNB - 1); \
            while ((int)min(min(FL[16], FL[17]), min(FL[18], FL[19])) < c_ - (SNB - 1)) __builtin_amdgcn_s_sleep(1); \
            asm volatile("" ::: "memory"); \
            LAS float* st_ = stage + b_ * SCH * 384 + F.lane; \
            float pr_ = __builtin_bit_cast(float, S.u[0][0] << 16), pk_ = __builtin_bit_cast(float, S.u[1][0] << 16), pv_ = __builtin_bit_cast(float, S.u[2][0] << 16); \
            if ((chx) == 0) { if (isP) { pr_ = 0.f; pk_ = 0.f; pv_ = 0.f; } else { pr_ = st0[0]; pk_ = st0[MIXW]; pv_ = st0[2 * MIXW]; } } \
            _Pragma("unroll") for (int j_ = 0; j_ < 8; ++j_) { const float ur_ = __builtin_bit_cast(float, S.u[0][j_ + 1] << 16), uk_ = __builtin_bit_cast(float, S.u[1][j_ + 1] << 16), uv_ = __builtin_bit_cast(float, S.u[2][j_ + 1] << 16); \
                const float r_ = ur_ + (pr_ - ur_) * mur, k_ = uk_ + (pk_ - uk_) * muk, v_ = uv_ + (pv_ - uv_) * muv; pr_ = ur_; pk_ = uk_; pv_ = uv_; \
                float kk_ = k_ * kka; float n2_ = sum16(kk_ * kk_); n2_ += __shfl_xor(n2_, 16); n2_ += __shfl_xor(n2_, 32); kk_ = kk_ * (1.0f / fmaxf(sqrtf(n2_), 1e-12f)); \
                const float a_ = S.a[j_]; \
                const float k2_ = k_ * (1.0f + (a_ - 1.0f) * kaa); float bs_ = sum16(r_ * k2_ * rkc); bs_ += __shfl_xor(bs_, 16); bs_ += __shfl_xor(bs_, 32); if (F.lane == 0) BS[b_ * SCH + j_] = bs_; \
                st_[j_ * 384] = r_; st_[j_ * 384 + 64] = S.w[j_]; st_[j_ * 384 + 128] = k2_; st_[j_ * 384 + 192] = -kk_; st_[j_ * 384 + 256] = kk_ * a_; st_[j_ * 384 + 320] = v_; } \
            asm volatile("s_waitcnt lgkmcnt(0)" ::: "memory"); \
            if (F.lane == 0) FL[b_] = (unsigned)(c_ + 1); } while (0)
        if (w < 6 && L < nch) { LdSet SA, SB; const int lastc = ((nch - 1 - L) & ~1) + L;
            int ch = L; LD_ISSUE(SA, ch);
            for (; ch < nch; ch += 4) {
                { const int c2 = ch + 2 <= lastc ? ch + 2 : ch; LD_ISSUE(SB, c2); }
                LD_COMPUTE(SA, ch);
                { const int c4 = ch + 4 <= lastc ? ch + 4 : ch; LD_ISSUE(SA, c4); }
                if (ch + 2 < nch) LD_COMPUTE(SB, ch + 2);
            } }
#undef LD_ISSUE
#undef LD_COMPUTE
        if (w == 6) { const int tq = F.lane >> 3, pq = F.lane & 7, cf = 64 * h + 8 * pq;
            const f32x4 lg0 = *(const GAS f32x4*)(F.a->in[I_LNG] + cf), lg1 = *(const GAS f32x4*)(F.a->in[I_LNG] + cf + 4), lb0 = *(const GAS f32x4*)(F.a->in[I_LNB] + cf), lb1 = *(const GAS f32x4*)(F.a->in[I_LNB] + cf + 4);
            const bf16* gp = WSP(bf16, WS_G) + (size_t)(row0 + tq) * MIXW + cf; bf16* op = WSP(bf16, WS_O) + (size_t)(row0 + tq) * D + cf;
            const LAS float* YZ = (const LAS float*)(F.lds + RING_BYTES + 2048) + tq * 128 + 8 * pq;
            int bq_cur = 0, bq_end = 0, bq_it0 = 0, bq_it1 = 0; bool bq_done = !isP; TrBuf bqb0, bqb1; LAS float* bscr = (LAS float*)(F.lds + RING_OFF + P5_FLAGS + 1024 + 6 * P5_SCR_STRIDE);
            if (isP) { bg_load(F, 0, bqb0); bg_load(F, 0, bqb1); }
#define FIN_BODY(chx, BG, bqb, bq_it) do { const int ch_ = (chx), c = gch + ch_, yb = c % 3;                 const v4u gw = *(const GAS v4u*)(gp + (size_t)ch_ * SCH * MIXW); \
                if (BG) { bg_store(F, bq_it, bqb, bscr); \
                    if (bq_cur == bq_end && !bq_done) { const int base_ = q_grab(F.ctl + CW_QA, F.lane) * BG_GRAB; if (base_ >= BG_C6) bq_done = true; else { bq_cur = base_; bq_end = base_ + BG_GRAB < BG_C6 ? base_ + BG_GRAB : BG_C6; } } \
                    bq_it = bq_cur < bq_end ? bq_cur : 0; bq_cur += bq_cur < bq_end ? 1 : 0; bg_load(F, bq_it, bqb); } \
 \
                while ((int)min(min(FL[16], FL[17]), min(FL[18], FL[19])) < c + 1) __builtin_amdgcn_s_sleep(1); \
                asm volatile("" ::: "memory"); \
                const LAS float* yp = YZ + yb * SCH * 128; \
                const f32x4 y0 = *(const LAS f32x4*)yp, y1 = *(const LAS f32x4*)(yp + 4), z0 = *(const LAS f32x4*)(yp + 64), z1 = *(const LAS f32x4*)(yp + 68); \
                const float mean = sum8(((y0.x + y0.y) + (y0.z + y0.w)) + ((y1.x + y1.y) + (y1.z + y1.w))) * (1.0f / 64.0f); const f32x4 d0 = y0 - mean, d1 = y1 - mean; \
                const float var = sum8(((d0.x * d0.x + d0.y * d0.y) + (d0.z * d0.z + d0.w * d0.w)) + ((d1.x * d1.x + d1.y * d1.y) + (d1.z * d1.z + d1.w * d1.w))) * (1.0f / 64.0f); const float rs = 1.0f / sqrtf(var + LNX_EPS); \
                const f32x4 g0 = bf4_to_f32(gw.x, gw.y), g1 = bf4_to_f32(gw.z, gw.w); \
                const f32x4 o0 = (d0 * rs * lg0 + lb0 + z0) * g0, o1 = (d1 * rs * lg1 + lb1 + z1) * g1; \
                v4u ow; ow.x = pk2(o0.x, o0.y); ow.y = pk2(o0.z, o0.w); ow.z = pk2(o1.x, o1.y); ow.w = pk2(o1.z, o1.w); \
                *(GAS v4u*)(op + (size_t)ch_ * SCH * D) = ow; \
                asm volatile("s_waitcnt lgkmcnt(0)" ::: "memory"); \
                if (F.lane == 0) FL[24] = (unsigned)(c + 1); } while (0)
            if (isP) { for (int ch = 0; ch < nch; ch += 2) { FIN_BODY(ch, true, bqb0, bq_it0); FIN_BODY(ch + 1, true, bqb1, bq_it1); }
                bg_store(F, bq_it0, bqb0, bscr); bg_store(F, bq_it1, bqb1, bscr);
                if (bq_cur < bq_end) bg_range(F, bq_cur, bq_end, bscr);
            } else { for (int ch = 0; ch < nch; ++ch) FIN_BODY(ch, false, bqb0, bq_it0); }
#undef FIN_BODY
            }
    } else {
        __builtin_amdgcn_s_setprio(2);
        f32x2 S[2][4];
        if (isP) {
#pragma unroll
            for (int r = 0; r < 2; ++r)
#pragma unroll
                for (int j = 0; j < 4; ++j) S[r][j] = (f32x2){0.f, 0.f};
        } else { const float* s0 = F.a->in[I_SWKV] + ((size_t)sh * 64 + 16 * w + 2 * rp) * 64 + 8 * co;
#pragma unroll
            for (int r = 0; r < 2; ++r) { const f32x4 x0 = *(const GAS f32x4*)(s0 + 64 * r), x1 = *(const GAS f32x4*)(s0 + 64 * r + 4);
                S[r][0] = (f32x2){x0.x, x0.y}; S[r][1] = (f32x2){x0.z, x0.w}; S[r][2] = (f32x2){x1.x, x1.y}; S[r][3] = (f32x2){x1.z, x1.w}; } }
        LAS float* YZw = (LAS float*)(F.lds + RING_BYTES + 2048) + 16 * w + 2 * rp;
        for (int ch = 0; ch < nch; ++ch) { const int c = gch + ch, b = c & (SNB - 1);
            while (FL[b] != (unsigned)(c + 1)) __builtin_amdgcn_s_sleep(1);
            asm volatile("" ::: "memory");
            const LAS float* P0 = stage + b * SCH * 384 + 8 * co; const LAS float* PV = stage + b * SCH * 384 + 320 + 16 * w + 2 * rp;
            f32x4 vec[2][10]; f32x2 vvv[2]; float ys[SCH][2], zs[SCH][2]; const volatile LAS float* BSr = (const volatile LAS float*)(F.lds + RING_OFF + P5_FLAGS + 256) + b * SCH;
#define SC_LOAD(buf, tt) do { const LAS float* P = P0 + (tt) * 384; _Pragma("unroll") for (int i_ = 0; i_ < 5; ++i_) { vec[buf][2 * i_] = *(const LAS f32x4*)(P + 64 * i_); vec[buf][2 * i_ + 1] = *(const LAS f32x4*)(P + 64 * i_ + 4); } \
                vvv[buf] = *(const LAS f32x2*)(PV + (tt) * 384); } while (0)
            SC_LOAD(0, 0);
#pragma unroll
            for (int tt = 0; tt < SCH; ++tt) { const int cb_ = tt & 1;
                if (tt + 1 < SCH) SC_LOAD(cb_ ^ 1, tt + 1);
                const f32x4 r0 = vec[cb_][0], r1 = vec[cb_][1], w0 = vec[cb_][2], w1 = vec[cb_][3], k0 = vec[cb_][4], k1 = vec[cb_][5], a0 = vec[cb_][6], a1 = vec[cb_][7], b0 = vec[cb_][8], b1 = vec[cb_][9]; const f32x2 vv = vvv[cb_];
                const f32x2 av[4] = {{a0.x, a0.y}, {a0.z, a0.w}, {a1.x, a1.y}, {a1.z, a1.w}}, wv[4] = {{w0.x, w0.y}, {w0.z, w0.w}, {w1.x, w1.y}, {w1.z, w1.w}};
                const f32x2 kv[4] = {{k0.x, k0.y}, {k0.z, k0.w}, {k1.x, k1.y}, {k1.z, k1.w}}, bv[4] = {{b0.x, b0.y}, {b0.z, b0.w}, {b1.x, b1.y}, {b1.z, b1.w}}, rv[4] = {{r0.x, r0.y}, {r0.z, r0.w}, {r1.x, r1.y}, {r1.z, r1.w}};
#pragma unroll
                for (int r = 0; r < 2; ++r) { f32x2 sa2 = S[r][0] * av[0]; sa2 += S[r][1] * av[1]; sa2 += S[r][2] * av[2]; sa2 += S[r][3] * av[3];
                    const float sa = sum8(sa2.x + sa2.y); const float vr = r == 0 ? vv.x : vv.y; f32x2 y2 = {0.f, 0.f};
#pragma unroll
                    for (int j = 0; j < 4; ++j) { S[r][j] = S[r][j] * wv[j] + sa * bv[j] + vr * kv[j]; y2 += S[r][j] * rv[j]; }
                    ys[tt][r] = sum8(y2.x + y2.y); }
                { const float bsv = BSr[tt]; zs[tt][0] = bsv * vv.x; zs[tt][1] = bsv * vv.y; }
            }
#undef SC_LOAD
            while ((int)FL[24] < c - 2) __builtin_amdgcn_s_sleep(1);
            asm volatile("" ::: "memory");
            if (co == 0) { const int yb = c % 3;
#pragma unroll
                for (int tt = 0; tt < SCH; ++tt) { *(LAS f32x2*)(YZw + (yb * SCH + tt) * 128) = (f32x2){ys[tt][0], ys[tt][1]}; *(LAS f32x2*)(YZw + (yb * SCH + tt) * 128 + 64) = (f32x2){zs[tt][0], zs[tt][1]}; } }
            asm volatile("s_waitcnt lgkmcnt(0)" ::: "memory");
            if (F.lane == 0) FL[16 + w] = (unsigned)(c + 1);
        }
        __builtin_amdgcn_s_setprio(0);
        float* so = F.out + (isP ? OUT_WKVP : OUT_WKVS) + ((size_t)sh * 64 + 16 * w + 2 * rp) * 64 + 8 * co;
#pragma unroll
        for (int r = 0; r < 2; ++r) { *(GAS f32x4*)(so + 64 * r) = (f32x4){S[r][0].x, S[r][0].y, S[r][1].x, S[r][1].y}; *(GAS f32x4*)(so + 64 * r + 4) = (f32x4){S[r][2].x, S[r][2].y, S[r][3].x, S[r][3].y}; }
    }
    gch += nch;
}
__device__ __forceinline__ void bg_copies(Frame& F, gu32* qb) {
    for (;;) { const int c = q_grab(qb, F.lane); if (c >= BG_NCOPY) break;
        int ci = c, g = 0, ipb = 30;
        if (ci >= 8 * 30) { ci -= 8 * 30; g = 1; ipb = 126; if (ci >= 8 * 126) { ci -= 8 * 126; g = 2; ipb = 510; } }
        const int b = ci / ipb, x0 = (ci - b * ipb) * 2048; const size_t full = (size_t)(128 << (2 * g)) * 2048;
        const float* C = (g == 0 ? F.a->in[I_C1] : (g == 1 ? F.a->in[I_C2] : F.a->in[I_C3])) + b * full + 16384 + 4 * (size_t)(x0 + F.lane);
        float* o = F.out + (g == 0 ? OUT_SWAS1 : (g == 1 ? OUT_SWAS2 : OUT_SWAS3)) + b * full + 4 * (size_t)(x0 + F.lane);
#pragma unroll
        for (int h = 0; h < 2; ++h) { f32x4 v[16];
#pragma unroll
            for (int k = 0; k < 16; ++k) v[k] = *(const GAS f32x4*)(C + (size_t)(16 * h + k) * 256);
#pragma unroll
            for (int k = 0; k < 16; ++k) *(GAS f32x4*)(o + (size_t)(16 * h + k) * 256) = v[k]; } }
}
__device__ __forceinline__ void p5_background(Frame F, int scr_off, bool copies_first) { PHASE_LOCAL(F);
    LAS float* scr = (LAS float*)(F.lds + RING_OFF + scr_off);
    gu32* qa = F.ctl + CW_QA; gu32* qb = F.ctl + CW_QB;
    if (copies_first) bg_copies(F, qb);
    for (;;) { const int base = q_grab(qa, F.lane) * BG_GRAB; if (base >= BG_C6) break;
        bg_range(F, base, base + BG_GRAB < BG_C6 ? base + BG_GRAB : BG_C6, scr); }
    bg_copies(F, qb);
}
struct P5In { f32x4 y, z, lg, lb; u32x2 g; };
__device__ __forceinline__ void p5b_post(Frame F) { PHASE_LOCAL(F);
    const float* lng = F.a->in[I_LNG]; const float* lnb = F.a->in[I_LNB];
    for (int un = F.gw; un < M * 3; un += F.NGW) { const int row = un / 3, itb = (un - 3 * row) * 4;
        const float* yrow = WSP(float, WS_YRAW) + (size_t)row * MIXW; const float* zrow = WSP(float, WS_ZRAW) + (size_t)row * MIXW; const bf16* grow = WSP(bf16, WS_G) + (size_t)row * MIXW; bf16* orow = WSP(bf16, WS_O) + (size_t)row * D;
        P5In in[4];
#pragma unroll
        for (int j = 0; j < 4; ++j) { const int c = 256 * (itb + j) + 4 * F.lane;
            in[j].y = *(const GAS f32x4*)(yrow + c); in[j].z = *(const GAS f32x4*)(zrow + c); in[j].g = *(const GAS u32x2*)(grow + c); in[j].lg = *(const GAS f32x4*)(lng + c); in[j].lb = *(const GAS f32x4*)(lnb + c); }
#pragma unroll
        for (int j = 0; j < 4; ++j) { const int c = 256 * (itb + j) + 4 * F.lane; const f32x4 y = in[j].y, g = bf4_to_f32(in[j].g.x, in[j].g.y);
            const float mean = sum16((y.x + y.y) + (y.z + y.w)) * (1.0f / 64.0f); const f32x4 d = y - mean;
            const float var = sum16((d.x * d.x + d.y * d.y) + (d.z * d.z + d.w * d.w)) * (1.0f / 64.0f); const float rs = 1.0f / sqrtf(var + LNX_EPS);
            const f32x4 o = (d * rs * in[j].lg + in[j].lb + in[j].z) * g;
            u32x2 ow; ow.x = pk2(o.x, o.y); ow.y = pk2(o.z, o.w); *(GAS u32x2*)(orow + c) = ow; }
    }
}

__device__ __forceinline__ void mem_attend_task(const bf16* Q, int ldq, int qmask, int nvalid, const float* gq, const bf16* K, const bf16* VT, bf16* Oo, int ldo, int lane) {
    const int q = lane & 15, g = lane >> 4;
    const bf16* qp = Q + (size_t)(q & qmask) * ldq + 8 * g;
    bf16x8 Bq[8]; float ss = 0.f;
    float qf[8][8];
#pragma unroll
    for (int s = 0; s < 8; ++s) { const v4u raw = *(const GAS v4u*)(qp + 32 * s);
        const unsigned w[4] = {raw.x, raw.y, raw.z, raw.w};
#pragma unroll
        for (int j = 0; j < 4; ++j) { qf[s][2 * j] = __builtin_bit_cast(float, w[j] << 16); qf[s][2 * j + 1] = __builtin_bit_cast(float, w[j] & 0xffff0000u); }
#pragma unroll
        for (int j = 0; j < 8; ++j) ss += qf[s][j] * qf[s][j]; }
    ss += __shfl_xor(ss, 16); ss += __shfl_xor(ss, 32);
    const float sc = (1.0f / sqrtf(ss * (1.0f / 256.0f) + RMS_EPS)) * (0.0625f * LOG2E);
#pragma unroll
    for (int s = 0; s < 8; ++s) { const f32x4 g0 = *(const GAS f32x4*)(gq + 32 * s + 8 * g), g1 = *(const GAS f32x4*)(gq + 32 * s + 8 * g + 4);
        v4u w; w.x = pk2(qf[s][0] * sc * g0.x, qf[s][1] * sc * g0.y); w.y = pk2(qf[s][2] * sc * g0.z, qf[s][3] * sc * g0.w);
        w.z = pk2(qf[s][4] * sc * g1.x, qf[s][5] * sc * g1.y); w.w = pk2(qf[s][6] * sc * g1.z, qf[s][7] * sc * g1.w);
        Bq[s] = __builtin_bit_cast(bf16x8, w); }
    f32x4 sT[16];
#pragma unroll
    for (int kt = 0; kt < 16; ++kt) { f32x4 acc = (f32x4){0.f, 0.f, 0.f, 0.f}; const bf16* kp = K + (size_t)(16 * kt + q) * 256 + 8 * g;
#pragma unroll
        for (int s = 0; s < 8; ++s) { const bf16x8 a = *(const GAS bf16x8*)(kp + 32 * s); acc = __builtin_amdgcn_mfma_f32_16x16x32_bf16(a, Bq[s], acc, 0, 0, 0); }
        sT[kt] = acc; }
    float mx = -3.0e38f;
#pragma unroll
    for (int kt = 0; kt < 16; ++kt) mx = fmaxf(mx, fmaxf(fmaxf(sT[kt][0], sT[kt][1]), fmaxf(sT[kt][2], sT[kt][3])));
    mx = fmaxf(mx, __shfl_xor(mx, 16)); mx = fmaxf(mx, __shfl_xor(mx, 32));
    float l = 0.f;
#pragma unroll
    for (int kt = 0; kt < 16; ++kt) {
#pragma unroll
        for (int i = 0; i < 4; ++i) { const float p = __builtin_amdgcn_exp2f(sT[kt][i] - mx); sT[kt][i] = p; l += p; } }
    l += __shfl_xor(l, 16); l += __shfl_xor(l, 32);
    const float inv = 1.0f / l;
    bf16x8 Bp[8];
#pragma unroll
    for (int s = 0; s < 8; ++s) { v4u w; w.x = pk2(sT[2 * s][0], sT[2 * s][1]); w.y = pk2(sT[2 * s][2], sT[2 * s][3]); w.z = pk2(sT[2 * s + 1][0], sT[2 * s + 1][1]); w.w = pk2(sT[2 * s + 1][2], sT[2 * s + 1][3]);
        Bp[s] = __builtin_bit_cast(bf16x8, w); }
    typedef unsigned u2 __attribute__((ext_vector_type(2)));
    f32x4 o[16];
#pragma unroll
    for (int dt = 0; dt < 16; ++dt) { o[dt] = (f32x4){0.f, 0.f, 0.f, 0.f}; const bf16* vp = VT + (size_t)(16 * dt + q) * 256 + 4 * g;
#pragma unroll
        for (int s = 0; s < 8; ++s) { const u2 lo = *(const GAS u2*)(vp + 32 * s), hi = *(const GAS u2*)(vp + 32 * s + 16); v4u w; w.x = lo.x; w.y = lo.y; w.z = hi.x; w.w = hi.y;
            o[dt] = __builtin_amdgcn_mfma_f32_16x16x32_bf16(__builtin_bit_cast(bf16x8, w), Bp[s], o[dt], 0, 0, 0); } }
    if (q < nvalid) {
#pragma unroll
        for (int dt = 0; dt < 16; ++dt) { u2 w; w.x = pk2(o[dt][0] * inv, o[dt][1] * inv); w.y = pk2(o[dt][2] * inv, o[dt][3] * inv); *(GAS u2*)(Oo + (size_t)q * ldo + 16 * dt + 4 * g) = w; } }
}
__device__ __forceinline__ void mem_img_dma(LAS unsigned char* img, const bf16* src, int w, int lane) {
#pragma unroll
    for (int i = 0; i < 16; ++i) { const int blk = w * 16 + i, P = blk * 64 + lane, row = P >> 5, c = (P & 31) ^ (row & 15);
        __builtin_amdgcn_global_load_lds((const unsigned*)(src + (size_t)row * 256 + c * 8), (LAS unsigned*)(img + blk * 1024), 16, 0, 0); }
}
__device__ __forceinline__ void mem_attend_wg(Frame F, int layer, const bf16* Usrc, int ldu, int qoff, bf16* Odst, int ldo, int ooff) { PHASE_LOCAL(F);
    LAS unsigned char* img = F.lds + RING_OFF;
    const float* gq = F.a->in[I_QNM] + layer * 256;
    const int w = F.wave;
    typedef unsigned u2 __attribute__((ext_vector_type(2)));
    __syncthreads();
    for (int unit = (int)blockIdx.x; unit < 256 + 32; unit += F.G) {
        const int lane = opaque_v(F.lane), q = lane & 15, g = lane >> 4;
        const bool isS = unit >= 256; int row0, qrow, nvalid, h; const bf16* Kg; const bf16* VTg;
        if (!isS) { const int bh = unit >> 4, qb = unit & 15, b = bh >> 2; h = bh & 3; row0 = b * SEQ + qb * 128 + 16 * w; qrow = q; nvalid = 16; const size_t kv = (size_t)((layer * 4 + b) * 4 + h) * 65536; Kg = WSP(bf16, WS_KP) + kv; VTg = WSP(bf16, WS_VTP) + kv; }
        else { const int st = unit - 256, b = st >> 2; h = st & 3; row0 = MP + b * 8; qrow = q & 7; nvalid = w == 0 ? 8 : 0; const size_t kv = (size_t)((layer * 8 + b) * 4 + h) * 65536; Kg = WSP(bf16, WS_KS) + kv; VTg = WSP(bf16, WS_VTS) + kv; }
        const bool active = nvalid > 0;
        mem_img_dma(img, Kg, w, lane);
        bf16x8 Bq[8];
        { const bf16* qp = Usrc + (size_t)(row0 + qrow) * ldu + qoff + h * 256 + 8 * g; float ss = 0.f; v4u raw[8];
#pragma unroll
          for (int s = 0; s < 8; ++s) { raw[s] = *(const GAS v4u*)(qp + 32 * s); const unsigned ww[4] = {raw[s].x, raw[s].y, raw[s].z, raw[s].w};
#pragma unroll
              for (int j = 0; j < 4; ++j) { const float lo = __builtin_bit_cast(float, ww[j] << 16), hi = __builtin_bit_cast(float, ww[j] & 0xffff0000u); ss += lo * lo + hi * hi; } }
          ss += __shfl_xor(ss, 16); ss += __shfl_xor(ss, 32);
          const float sc = (1.0f / sqrtf(ss * (1.0f / 256.0f) + RMS_EPS)) * (0.0625f * LOG2E);
          const int goff = 8 * g;
#pragma unroll
          for (int s = 0; s < 8; ++s) { const f32x4 g0 = *(const GAS f32x4*)(gq + 32 * s + goff) * sc, g1 = *(const GAS f32x4*)(gq + 32 * s + goff + 4) * sc; const unsigned ww[4] = {raw[s].x, raw[s].y, raw[s].z, raw[s].w};
              float lo[4], hi[4];
#pragma unroll
              for (int j = 0; j < 4; ++j) { lo[j] = __builtin_bit_cast(float, ww[j] << 16); hi[j] = __builtin_bit_cast(float, ww[j] & 0xffff0000u); }
              v4u o; o.x = pk2(lo[0] * g0.x, hi[0] * g0.y); o.y = pk2(lo[1] * g0.z, hi[1] * g0.w); o.z = pk2(lo[2] * g1.x, hi[2] * g1.y); o.w = pk2(lo[3] * g1.z, hi[3] * g1.w);
              Bq[s] = __builtin_bit_cast(bf16x8, o); } }
        asm volatile("s_waitcnt vmcnt(0)" ::: "memory"); __syncthreads();
        bf16x8 Bp[8]; float inv = 0.f;
        if (active) { f32x4 sT[16];
#pragma unroll
            for (int kt = 0; kt < 16; ++kt) { f32x4 acc = (f32x4){0.f, 0.f, 0.f, 0.f}; const LAS unsigned char* kr = img + (16 * kt + q) * 512;
#pragma unroll
                for (int s = 0; s < 8; ++s) { const bf16x8 a = *(const LAS bf16x8*)(kr + (((4 * s + g) ^ q) << 4)); acc = __builtin_amdgcn_mfma_f32_16x16x32_bf16(a, Bq[s], acc, 0, 0, 0); }
                sT[kt] = acc; if (kt & 1) __builtin_amdgcn_sched_barrier(0); }
            float mx = -3.0e38f;
#pragma unroll
            for (int kt = 0; kt < 16; ++kt) mx = fmaxf(mx, fmaxf(fmaxf(sT[kt][0], sT[kt][1]), fmaxf(sT[kt][2], sT[kt][3])));
            mx = fmaxf(mx, __shfl_xor(mx, 16)); mx = fmaxf(mx, __shfl_xor(mx, 32));
            float l = 0.f;
#pragma unroll
            for (int kt = 0; kt < 16; ++kt) {
#pragma unroll
                for (int i = 0; i < 4; ++i) { const float p = __builtin_amdgcn_exp2f(sT[kt][i] - mx); sT[kt][i] = p; l += p; } }
            l += __shfl_xor(l, 16); l += __shfl_xor(l, 32); inv = 1.0f / l;
#pragma unroll
            for (int s = 0; s < 8; ++s) { v4u ww; ww.x = pk2(sT[2 * s][0], sT[2 * s][1]); ww.y = pk2(sT[2 * s][2], sT[2 * s][3]); ww.z = pk2(sT[2 * s + 1][0], sT[2 * s + 1][1]); ww.w = pk2(sT[2 * s + 1][2], sT[2 * s + 1][3]);
                Bp[s] = __builtin_bit_cast(bf16x8, ww); } }
        __syncthreads();
        mem_img_dma(img, VTg, w, lane);
        asm volatile("s_waitcnt vmcnt(0)" ::: "memory"); __syncthreads();
        if (active) { bf16* Oo = Odst + (size_t)row0 * ldo + ooff + h * 256;
#pragma unroll 2
            for (int dt = 0; dt < 16; ++dt) { f32x4 o = (f32x4){0.f, 0.f, 0.f, 0.f}; const LAS unsigned char* vr = img + (16 * dt + q) * 512 + 8 * (g & 1);
#pragma unroll
                for (int s = 0; s < 8; ++s) { const int c0 = 4 * s + (g >> 1); const u2 lo = *(const LAS u2*)(vr + ((c0 ^ q) << 4)), hi = *(const LAS u2*)(vr + (((c0 + 2) ^ q) << 4)); v4u ww; ww.x = lo.x; ww.y = lo.y; ww.z = hi.x; ww.w = hi.y;
                    o = __builtin_amdgcn_mfma_f32_16x16x32_bf16(__builtin_bit_cast(bf16x8, ww), Bp[s], o, 0, 0, 0); }
                if (q < nvalid) { u2 ww; ww.x = pk2(o[0] * inv, o[1] * inv); ww.y = pk2(o[2] * inv, o[3] * inv); *(GAS u2*)(Oo + (size_t)q * ldo + 16 * dt + 4 * g) = ww; }
                __builtin_amdgcn_sched_barrier(0); } }
        __syncthreads();
    }
}
__device__ __forceinline__ void mem_attend_phase(Frame F, int layer, const bf16* Usrc, int ldu, int qoff, bf16* Odst, int ldo, int ooff) { PHASE_LOCAL(F);
    const float* gq = F.a->in[I_QNM] + layer * 256;
    const int NT = (MP / 16) * 4 + NBS * 4;
    for (int task = F.gw; task < NT; task += F.NGW) {
        if (task < (MP / 16) * 4) { const int rt = task >> 2, h = task & 3, row0 = rt * 16, b = row0 >> 11; const size_t kv = (size_t)((layer * 4 + b) * 4 + h) * 65536;
            mem_attend_task(Usrc + (size_t)row0 * ldu + qoff + h * 256, ldu, 15, 16, gq, WSP(bf16, WS_KP) + kv, WSP(bf16, WS_VTP) + kv, Odst + (size_t)row0 * ldo + ooff + h * 256, ldo, F.lane);
        } else { const int st = task - (MP / 16) * 4, b = st >> 2, h = st & 3, row0 = MP + b * 8; const size_t kv = (size_t)((layer * 8 + b) * 4 + h) * 65536;
            mem_attend_task(Usrc + (size_t)row0 * ldu + qoff + h * 256, ldu, 7, 8, gq, WSP(bf16, WS_KS) + kv, WSP(bf16, WS_VTS) + kv, Odst + (size_t)row0 * ldo + ooff + h * 256, ldo, F.lane); }
    }
}
struct SkEpi { bf16* O; int ldo; const float* ss; const float* bias; float* scanS; int slot; const float* base; float* Y; bf16* XA; float* SSo; int base16, wy, feed; };
template <int MODE> __device__ __forceinline__ void skinny_gemm(Frame F, const bf16* A, const bf16* Bt, int K, int nunits, int rot, const SkEpi e, gu32* qc = nullptr, int LDB = 0) { PHASE_LOCAL(F);
    K = opaque_s(K); LDB = opaque_s(LDB ? LDB : K);
    const int w = F.wave, q = F.lane & 15, g = F.lane >> 4, tid = w * 64 + F.lane;
    LAS float* part = (LAS float*)(F.lds + RING_OFF); LAS float* rsl = (LAS float*)(F.lds + RING_BYTES + 1024);
    int first = (int)blockIdx.x - (rot % F.G); if (first < 0) first += F.G;
    volatile LAS unsigned* qslot = (volatile LAS unsigned*)(F.lds + RING_BYTES + 1024 + 512);
    if (qc) { if (tid == 0) qslot[0] = __hip_atomic_fetch_add(qc, 1u, RLX_AGENT); __syncthreads(); first = (int)__builtin_amdgcn_readfirstlane(qslot[0]); }
    for (int unit = first; unit < nunits; ) {
        if ((MODE == 0 || MODE == 5) && w == 0) { const GAS f32x4* sp = (const GAS f32x4*)(e.ss + (size_t)(MP + F.lane) * 64); float s = 0.f;
#pragma unroll
            for (int i = 0; i < 16; ++i) { const f32x4 x = sp[i]; s += (x.x + x.y) + (x.z + x.w); }
            rsl[F.lane] = 1.0f / sqrtf(s * (1.0f / 4096.0f) + RMS_EPS); }
        f32x4 acc[4][4];
#pragma unroll
        for (int rt = 0; rt < 4; ++rt)
#pragma unroll
            for (int ct = 0; ct < 4; ++ct) acc[rt][ct] = (f32x4){0.f, 0.f, 0.f, 0.f};
        const bf16* ap = A + (size_t)q * K + (MODE == 5 ? 8 : 16) * g;
        const bf16* bp[4];
#pragma unroll
        for (int ct = 0; ct < 4; ++ct) { int br;
            if (MODE == 5) { const int j0 = 32 * unit; br = 256 * (j0 >> 7) + (j0 & 127) + (ct >> 1) * 128 + (ct & 1) * 16; } else br = 64 * unit + 16 * ct;
            bp[ct] = Bt + (size_t)(br + q) * LDB + (MODE == 5 ? 8 : 16) * g; }
        if constexpr (MODE == 5) {
            bf16x8 a[3][4], b[4][4];
            const bf16* pa[4]; const bf16* pb[4];
#pragma unroll
            for (int rt = 0; rt < 4; ++rt) pa[rt] = ap + (size_t)(16 * rt) * K + 64 * w;
#pragma unroll
            for (int ct = 0; ct < 4; ++ct) pb[ct] = bp[ct] + 64 * w;
#define SK_LA(buf, dj) do { _Pragma("unroll") for (int rt = 0; rt < 4; ++rt) a[buf][rt] = *(const GAS bf16x8*)(pa[rt] + 512 * ((dj) >> 1) + 32 * ((dj) & 1)); } while (0)
#define SK_LB(buf, dj) do { _Pragma("unroll") for (int ct = 0; ct < 4; ++ct) b[buf][ct] = *(const GAS bf16x8*)(pb[ct] + 512 * ((dj) >> 1) + 32 * ((dj) & 1)); } while (0)
#define SK_MM(j) do { _Pragma("unroll") for (int rt = 0; rt < 4; ++rt) _Pragma("unroll") for (int ct = 0; ct < 4; ++ct) \
            acc[rt][ct] = __builtin_amdgcn_mfma_f32_16x16x32_bf16(b[(j) % 4][ct], a[(j) % 3][rt], acc[rt][ct], 0, 0, 0); } while (0)
            SK_LB(0, 0); SK_LA(0, 0); SK_LB(1, 1); SK_LA(1, 1); SK_LB(2, 2);
            __builtin_amdgcn_sched_barrier(0);
#pragma unroll
            for (int i = 0; i < 8; ++i) { const int j = 2 * i;
                if (j + 2 < 16) SK_LA((j + 2) % 3, 2);
                if (j + 3 < 16) SK_LB((j + 3) % 4, 3);
                __builtin_amdgcn_sched_barrier(0);
                SK_MM(j);
                __builtin_amdgcn_sched_barrier(0);
                if (j + 3 < 16) SK_LA((j + 3) % 3, 3);
                if (j + 4 < 16) SK_LB((j + 4) % 4, 4);
                __builtin_amdgcn_sched_barrier(0);
                SK_MM(j + 1);
                __builtin_amdgcn_sched_barrier(0);
#pragma unroll
                for (int rt = 0; rt < 4; ++rt) { pa[rt] += 512; asm volatile("" : "+v"(pa[rt])); }
#pragma unroll
                for (int ct = 0; ct < 4; ++ct) { pb[ct] += 512; asm volatile("" : "+v"(pb[ct])); }
            }
#undef SK_LA
#undef SK_LB
#undef SK_MM
        } else {
        const int KC = K >> 6;
        bf16x8 a[2][4][2], b[2][4][2];
#define SK_LOAD(buf, s) do { _Pragma("unroll") for (int rt = 0; rt < 4; ++rt) { const bf16* p_ = ap + (size_t)(16 * rt) * K + 64 * (s); a[buf][rt][0] = *(const GAS bf16x8*)p_; a[buf][rt][1] = *(const GAS bf16x8*)(p_ + 8); } \
        _Pragma("unroll") for (int ct = 0; ct < 4; ++ct) { const bf16* p_ = bp[ct] + 64 * (s); b[buf][ct][0] = *(const GAS bf16x8*)p_; b[buf][ct][1] = *(const GAS bf16x8*)(p_ + 8); } } while (0)
#define SK_MMA(buf) do { _Pragma("unroll") for (int h = 0; h < 2; ++h) _Pragma("unroll") for (int rt = 0; rt < 4; ++rt) _Pragma("unroll") for (int ct = 0; ct < 4; ++ct) \
        acc[rt][ct] = __builtin_amdgcn_mfma_f32_16x16x32_bf16(b[buf][ct][h], a[buf][rt][h], acc[rt][ct], 0, 0, 0); } while (0)
        int s = w;
        if (s < KC) { SK_LOAD(0, s);
            for (; s < KC; s += 16) {
                { const int s1 = s + 8 < KC ? s + 8 : s; SK_LOAD(1, s1); }
                __builtin_amdgcn_sched_barrier(0);
                SK_MMA(0);
                __builtin_amdgcn_sched_barrier(0);
                { const int s2 = s + 16 < KC ? s + 16 : s; SK_LOAD(0, s2); }
                __builtin_amdgcn_sched_barrier(0);
                if (s + 8 < KC) SK_MMA(1);
                __builtin_amdgcn_sched_barrier(0);
            } }
#undef SK_LOAD
#undef SK_MMA
        }
#pragma unroll
        for (int rt = 0; rt < 4; ++rt)
#pragma unroll
            for (int ct = 0; ct < 4; ++ct) *(LAS f32x4*)(part + w * 4096 + (16 * rt + q) * 64 + (((4 * ct + g) ^ q) << 2)) = acc[rt][ct];
        __syncthreads();
        if (MODE == 5) { const int m = tid >> 3, c4 = tid & 7; f32x4 gv = (f32x4){0.f, 0.f, 0.f, 0.f}, uv = gv;
#pragma unroll
            for (int ww = 0; ww < 8; ++ww) { gv += *(const LAS f32x4*)(part + ww * 4096 + m * 64 + ((c4 ^ (m & 15)) << 2)); uv += *(const LAS f32x4*)(part + ww * 4096 + m * 64 + (((c4 + 8) ^ (m & 15)) << 2)); }
            const float sc = rsl[m]; gv = gv * sc; uv = uv * sc;
            u32x2 o; o.x = pk2(pg8::silu_mul(gv.x, uv.x), pg8::silu_mul(gv.y, uv.y)); o.y = pk2(pg8::silu_mul(gv.z, uv.z), pg8::silu_mul(gv.w, uv.w));
            *(GAS u32x2*)(e.O + (size_t)(MP + m) * e.ldo + 32 * unit + 4 * c4) = o;
        } else {
#pragma unroll
            for (int it = 0; it < 2; ++it) { const int i = tid + 512 * it, m = i >> 4, c4 = i & 15, col = 64 * unit + 4 * c4; f32x4 v = (f32x4){0.f, 0.f, 0.f, 0.f};
#pragma unroll
                for (int ww = 0; ww < 8; ++ww) v += *(const LAS f32x4*)(part + ww * 4096 + m * 64 + ((c4 ^ (m & 15)) << 2));
                if (MODE == 0 || MODE == 1) { if (MODE == 0) v = v * rsl[m]; u32x2 o; o.x = pk2(v.x, v.y); o.y = pk2(v.z, v.w); *(GAS u32x2*)(e.O + (size_t)(MP + m) * e.ldo + col) = o; }
                else if (MODE == 2 || MODE == 3) { const f32x4 x = v + *(const GAS f32x4*)(e.bias + col); f32x4 o;
#pragma unroll
                    for (int j = 0; j < 4; ++j) o[j] = MODE == 2 ? pg8::decay_fn(x[j]) : __builtin_amdgcn_rcpf(1.0f + __builtin_amdgcn_exp2f(-LOG2E * x[j]));
                    *(GAS f32x4*)(e.scanS + (((size_t)((m >> 3) * AH + (col >> 6)) * DSEQ + (m & 7)) * 6 + e.slot) * 64 + (col & 63)) = o; }
                else { const f32x4 y = *(const GAS f32x4*)(e.base + (size_t)m * D + col) + v; *(GAS f32x4*)(e.Y + (size_t)m * D + col) = y;
                    u32x2 o; o.x = pk2(y.x, y.y); o.y = pk2(y.z, y.w); *(GAS u32x2*)(e.XA + (size_t)(MP + m) * D + col) = o;
                    const float qs = sum16((y.x * y.x + y.y * y.y) + (y.z * y.z + y.w * y.w)); if (c4 == 0) e.SSo[(size_t)(MP + m) * 64 + unit] = qs; }
            }
        }
        __syncthreads();
        if (qc) { if (tid == 0) qslot[0] = __hip_atomic_fetch_add(qc, 1u, RLX_AGENT); __syncthreads(); unit = (int)__builtin_amdgcn_readfirstlane(qslot[0]); } else unit += F.G;
    }
}

constexpr int CW_SPLITK = 65536;
__device__ __forceinline__ void skinny_res_splitk(Frame F, const bf16* A, const bf16* Bt, int K, int cset, const SkEpi e, int LD = 0) { PHASE_LOCAL(F);
    K = opaque_s(K); LD = opaque_s(LD ? LD : K);
    const int w = F.wave, q = F.lane & 15, g = F.lane >> 4, tid = w * 64 + F.lane;
    LAS float* part = (LAS float*)(F.lds + RING_OFF); volatile LAS unsigned* lflag = (volatile LAS unsigned*)(F.lds + RING_BYTES + 1536);
    float* PART = (float*)(F.ws + WS_SPLITK);
    for (int task = (int)blockIdx.x; task < 256; task += F.G) { const int unit = task >> 2, kq = task & 3;
        f32x4 acc[4][4];
#pragma unroll
        for (int rt = 0; rt < 4; ++rt)
#pragma unroll
            for (int ct = 0; ct < 4; ++ct) acc[rt][ct] = (f32x4){0.f, 0.f, 0.f, 0.f};
        const bf16* ap = A + (size_t)q * LD + 16 * g;
        const bf16* bp[4];
#pragma unroll
        for (int ct = 0; ct < 4; ++ct) bp[ct] = Bt + (size_t)(64 * unit + 16 * ct + q) * LD + 16 * g;
        const int KC = K >> 6, c0 = (KC * kq) >> 2, c1 = (KC * (kq + 1)) >> 2;
        bf16x8 a[2][4][2], b[2][4][2];
#define SK_LOAD(buf, s) do { _Pragma("unroll") for (int rt = 0; rt < 4; ++rt) { const bf16* p_ = ap + (size_t)(16 * rt) * LD + 64 * (s); a[buf][rt][0] = *(const GAS bf16x8*)p_; a[buf][rt][1] = *(const GAS bf16x8*)(p_ + 8); } \
        _Pragma("unroll") for (int ct = 0; ct < 4; ++ct) { const bf16* p_ = bp[ct] + 64 * (s); b[buf][ct][0] = *(const GAS bf16x8*)p_; b[buf][ct][1] = *(const GAS bf16x8*)(p_ + 8); } } while (0)
#define SK_MMA(buf) do { _Pragma("unroll") for (int h = 0; h < 2; ++h) _Pragma("unroll") for (int rt = 0; rt < 4; ++rt) _Pragma("unroll") for (int ct = 0; ct < 4; ++ct) \
        acc[rt][ct] = __builtin_amdgcn_mfma_f32_16x16x32_bf16(b[buf][ct][h], a[buf][rt][h], acc[rt][ct], 0, 0, 0); } while (0)
        int s = c0 + w;
        if (s < c1) { SK_LOAD(0, s);
            for (; s < c1; s += 16) {
                { const int s1 = s + 8 < c1 ? s + 8 : s; SK_LOAD(1, s1); }
                __builtin_amdgcn_sched_barrier(0);
                SK_MMA(0);
                __builtin_amdgcn_sched_barrier(0);
                { const int s2 = s + 16 < c1 ? s + 16 : s; SK_LOAD(0, s2); }
                __builtin_amdgcn_sched_barrier(0);
                if (s + 8 < c1) SK_MMA(1);
                __builtin_amdgcn_sched_barrier(0);
            } }
#undef SK_LOAD
#undef SK_MMA
#pragma unroll
        for (int rt = 0; rt < 4; ++rt)
#pragma unroll
            for (int ct = 0; ct < 4; ++ct) *(LAS f32x4*)(part + w * 4096 + (16 * rt + q) * 64 + (((4 * ct + g) ^ q) << 2)) = acc[rt][ct];
        __syncthreads();
        gu64* slab = (gu64*)(PART + ((size_t)unit * 4 + kq) * 4096);
#pragma unroll
        for (int it = 0; it < 2; ++it) { const int i = tid + 512 * it, m = i >> 4, c4 = i & 15; f32x4 v = (f32x4){0.f, 0.f, 0.f, 0.f};
#pragma unroll
            for (int ww = 0; ww < 8; ++ww) v += *(const LAS f32x4*)(part + ww * 4096 + m * 64 + ((c4 ^ (m & 15)) << 2));
            const float vx = v.x, vy = v.y, vz = v.z, vw = v.w;
            __hip_atomic_store(slab + 2 * i, ((unsigned long long)__builtin_bit_cast(unsigned, vy) << 32) | __builtin_bit_cast(unsigned, vx), RLX_AGENT);
            __hip_atomic_store(slab + 2 * i + 1, ((unsigned long long)__builtin_bit_cast(unsigned, vw) << 32) | __builtin_bit_cast(unsigned, vz), RLX_AGENT); }
        asm volatile("s_waitcnt vmcnt(0)" ::: "memory");
        __syncthreads();
        if (tid == 0) { const unsigned old = __hip_atomic_fetch_add(F.ctl + CW_SPLITK + (cset * 64 + unit) * 64, 1u, RLX_AGENT); lflag[0] = old; }
        __syncthreads();
        if (lflag[0] == 3u) {
            __builtin_amdgcn_fence(__ATOMIC_ACQUIRE, "agent");
            const gu64* sl = (const gu64*)(PART + (size_t)unit * 4 * 4096);
#pragma unroll
            for (int it = 0; it < 2; ++it) { const int i = tid + 512 * it, m = i >> 4, c4 = i & 15, col = 64 * unit + 4 * c4; f32x4 v = (f32x4){0.f, 0.f, 0.f, 0.f};
#pragma unroll
                for (int kk = 0; kk < 4; ++kk) { const unsigned long long lo = __hip_atomic_load(sl + (size_t)kk * 2048 + 2 * i, RLX_AGENT), hi = __hip_atomic_load(sl + (size_t)kk * 2048 + 2 * i + 1, RLX_AGENT);
                    v += (f32x4){__builtin_bit_cast(float, (unsigned)lo), __builtin_bit_cast(float, (unsigned)(lo >> 32)), __builtin_bit_cast(float, (unsigned)hi), __builtin_bit_cast(float, (unsigned)(hi >> 32))}; }
                f32x4 bs; if (e.base16) { const u32x2 bw = *(const GAS u32x2*)(e.XA + (size_t)(MP + m) * D + col); bs = bf4_to_f32(bw.x, bw.y); } else bs = *(const GAS f32x4*)(e.base + (size_t)m * D + col);
                const f32x4 y = bs + v; if (e.wy) *(GAS f32x4*)(e.Y + (size_t)m * D + col) = y;
                const float qs = sum16((y.x * y.x + y.y * y.y) + (y.z * y.z + y.w * y.w));
                if (e.feed) { u32x2 o; o.x = pk2(y.x, y.y); o.y = pk2(y.z, y.w); *(GAS u32x2*)(e.XA + (size_t)(MP + m) * D + col) = o; if (c4 == 0) e.SSo[(size_t)(MP + m) * 64 + unit] = qs; } }
        }
        __syncthreads();
    }
}
constexpr size_t GRP_ELEMS = (size_t)NBP * 8 * SEQ * 128;
__device__ __forceinline__ float sum32(float x) { x = sum16(x); return x + __shfl_xor(x, 16); }
__device__ __forceinline__ void p10_qkv_post(Frame F) { PHASE_LOCAL(F);
    const int d = 4 * (F.lane & 31);
    const f32x4 gq = *(const GAS f32x4*)(F.a->in[I_QNB] + d), gk = *(const GAS f32x4*)(F.a->in[I_KNB] + d);
    const float qscale = 0.08838834764831845f * LOG2E;
    for (int un = F.gw; un < M * 2; un += F.NGW) { const int row = un >> 1, itb = (un & 1) * 6;
        const bf16* u = WSP(bf16, WS_U) + (size_t)row * NB; const bool isP = row < MP;
        const int b = isP ? row >> 11 : (row - MP) >> 3, t = isP ? row & (SEQ - 1) : (row - MP) & (DSEQ - 1);
        for (int it0 = itb; it0 < itb + 6; it0 += 6) { u32x2 qw[6], kw[6], vw[6];
#pragma unroll
            for (int j = 0; j < 6; ++j) { const int c = 256 * (it0 + j) + 4 * F.lane; qw[j] = *(const GAS u32x2*)(u + c); kw[j] = *(const GAS u32x2*)(u + MIXW + c); vw[j] = *(const GAS u32x2*)(u + 2 * MIXW + c); }
#pragma unroll
            for (int j = 0; j < 6; ++j) { const int it = it0 + j; const int H = 2 * it + (F.lane >> 5), g = H >> 3, h = H & 7, dsh = 2 * g, dil = 1 << dsh, sub = SEQ >> dsh, win = 128 << dsh;
            const f32x4 q = bf4_to_f32(qw[j].x, qw[j].y), k = bf4_to_f32(kw[j].x, kw[j].y), v = bf4_to_f32(vw[j].x, vw[j].y);
            const float rq = 1.0f / sqrtf(sum32((q.x * q.x + q.y * q.y) + (q.z * q.z + q.w * q.w)) * (1.0f / 128.0f) + RMS_EPS), rk = 1.0f / sqrtf(sum32((k.x * k.x + k.y * k.y) + (k.z * k.z + k.w * k.w)) * (1.0f / 128.0f) + RMS_EPS);
            const f32x4 qn = q * rq * gq, kn = k * rk * gk;
            float* ob;
            if (isP) { const int r = t & (dil - 1), jj = t >> dsh; const size_t seq = (size_t)((b * 8 + h) * dil + r);
                u32x2 o; o.x = pk2(qn.x * qscale, qn.y * qscale); o.y = pk2(qn.z * qscale, qn.w * qscale); *(GAS u32x2*)(WSP(bf16, WS_QN) + g * GRP_ELEMS + (seq * sub + jj) * 128 + d) = o;
                o.x = pk2(kn.x, kn.y); o.y = pk2(kn.z, kn.w); *(GAS u32x2*)(WSP(bf16, WS_KN) + g * GRP_ELEMS + (seq * sub + jj) * 128 + d) = o;
                *(GAS u32x2*)(WSP(bf16, WS_VT) + g * GRP_ELEMS + (seq * sub + jj) * 128 + d) = vw[j];
                const int keep = win < SEQ ? win : SEQ;
                ob = t >= SEQ - keep ? F.out + (g == 0 ? OUT_SWAP1 : (g == 1 ? OUT_SWAP2 : OUT_SWAP3)) + ((size_t)(b * keep + (t - (SEQ - keep))) * 2) * 1024 + h * 128 + d : nullptr;
            } else { *(GAS f32x4*)(WSP(float, WS_QS) + ((size_t)(row - MP) * 24 + H) * 128 + d) = qn * qscale;
                ob = F.out + (g == 0 ? OUT_SWAS1 : (g == 1 ? OUT_SWAS2 : OUT_SWAS3)) + ((size_t)(b * win + (win - DSEQ + t)) * 2) * 1024 + h * 128 + d; }
            if (ob) { *(GAS f32x4*)ob = kn; *(GAS f32x4*)(ob + 1024) = v; }
            } }
    }
}
__device__ __forceinline__ void band_attn_task(const bf16* QNs, const bf16* KNs, const bf16* VTs, int sub, int i0, bf16* OGrow0, size_t ogstride, float* LSErow0, size_t lsestride, int lane) {
    const int q = lane & 15, g = lane >> 4, ks = i0 - 144;
    bf16x8 Bq[4];
#pragma unroll
    for (int s = 0; s < 4; ++s) Bq[s] = *(const GAS bf16x8*)(QNs + (size_t)(i0 + q) * 128 + 32 * s + 8 * g);
    f32x4 sT[10]; float mx = -3.0e38f;
#pragma unroll
    for (int kt = 0; kt < 10; ++kt) { f32x4 acc = (f32x4){0.f, 0.f, 0.f, 0.f}; int kr = ks + 16 * kt + q; kr = kr < 0 ? 0 : kr; const bf16* kp = KNs + (size_t)kr * 128 + 8 * g;
#pragma unroll
        for (int s = 0; s < 4; ++s) { const bf16x8 a = *(const GAS bf16x8*)(kp + 32 * s); acc = __builtin_amdgcn_mfma_f32_16x16x32_bf16(a, Bq[s], acc, 0, 0, 0); }
#pragma unroll
        for (int i = 0; i < 4; ++i) { const int kpos = ks + 16 * kt + 4 * g + i, dist = (i0 + q) - kpos; const bool ok = kpos >= 0 && dist >= 0 && dist <= 128; acc[i] = ok ? acc[i] : -1.0e30f; mx = fmaxf(mx, acc[i]); }
        sT[kt] = acc; }
    mx = fmaxf(mx, __shfl_xor(mx, 16)); mx = fmaxf(mx, __shfl_xor(mx, 32));
    float l = 0.f;
#pragma unroll
    for (int kt = 0; kt < 10; ++kt) {
#pragma unroll
        for (int i = 0; i < 4; ++i) { const float p = __builtin_amdgcn_exp2f(sT[kt][i] - mx); sT[kt][i] = p; l += p; } }
    l += __shfl_xor(l, 16); l += __shfl_xor(l, 32);
    const float inv = 1.0f / l;
    bf16x8 Bp[5];
#pragma unroll
    for (int s = 0; s < 5; ++s) { v4u w; w.x = pk2(sT[2 * s][0], sT[2 * s][1]); w.y = pk2(sT[2 * s][2], sT[2 * s][3]); w.z = pk2(sT[2 * s + 1][0], sT[2 * s + 1][1]); w.w = pk2(sT[2 * s + 1][2], sT[2 * s + 1][3]);
        Bp[s] = __builtin_bit_cast(bf16x8, w); }
    typedef unsigned u2 __attribute__((ext_vector_type(2)));
    f32x4 o[8];
#pragma unroll
    for (int dt = 0; dt < 8; ++dt) { o[dt] = (f32x4){0.f, 0.f, 0.f, 0.f}; const bf16* vp = VTs + (size_t)(16 * dt + q) * sub;
#pragma unroll
        for (int s = 0; s < 5; ++s) { int c0 = ks + 32 * s + 4 * g, c1 = c0 + 16; c0 = c0 < 0 ? 0 : c0; c1 = c1 < 0 ? 0 : c1;
            const u2 lo = *(const GAS u2*)(vp + c0), hi = *(const GAS u2*)(vp + c1); v4u w; w.x = lo.x; w.y = lo.y; w.z = hi.x; w.w = hi.y;
            o[dt] = __builtin_amdgcn_mfma_f32_16x16x32_bf16(__builtin_bit_cast(bf16x8, w), Bp[s], o[dt], 0, 0, 0); } }
#pragma unroll
    for (int dt = 0; dt < 8; ++dt) { u2 w; w.x = pk2(o[dt][0] * inv, o[dt][1] * inv); w.y = pk2(o[dt][2] * inv, o[dt][3] * inv);
        *(GAS u2*)(OGrow0 + (size_t)q * ogstride + 16 * dt + 4 * g) = w; }
    if (g == 0) LSErow0[(size_t)q * lsestride] = (mx + __builtin_amdgcn_logf(l)) * LN2;
}
__device__ __forceinline__ void band_attn_wg(Frame F) { PHASE_LOCAL(F);
    LAS unsigned char* kimg = F.lds + RING_OFF; LAS unsigned char* vimg = F.lds + RING_OFF + 65536;
    const int w = F.wave;
    typedef unsigned u2 __attribute__((ext_vector_type(2))); typedef short v4i16 __attribute__((ext_vector_type(4)));
    __syncthreads();
    for (int unit = (int)blockIdx.x; unit < 1536; unit += F.G) {
        const int lane = opaque_v(F.lane), q = lane & 15, g = lane >> 4;
        const int grp = unit >> 9, uu = unit & 511, dsh = 2 * grp, dil = 1 << dsh, sub = SEQ >> dsh, ups = sub >> 7;
        const int seq = uu / ups, i0 = (uu % ups) * 128, ks0 = i0 - 128, r = seq & (dil - 1), bh = seq >> dsh, b = bh >> 3, h = bh & 7;
        const bf16* QNs = WSP(bf16, WS_QN) + grp * GRP_ELEMS + (size_t)seq * sub * 128; const bf16* KNs = WSP(bf16, WS_KN) + grp * GRP_ELEMS + (size_t)seq * sub * 128;
        const bf16* VNs = WSP(bf16, WS_VT) + grp * GRP_ELEMS + (size_t)seq * sub * 128;
#pragma unroll
        for (int i = 0; i < 8; ++i) { const int blk = w * 8 + i, P = blk * 64 + lane, row = P >> 4, c = (P & 15) ^ (row & 15); int kr = ks0 + row; kr = kr < 0 ? 0 : kr;
            __builtin_amdgcn_global_load_lds((const unsigned*)(KNs + (size_t)kr * 128 + c * 8), (LAS unsigned*)(kimg + blk * 1024), 16, 0, 0); }
        bf16x8 Bq[4];
#pragma unroll
        for (int s = 0; s < 4; ++s) Bq[s] = *(const GAS bf16x8*)(QNs + (size_t)(i0 + 16 * w + q) * 128 + 32 * s + 8 * g);
#pragma unroll
        for (int i = 0; i < 8; ++i) { const int blk = w * 8 + i, P = blk * 64 + lane, row = P >> 4, c = (P & 15) ^ (row & 15); int kr = ks0 + row; kr = kr < 0 ? 0 : kr;
            __builtin_amdgcn_global_load_lds((const unsigned*)(VNs + (size_t)kr * 128 + c * 8), (LAS unsigned*)(vimg + blk * 1024), 16, 0, 0); }
        asm volatile("s_waitcnt vmcnt(8)" ::: "memory"); __syncthreads();
        const int ts = w & ~1, qpos = i0 + 16 * w + q;
        f32x4 sT[10]; float mx = -3.0e38f;
#pragma unroll
        for (int t = 0; t < 10; ++t) { f32x4 acc = (f32x4){0.f, 0.f, 0.f, 0.f}; const LAS unsigned char* kr = kimg + (16 * (ts + t) + q) * 256;
#pragma unroll
            for (int s = 0; s < 4; ++s) { const bf16x8 a = *(const LAS bf16x8*)(kr + (((4 * s + g) ^ q) << 4)); acc = __builtin_amdgcn_mfma_f32_16x16x32_bf16(a, Bq[s], acc, 0, 0, 0); }
#pragma unroll
            for (int i = 0; i < 4; ++i) { const int kpos = ks0 + 16 * (ts + t) + 4 * g + i, dist = qpos - kpos; const bool ok = kpos >= 0 && dist >= 0 && dist <= 128; acc[i] = ok ? acc[i] : -1.0e30f; mx = fmaxf(mx, acc[i]); }
            sT[t] = acc; }
        mx = fmaxf(mx, __shfl_xor(mx, 16)); mx = fmaxf(mx, __shfl_xor(mx, 32));
        float l = 0.f;
#pragma unroll
        for (int t = 0; t < 10; ++t) {
#pragma unroll
            for (int i = 0; i < 4; ++i) { const float p = __builtin_amdgcn_exp2f(sT[t][i] - mx); sT[t][i] = p; l += p; } }
        l += __shfl_xor(l, 16); l += __shfl_xor(l, 32);
        const float inv = 1.0f / l;
        bf16x8 Bp[5];
#pragma unroll
        for (int s = 0; s < 5; ++s) { v4u ww; ww.x = pk2(sT[2 * s][0], sT[2 * s][1]); ww.y = pk2(sT[2 * s][2], sT[2 * s][3]); ww.z = pk2(sT[2 * s + 1][0], sT[2 * s + 1][1]); ww.w = pk2(sT[2 * s + 1][2], sT[2 * s + 1][3]);
            Bp[s] = __builtin_bit_cast(bf16x8, ww); }
        asm volatile("s_waitcnt vmcnt(0)" ::: "memory"); __syncthreads();
        const size_t row0 = (size_t)b * SEQ + r + (size_t)dil * (i0 + 16 * w);
        bf16* OGrow = WSP(bf16, WS_OG) + ((size_t)grp * MP + row0 + (size_t)dil * q) * 1024 + h * 128;
        const int trow = 4 * g + (q >> 2), tp = q & 3;
#pragma unroll 2
        for (int dt = 0; dt < 8; ++dt) { f32x4 o = (f32x4){0.f, 0.f, 0.f, 0.f};
#pragma unroll
            for (int s = 0; s < 5; ++s) { const int row = 16 * (ts + 2 * s) + trow; const LAS unsigned char* va = vimg + row * 256 + (((2 * dt + (tp >> 1)) ^ (row & 15)) << 4) + 8 * (tp & 1);
                const v4i16 lo = __builtin_amdgcn_ds_read_tr16_b64_v4i16((LAS v4i16*)va), hi = __builtin_amdgcn_ds_read_tr16_b64_v4i16((LAS v4i16*)(va + 4096));
                const u2 lw = __builtin_bit_cast(u2, lo), hw = __builtin_bit_cast(u2, hi); v4u ww; ww.x = lw.x; ww.y = lw.y; ww.z = hw.x; ww.w = hw.y;
                o = __builtin_amdgcn_mfma_f32_16x16x32_bf16(__builtin_bit_cast(bf16x8, ww), Bp[s], o, 0, 0, 0); }
            u2 ww; ww.x = pk2(o[0] * inv, o[1] * inv); ww.y = pk2(o[2] * inv, o[3] * inv); *(GAS u2*)(OGrow + 16 * dt + 4 * g) = ww;
            __builtin_amdgcn_sched_barrier(0); }
        if (g == 0) WSP(float, WS_LSE)[((size_t)grp * MP + row0 + (size_t)dil * q) * 8 + h] = (mx + __builtin_amdgcn_logf(l)) * LN2;
        __syncthreads();
    }
}
__device__ __forceinline__ void band_attn_phase(Frame F) { PHASE_LOCAL(F);
    for (int task = F.gw; task < 3 * 4096; task += F.NGW) { const int g = task >> 12, tt = task & 4095, dsh = 2 * g, dil = 1 << dsh, sub = SEQ >> dsh, tps = sub >> 4;
        const int seq = tt / tps, i0 = (tt % tps) * 16, r = seq & (dil - 1), bh = seq >> dsh, b = bh >> 3, h = bh & 7;
        const size_t row0 = (size_t)b * SEQ + r + (size_t)dil * i0;
        band_attn_task(WSP(bf16, WS_QN) + g * GRP_ELEMS + (size_t)seq * sub * 128, WSP(bf16, WS_KN) + g * GRP_ELEMS + (size_t)seq * sub * 128, WSP(bf16, WS_VT) + g * GRP_ELEMS + (size_t)seq * 128 * sub, sub, i0,
                       WSP(bf16, WS_OG) + (size_t)g * MP * 1024 + row0 * 1024 + h * 128, (size_t)dil * 1024, WSP(float, WS_LSE) + ((size_t)g * MP + row0) * 8 + h, (size_t)dil * 8, F.lane); }
}
__device__ __forceinline__ void sample_attn_phase(Frame F) { PHASE_LOCAL(F);
    LAS float* qs = (LAS float*)(F.lds + RING_OFF + F.wave * 16384);
    for (int task = F.gw; task < MS * 8 * 3; task += F.NGW) { const int g = task % 3, sh = task / 3, sr = sh >> 3, h = sh & 7, b = sr >> 3, t = sr & 7;
        const int dsh = 2 * g, dil = 1 << dsh, win = 128 << dsh; const float* C = g == 0 ? F.a->in[I_C1] : (g == 1 ? F.a->in[I_C2] : F.a->in[I_C3]); const float* NO = F.out + (g == 0 ? OUT_SWAS1 : (g == 1 ? OUT_SWAS2 : OUT_SWAS3));
        { const f32x2 qv = *(const GAS f32x2*)(WSP(float, WS_QS) + ((size_t)sr * 24 + g * 8 + h) * 128 + 2 * F.lane); qs[2 * F.lane] = qv.x; qs[2 * F.lane + 1] = qv.y; }
        LDS_WAIT(); asm volatile("" ::: "memory");
        float sc[3];
#pragma unroll
        for (int jj = 0; jj < 3; ++jj) { const int j = F.lane + 64 * jj; const bool ok = j <= 128; const int idx = win + t - dil * (ok ? j : 0);
            const float* kp = idx < win ? C + ((size_t)(b * win + idx) * 2) * 1024 + h * 128 : NO + ((size_t)(b * win + idx - DSEQ) * 2) * 1024 + h * 128;
            float s = 0.f;
            if (jj < 2 || F.lane == 0) {
#pragma unroll 16
                for (int d4 = 0; d4 < 32; ++d4) { const f32x4 kv = *(const GAS f32x4*)(kp + 4 * d4); const f32x4 qv = *(const LAS f32x4*)(qs + 4 * d4); s += (kv.x * qv.x + kv.y * qv.y) + (kv.z * qv.z + kv.w * qv.w); } }
            sc[jj] = ok ? s : -1.0e30f; }
        const float m = wave_max(fmaxf(fmaxf(sc[0], sc[1]), sc[2]));
        float p[3], ps = 0.f;
#pragma unroll
        for (int jj = 0; jj < 3; ++jj) { p[jj] = __builtin_amdgcn_exp2f(sc[jj] - m); ps += p[jj]; }
        const float l = wave_sum(ps); float o0 = 0.f, o1 = 0.f;
#pragma unroll
        for (int jj = 0; jj < 3; ++jj) { const int nj = jj < 2 ? 64 : 1;
#pragma unroll 16
            for (int jl = 0; jl < nj; ++jl) { const int j = jl + 64 * jj, idx = win + t - dil * j; const float pj = __shfl(p[jj], jl);
                const float* vp = (idx < win ? C + ((size_t)(b * win + idx) * 2 + 1) * 1024 : NO + ((size_t)(b * win + idx - DSEQ) * 2 + 1) * 1024) + h * 128 + 2 * F.lane;
                const f32x2 vv = *(const GAS f32x2*)vp; o0 += pj * vv.x; o1 += pj * vv.y; } }
        const float inv = 1.0f / l;
        *(GAS unsigned*)(WSP(bf16, WS_OGS) + ((size_t)g * MS + sr) * 1024 + h * 128 + 2 * F.lane) = pk2(o0 * inv, o1 * inv);
        if (F.lane == 0) ((float*)(F.ws + WS_OGS + 512 * 1024))[((size_t)g * MS + sr) * 8 + h] = (m + __builtin_amdgcn_logf(l)) * LN2;
        asm volatile("" ::: "memory");
    }
}
__device__ __forceinline__ void merge_phase(Frame F) { PHASE_LOCAL(F);
    for (int row = F.gw; row < M; row += F.NGW) { const int h = F.lane >> 3;
        const bool isP = row < MP; const int rr = isP ? row : row - MP; const size_t gs = isP ? MP : MS;
        const float* lse = isP ? WSP(float, WS_LSE) : (const float*)(F.ws + WS_OGS + 512 * 1024); const bf16* og = isP ? WSP(bf16, WS_OG) : WSP(bf16, WS_OGS);
        const float l0 = lse[((size_t)0 * gs + rr) * 8 + h], l1 = lse[((size_t)1 * gs + rr) * 8 + h], l2 = lse[((size_t)2 * gs + rr) * 8 + h];
        const float mm = fmaxf(l0, fmaxf(l1, l2)); float w0 = expf(l0 - mm), w1 = expf(l1 - mm), w2 = expf(l2 - mm); const float is = 1.0f / (w0 + w1 + w2); w0 *= is; w1 *= is; w2 *= is;
        float acc[16];
#pragma unroll
        for (int j = 0; j < 16; ++j) acc[j] = 0.f;
#pragma unroll
        for (int g = 0; g < 3; ++g) { const float w = g == 0 ? w0 : (g == 1 ? w1 : w2); const bf16* src = og + ((size_t)g * gs + rr) * 1024 + 16 * F.lane;
#pragma unroll
            for (int c = 0; c < 2; ++c) { const v4u raw = *(const GAS v4u*)(src + 8 * c); const unsigned ww[4] = {raw.x, raw.y, raw.z, raw.w};
#pragma unroll
                for (int j = 0; j < 4; ++j) { acc[8 * c + 2 * j] += w * __builtin_bit_cast(float, ww[j] << 16); acc[8 * c + 2 * j + 1] += w * __builtin_bit_cast(float, ww[j] & 0xffff0000u); } } }
        bf16* dst = WSP(bf16, WS_O) + (size_t)row * 2048 + 16 * F.lane;
#pragma unroll
        for (int c = 0; c < 2; ++c) { v4u w; w.x = pk2(acc[8 * c], acc[8 * c + 1]); w.y = pk2(acc[8 * c + 2], acc[8 * c + 3]); w.z = pk2(acc[8 * c + 4], acc[8 * c + 5]); w.w = pk2(acc[8 * c + 6], acc[8 * c + 7]);
            *(GAS v4u*)(dst + 8 * c) = w; }
    }
}
#ifndef PH_MASK
#define PH_MASK 0xFFFF
#endif
#ifndef P3_SUB
#define P3_SUB 7
#endif
#ifndef REP_MASK
#define REP_MASK 0
#endif
#define REP(k) (((REP_MASK >> (k)) & 1) ? 2 : 1)
#ifndef P6_SK
#define P6_SK 1
#endif
#ifndef MK_STOP_AFTER
#define MK_STOP_AFTER 99
#endif
__device__ __forceinline__ int rot_c(int c, int G, int used) { int r = c - (used % G); return r < 0 ? r + G : r; }

#define RS_CACHE(F) ((LAS float*)((F).lds + RING_BYTES + 4096))
#define RS_RESET(F) do { __syncthreads(); if ((F).tid == 0) ((volatile LAS int*)RS_CACHE(F))[256] = -1; __syncthreads(); } while (0)
#define IN(k) (((PH_MASK >> (k)) & 1) && (k) <= MK_STOP_AFTER)
#define SEAM(k) do { if (IN(k) && IN((k) + 1)) xcd_barrier(bar); } while (0)
template <int layer> __device__ __forceinline__ void tail_phases(Frame F, const XcdBarrier bar) {
    const int cb = (int)blockIdx.x; LAS unsigned char* ring = F.lds + RING_OFF;
        const int pb = layer == 0 ? 6 : 13;
        if (IN(pb)) { const int K = layer == 0 ? D : 2048; const bf16* Wt = layer == 0 ? WSP(bf16, WS_WOUTA) : WSP(bf16, WS_WOUTB); float* SSo = WSP(float, WS_SS) + (size_t)(2 * layer + 1) * (SS_STRIDE / 4);
            { pg8::Gemm g{WSP(bf16, WS_O), Wt, MP, D, K}; pg8::StaticOrder S; S.init(MP, D, F.G, cb);
              typedef pg8::EpiRes<true, false, true> EpiO;
              EpiO E{F.a->in[I_XP], F.a->in[I_XS], F.out, WSP(bf16, WS_XA), SSo, D, M};
              pg8::gemm_phase<EpiO, pg8::StaticOrder, true, true>(ring, g, S, E); }
            { SkEpi e{}; e.base = F.a->in[I_XS]; e.base16 = 1; e.wy = 0; e.feed = 1; e.Y = F.out + (size_t)MP * D; e.XA = WSP(bf16, WS_XA); e.SSo = SSo;
              skinny_res_splitk(F, WSP(bf16, WS_O) + (size_t)MP * K, Wt, K, 2 * layer, e); }
            if (layer == 0 && REP(6) == 2) {
            { pg8::Gemm g{WSP(bf16, WS_O), Wt, MP, D, K}; pg8::StaticOrder S; S.init(MP, D, F.G, cb);
              typedef pg8::EpiRes<layer != 0, false, true> EpiO;
              EpiO E{F.a->in[I_XP], F.a->in[I_XS], F.out, WSP(bf16, WS_XA), SSo, D, M};
              pg8::gemm_phase<EpiO, pg8::StaticOrder, true, true>(ring, g, S, E); }
            if (P6_SK) { SkEpi e{}; e.base = F.a->in[I_XS]; e.base16 = layer != 0; e.wy = 0; e.feed = 1; e.Y = F.out + (size_t)MP * D; e.XA = WSP(bf16, WS_XA); e.SSo = SSo;
              skinny_res_splitk(F, WSP(bf16, WS_O) + (size_t)MP * K, Wt, K, 2 * layer, e); } } }
        SEAM(pb);
        if (IN(pb + 1)) { const bf16* Wt = WSP(bf16, WS_WFI) + (size_t)layer * NFI * KFIP; const float* SSi = WSP(float, WS_SS) + (size_t)(2 * layer + 1) * (SS_STRIDE / 4);
            { pg8::Gemm g{WSP(bf16, WS_XA), Wt, MP, NFI, D, D, KFIP}; pg8::StaticOrder S; S.init(MP, NFI, F.G, cb);
              RS_RESET(F); pg8::EpiSwiGLU E{WSP(bf16, WS_U), DFFP, {SSi, RS_CACHE(F)}};
              pg8::gemm_phase<pg8::EpiSwiGLU, pg8::StaticOrder, true, true>(ring, g, S, E); }
            { SkEpi e{}; e.O = WSP(bf16, WS_U); e.ldo = DFFP; e.ss = SSi; skinny_gemm<5>(F, WSP(bf16, WS_XA) + (size_t)MP * D, Wt, D, DFF / 32, 32 * 86, e, F.ctl + CW_SKQ + 64 * layer, KFIP); }
            if (REP(pb + 1) == 2) { { pg8::Gemm g{WSP(bf16, WS_XA), Wt, MP, NFI, D, D, KFIP}; pg8::StaticOrder S; S.init(MP, NFI, F.G, cb);
              RS_RESET(F); pg8::EpiSwiGLU E{WSP(bf16, WS_U), DFFP, {SSi, RS_CACHE(F)}};
              pg8::gemm_phase<pg8::EpiSwiGLU, pg8::StaticOrder, true, true>(ring, g, S, E); }
            { SkEpi e{}; e.O = WSP(bf16, WS_U); e.ldo = DFFP; e.ss = SSi; skinny_gemm<5>(F, WSP(bf16, WS_XA) + (size_t)MP * D, Wt, D, DFF / 32, 32 * 86, e, nullptr, KFIP); } } }
        SEAM(pb + 1);
        if (IN(pb + 2)) { const bf16* Wt = WSP(bf16, WS_WFOP) + (size_t)layer * D * DFFP; float* SSo = WSP(float, WS_SS) + (size_t)(2 * layer + 2) * (SS_STRIDE / 4);
            { pg8::Gemm g{WSP(bf16, WS_U), Wt, MP, D, DFF, DFFP}; pg8::StaticOrder S; S.init(MP, D, F.G, cb);
              typedef pg8::EpiRes<true, layer == 1, layer == 0> EpiF;
              EpiF E{nullptr, nullptr, F.out, WSP(bf16, WS_XA), SSo, D, M};
              pg8::gemm_phase<EpiF, pg8::StaticOrder, true, true>(ring, g, S, E); }
            { SkEpi e{}; e.base16 = 1; e.wy = layer == 1; e.feed = layer == 0; e.Y = F.out + (size_t)MP * D; e.XA = WSP(bf16, WS_XA); e.SSo = SSo;
              skinny_res_splitk(F, WSP(bf16, WS_U) + (size_t)MP * DFFP, Wt, DFF, 2 * layer + 1, e, DFFP); }
            if (layer == 0 && REP(15) == 2) { SkEpi e{}; e.base16 = 1; e.wy = 1; e.feed = 0; e.Y = WSP(float, WS_WARR); e.XA = WSP(bf16, WS_XA); e.SSo = SSo;
              skinny_res_splitk(F, WSP(bf16, WS_U) + (size_t)MP * DFFP, Wt, DFF, 5, e, DFFP); }
            if (layer == 0 && REP(8) == 2) { pg8::Gemm g{WSP(bf16, WS_U), Wt, MP, D, DFF, DFFP}; pg8::StaticOrder S; S.init(MP, D, F.G, cb);
              typedef pg8::EpiRes<true, true, false> EpiP;
              EpiP E{nullptr, nullptr, WSP(float, WS_WARR), WSP(bf16, WS_XA), SSo, D, M};
              pg8::gemm_phase<EpiP, pg8::StaticOrder, true, true>(ring, g, S, E); } }
}
__global__ void __launch_bounds__(NWAVES * 64, 2) mega_fwd(Args args) {
    extern __shared__ __attribute__((aligned(16))) unsigned char lds[];
    Frame F;
    F.lds = (LAS unsigned char*)lds;
    F.MISC = (volatile LAS unsigned*)(F.lds + MISC_OFF);
    F.tid = threadIdx.x; F.lane = F.tid & 63; F.wave = __builtin_amdgcn_readfirstlane(F.tid >> 6);
    F.G = gridDim.x; { const int bx = blockIdx.x; F.vcu = (F.G % 8 == 0) ? (bx % 8) * (F.G / 8) + bx / 8 : bx; }
    F.gw = F.vcu * NWAVES + F.wave; F.NGW = F.G * NWAVES;
    F.ws = args.ws; F.out = args.out; F.ctl = (gu32*)(args.ws + WS_CTL);
    F.a = &args;
    for (int u = F.tid; u < (LDS_BYTES - LDSCTL_OFF) / 4; u += NWAVES * 64) ((LAS unsigned*)(F.lds + LDSCTL_OFF))[u] = 0u;
    __syncthreads();
    XcdBarrier bar = xcd_barrier_post((unsigned*)(F.ctl + CW_BAR), F.MISC + 8);
    const int cb = (int)blockIdx.x;
    LAS unsigned char* ring = F.lds + RING_OFF;

    if (IN(0)) { for (int rep = 0; rep < REP(0); ++rep) p0_prologue(F); }
    SEAM(0);
    if (IN(1)) {
        { pg8::Gemm g{WSP(bf16, WS_XA), WSP(bf16, WS_WINA), MPAD, NA, D}; pg8::StaticOrder S; S.init(MPAD, NA, F.G, cb);
          RS_RESET(F); pg8::EpiB16<3> E{WSP(bf16, WS_U), NA, {WSP(float, WS_SS), RS_CACHE(F)}};
          pg8::gemm_phase<pg8::EpiB16<3>, pg8::StaticOrder, true, true>(ring, g, S, E); }
        for (int l = 0; l < 2; ++l) { pg8::Gemm g{WSP(bf16, WS_XM), WSP(bf16, WS_WMEM) + (size_t)l * 2048 * D, 1024, 2048, D}; pg8::StaticOrder S; S.init(1024, 2048, F.G, rot_c(cb, F.G, 33 * 43 + 32 * l));
          pg8::EpiF32 E{WSP(float, WS_MEMRAW) + (size_t)l * 1024 * 2048, 2048, {WSP(float, WS_RSTDM)}};
          pg8::gemm_phase<pg8::EpiF32, pg8::StaticOrder, true, true>(ring, g, S, E); }
        if (REP(1) == 2) {
        { pg8::Gemm g{WSP(bf16, WS_XA), WSP(bf16, WS_WINA), MPAD, NA, D}; pg8::StaticOrder S; S.init(MPAD, NA, F.G, cb);
          RS_RESET(F); pg8::EpiB16<3> E{WSP(bf16, WS_U), NA, {WSP(float, WS_SS), RS_CACHE(F)}};
          pg8::gemm_phase<pg8::EpiB16<3>, pg8::StaticOrder, true, true>(ring, g, S, E); }
        for (int l = 0; l < 2; ++l) { pg8::Gemm g{WSP(bf16, WS_XM), WSP(bf16, WS_WMEM) + (size_t)l * 2048 * D, 1024, 2048, D}; pg8::StaticOrder S; S.init(1024, 2048, F.G, rot_c(cb, F.G, 33 * 43 + 32 * l));
          pg8::EpiF32 E{WSP(float, WS_MEMRAW) + (size_t)l * 1024 * 2048, 2048, {WSP(float, WS_RSTDM)}};
          pg8::gemm_phase<pg8::EpiF32, pg8::StaticOrder, true, true>(ring, g, S, E); } }
    }
    SEAM(1);
    if (IN(2)) { p2_lora_prep(F); p2_memkv_post(F); if (REP(2) == 2) { p2_lora_prep(F); p2_memkv_post(F); } }
    SEAM(2);
    if (IN(3)) {
        { pg8::Gemm g{WSP(bf16, WS_XLW), WSP(bf16, WS_W2), MPAD, MIXW, 256}; pg8::StaticOrder S; S.init(MPAD, MIXW, F.G, cb);
          pg8::EpiAct<0> E{WSP(float, WS_WARR), MIXW, F.a->in[I_W0]};
          pg8::gemm_phase<pg8::EpiAct<0>, pg8::StaticOrder, true, true>(ring, g, S, E); }
        { pg8::Gemm g{WSP(bf16, WS_XLA), WSP(bf16, WS_A2), MPAD, MIXW, 256}; pg8::StaticOrder S; S.init(MPAD, MIXW, F.G, rot_c(cb, F.G, 396));
          pg8::EpiAct<1> E{WSP(float, WS_AARR), MIXW, F.a->in[I_A0]};
          pg8::gemm_phase<pg8::EpiAct<1>, pg8::StaticOrder, true, true>(ring, g, S, E); }
        { pg8::Gemm g{WSP(bf16, WS_XLG), WSP(bf16, WS_G2), MPAD, MIXW, 384}; pg8::StaticOrder S; S.init(MPAD, MIXW, F.G, rot_c(cb, F.G, 792));
          pg8::EpiB16<0> E{WSP(bf16, WS_G), MIXW, {nullptr}};
          pg8::gemm_phase<pg8::EpiB16<0>, pg8::StaticOrder, true, true>(ring, g, S, E); }
        mem_attend_wg(F, 0, WSP(bf16, WS_U), NA, ASW, WSP(bf16, WS_O), D, MIXW);
    }
    SEAM(4);
    if (IN(5)) {
        const bool spread = F.G == 256; const bool scanwg = spread ? (F.vcu & 31) < 24 : F.vcu < NBP * AH; int gch = 0;
        const int sidx = spread ? (scanwg ? (F.vcu >> 5) * 24 + (F.vcu & 31) : (F.vcu >> 5) * 8 + (F.vcu & 31) - 24) : (scanwg ? F.vcu : F.vcu - NBP * AH);
        constexpr int SNB = 4, P5_SCR = SNB * SCH * 1536 + 1024;
        if (F.tid < 32) ((volatile LAS unsigned*)(F.lds + RING_OFF + SNB * SCH * 1536))[F.tid] = 0u;
        __syncthreads();
        if (F.wave < 7) { if (scanwg) p5_scan_wg<SNB>(F, sidx, gch);
            else { for (int i = 0; i < 6; ++i) { const int t = sidx + (F.G - NBP * AH) * i; if (t < NBS * AH) p5_scan_wg<SNB>(F, NBP * AH + t, gch); } } }
        p5_background(F, P5_SCR + F.wave * P5_SCR_STRIDE, scanwg && F.wave == 7);
    }
    SEAM(5);
    tail_phases<0>(F, bar);
    SEAM(8);

            if (IN(9)) { { pg8::Gemm g{WSP(bf16, WS_XA), WSP(bf16, WS_WINB), MP, NB, D}; pg8::StaticOrder S; S.init(MP, NB, F.G, cb);
                RS_RESET(F); pg8::EpiB16<3> E{WSP(bf16, WS_U), NB, {WSP(float, WS_SS) + 2 * (SS_STRIDE / 4), RS_CACHE(F)}};
                pg8::gemm_phase<pg8::EpiB16<3>, pg8::StaticOrder, true, true>(ring, g, S, E); }
                { SkEpi e{}; e.O = WSP(bf16, WS_U); e.ldo = NB; e.ss = WSP(float, WS_SS) + 2 * (SS_STRIDE / 4);
                  skinny_gemm<0>(F, WSP(bf16, WS_XA) + (size_t)MP * D, WSP(bf16, WS_WINB), D, NB / 64, 32 * 40, e); }
                if (REP(9) == 2) { { pg8::Gemm g{WSP(bf16, WS_XA), WSP(bf16, WS_WINB), MP, NB, D}; pg8::StaticOrder S; S.init(MP, NB, F.G, cb);
                RS_RESET(F); pg8::EpiB16<3> E{WSP(bf16, WS_U), NB, {WSP(float, WS_SS) + 2 * (SS_STRIDE / 4), RS_CACHE(F)}};
                pg8::gemm_phase<pg8::EpiB16<3>, pg8::StaticOrder, true, true>(ring, g, S, E); }
                { SkEpi e{}; e.O = WSP(bf16, WS_U); e.ldo = NB; e.ss = WSP(float, WS_SS) + 2 * (SS_STRIDE / 4);
                  skinny_gemm<0>(F, WSP(bf16, WS_XA) + (size_t)MP * D, WSP(bf16, WS_WINB), D, NB / 64, 32 * 40, e); } } }
            SEAM(9);
            if (IN(10)) { p10_qkv_post(F); if (REP(10) == 2) p10_qkv_post(F); }
            SEAM(10);
#define P11_BODY do { sample_attn_phase(F); band_attn_wg(F); mem_attend_wg(F, 1, WSP(bf16, WS_U), NB, 3 * MIXW, WSP(bf16, WS_O), 2048, 1024); } while (0)
            if (IN(11)) { P11_BODY; if (REP(11) == 2) { P11_BODY; } }
            SEAM(11);
            if (IN(12)) { merge_phase(F); if (REP(12) == 2) merge_phase(F); }
            SEAM(12);
            tail_phases<1>(F, bar);
#undef IN
#undef SEAM
}

extern "C" void kernel_launch(void* const* d_in, const int* in_sizes, int n_in, void* d_out, int out_size, void* d_ws, size_t ws_size, hipStream_t stream) {
    static int grid = 0;
    if (grid == 0) {
        if (n_in != N_IN || (size_t)out_size != OUT_END || ws_size < WS_END) { fprintf(stderr, "kernel_launch: unexpected sizes: n_in %d out %d (want %zu) ws %zu (want %zu)\n", n_in, out_size, (size_t)OUT_END, ws_size, (size_t)WS_END); grid = -1; return; }
        int dev = 0, cus = 0, per_cu = 0;
        if (hipGetDevice(&dev) != hipSuccess || hipDeviceGetAttribute(&cus, hipDeviceAttributeMultiprocessorCount, dev) != hipSuccess) { grid = -1; return; }
        if (hipFuncSetAttribute((const void*)mega_fwd, hipFuncAttributeMaxDynamicSharedMemorySize, LDS_BYTES) != hipSuccess) { fprintf(stderr, "kernel_launch: hipFuncSetAttribute failed\n"); grid = -1; return; }
        if (hipOccupancyMaxActiveBlocksPerMultiprocessor(&per_cu, (const void*)mega_fwd, NWAVES * 64, LDS_BYTES) != hipSuccess || per_cu < 1) fprintf(stderr, "kernel_launch: occupancy query says %d\n", per_cu);
        (void)hipGetLastError();
        grid = cus;
    }
    if (grid < 0) return;
    if (hipMemsetAsync((char*)d_ws + WS_CTL, 0, CTL_ZERO_BYTES, stream) != hipSuccess) return;
    Args a{};
    for (int i = 0; i < N_IN; ++i) a.in[i] = (const float*)d_in[i];
    a.out = (float*)d_out; a.ws = (unsigned char*)d_ws;
    hipLaunchKernelGGL(mega_fwd, dim3(grid), dim3(NWAVES * 64), LDS_BYTES, stream, a);
    const hipError_t le = hipPeekAtLastError();
    if (le != hipSuccess) fprintf(stderr, "kernel_launch: launch failed: %s\n", hipGetErrorName(le));
}
```
